# Optimizing an MI355X kernel written in HIP

```python
import jax
import jax.numpy as jnp
from jax import lax
import numpy as np

D_MODEL = 1024
BATCH = 8
SEQ = 4096
DEPTH = 4

CTX_LEN = 256
GRID_W = 64
HEAD_DIM = 64
NORM_EPS = 1e-6
NA_HEADS = 4
NA_KH = 8
NA_KW = 16
NA_WIDTH = NA_HEADS * HEAD_DIM
GLA_HEADS = 4
GLA_DK = 128
GLA_DV = 256
GLA_LOWRANK = 16
GLA_TAU = 16.0
GLA_CHUNK = 64
GQA_HEADS = 4
GQA_KV_HEADS = 2
GQA_WIDTH = GQA_HEADS * HEAD_DIM
GQA_KV_WIDTH = GQA_KV_HEADS * HEAD_DIM
Q_BLOCK = 128
ROPE_BASE = 10000.0
N_EXPERTS = 16
EXPERT_FF = 2048
EC_CAPACITY_FACTOR = 2
IN_SPLITS = (NA_WIDTH, NA_WIDTH, NA_WIDTH,
             GLA_DK, GLA_DK, GLA_DV, GLA_DV, GLA_LOWRANK, GLA_LOWRANK,
             GQA_WIDTH, GQA_KV_WIDTH, GQA_KV_WIDTH,
             D_MODEL, D_MODEL, D_MODEL)
IN_COLS = 5152

kernel_name = "hybrid_na_gla_gqa_ec_moe_diffusion"


def rmsnorm(x, g):
    xf = x.astype(jnp.float32)
    y = xf * lax.rsqrt(jnp.mean(xf * xf, axis=-1, keepdims=True) + NORM_EPS)
    return y.astype(x.dtype) * g


def modulate(x, g, shift, scale):
    return rmsnorm(x, g) * (1 + scale) + shift


def adaln(cv, w, b):
    mod = (jax.nn.silu(cv) @ w + b)[:, None, :]
    return jnp.split(mod, 6, axis=-1)


def split_heads(t, n):
    return t.reshape(t.shape[:-1] + (n, t.shape[-1] // n))


def split_projection(p):
    offs = np.cumsum(IN_SPLITS)[:-1].tolist()
    return jnp.split(p, offs, axis=-1)


def rope_1d(x, pos):
    half = x.shape[-1] // 2
    inv_freq = ROPE_BASE ** (-jnp.arange(half, dtype=jnp.float32) / half)
    ang = pos.astype(jnp.float32)[:, None] * inv_freq[None, :]
    cos = jnp.cos(ang)[:, None, :]
    sin = jnp.sin(ang)[:, None, :]
    x1 = x[..., :half].astype(jnp.float32)
    x2 = x[..., half:].astype(jnp.float32)
    return jnp.concatenate([x1 * cos - x2 * sin, x2 * cos + x1 * sin], axis=-1).astype(x.dtype)


def axial_rope(x, row, col):
    half = x.shape[-1] // 2
    return jnp.concatenate([rope_1d(x[..., :half], row), rope_1d(x[..., half:], col)], axis=-1)


def attend(q, k, v):
    s = jnp.einsum('btkgd,bskd->bkgts', q, k) * (q.shape[-1] ** -0.5)
    p = jax.nn.softmax(s.astype(jnp.float32), axis=-1).astype(v.dtype)
    return jnp.einsum('bkgts,bskd->btkgd', p, v)


def attend_blocked(q, k, v):
    B, T = q.shape[:2]
    nb = T // Q_BLOCK
    qb = jnp.moveaxis(q.reshape((B, nb, Q_BLOCK) + q.shape[2:]), 1, 0)
    o = lax.map(lambda qi: attend(qi, k, v), qb)
    return jnp.moveaxis(o, 0, 1).reshape(q.shape)


def neighbourhood_attention(q, k, v, k_ctx, v_ctx, rpb):
    B, T, H, D = q.shape
    rows = T // GRID_W
    kh = min(NA_KH, rows)
    kw = NA_KW
    scale = D ** -0.5
    qg = q.reshape(B, rows, GRID_W, H, D)
    kg = k.reshape(B, rows, GRID_W, H, D)
    vg = v.reshape(B, rows, GRID_W, H, D)
    col = jnp.arange(GRID_W)
    col_start = jnp.clip(col - kw // 2, 0, GRID_W - kw)
    col_idx = col_start[:, None] + jnp.arange(kw)[None, :]
    dc = col_idx - col[:, None] + (NA_KW - 1)

    def row_block(args):
        q_row, r = args
        r_start = jnp.clip(r - kh // 2, 0, rows - kh)
        k_rows = lax.dynamic_slice_in_dim(kg, r_start, kh, axis=1)
        v_rows = lax.dynamic_slice_in_dim(vg, r_start, kh, axis=1)
        k_win = k_rows[:, :, col_idx]
        v_win = v_rows[:, :, col_idx]
        dr = r_start + jnp.arange(kh) - r + (NA_KH - 1)
        bias = rpb[:, dr[:, None, None], dc[None, :, :]]
        bias = jnp.transpose(bias, (0, 2, 1, 3)).astype(jnp.float32)
        s_loc = jnp.einsum('bqhd,baqkhd->bhqak', q_row, k_win).astype(jnp.float32) * scale + bias[None]
        s_ctx = jnp.einsum('bqhd,bshd->bhqs', q_row, k_ctx).astype(jnp.float32) * scale
        s = jnp.concatenate([s_loc.reshape(B, H, GRID_W, kh * kw), s_ctx], axis=-1)
        p = jax.nn.softmax(s, axis=-1).astype(v.dtype)
        p_loc = p[..., :kh * kw].reshape(B, H, GRID_W, kh, kw)
        p_ctx = p[..., kh * kw:]
        return (jnp.einsum('bhqak,baqkhd->bqhd', p_loc, v_win)
                + jnp.einsum('bhqs,bshd->bqhd', p_ctx, v_ctx))

    out = lax.map(row_block, (jnp.moveaxis(qg, 1, 0), jnp.arange(rows)))
    return jnp.moveaxis(out, 0, 1).reshape(B, T, H, D)


def gla_log_gate(lr, w, b):
    g = jax.nn.log_sigmoid((lr @ w + b).astype(jnp.float32)) / GLA_TAU
    return split_heads(g, GLA_HEADS)


def gla_chunk_states(k, v, g, s0):
    b = jnp.cumsum(g, axis=2)
    b_last = b[:, :, -1]
    k_end = k * jnp.exp(b_last[:, :, None] - b)
    d_state = jnp.einsum('bnjhk,bnjhv->bnhkv', k_end, v)

    def step(s, inp):
        decay, ds = inp
        return decay[..., None] * s + ds, s

    s_final, s_in = lax.scan(step, s0, (jnp.moveaxis(jnp.exp(b_last), 1, 0), jnp.moveaxis(d_state, 1, 0)))
    return b, jnp.moveaxis(s_in, 0, 1), s_final


def _to_chunks(t):
    B, T, H, d = t.shape
    return t.reshape(B, T // GLA_CHUNK, GLA_CHUNK, H, d)


def gla_scan(q, k, v, g, s0):
    B, T, H, dk = q.shape
    qn, kn, vn, gn = _to_chunks(q), _to_chunks(k), _to_chunks(v), _to_chunks(g)
    b, s_in, s_final = gla_chunk_states(kn, vn, gn, s0)
    q_dec = qn * (dk ** -0.5) * jnp.exp(b)
    k_inv = kn * jnp.exp(-b)
    tri = jnp.tril(jnp.ones((GLA_CHUNK, GLA_CHUNK), dtype=bool))
    a = jnp.where(tri, jnp.einsum('bnihk,bnjhk->bnhij', q_dec, k_inv), 0.0)
    o = (jnp.einsum('bnhij,bnjhv->bnihv', a, vn)
         + jnp.einsum('bnihk,bnhkv->bnihv', q_dec, s_in))
    return o.reshape(B, T, H, v.shape[-1]).astype(v.dtype), s_final


def gla_final_state(k, v, g, s0):
    _, _, s_final = gla_chunk_states(_to_chunks(k), _to_chunks(v), _to_chunks(g), s0)
    return s_final


def gla_output(o, r, g):
    B, T = o.shape[:2]
    return rmsnorm(o, g).reshape(B, T, GLA_DV) * jax.nn.silu(r)


def rev(t):
    return jnp.flip(t, axis=1)


def merge_branches(ya, yb, yc, mga, mgb, mgc, wb_a, wb_b, wb_c, w_out):
    m = (jax.nn.sigmoid(mga) * (ya @ wb_a)
         + jax.nn.sigmoid(mgb) * (yb @ wb_b)
         + jax.nn.sigmoid(mgc) * (yc @ wb_c))
    return m @ w_out


def hybrid_mixer(u, uc, w_in, rpb, wg_f, bg_f, wg_b, bg_b, gla_g, qn_g, kn_g,
                 wb_a, wb_b, wb_c, w_out, row, col, with_ctx_out):
    B, T, _ = u.shape
    S = uc.shape[1]
    (qa, ka, va, qb, kb, vb, rb, lf, lb, qc, kc, vc, mga, mgb, mgc) = split_projection(u @ w_in)
    (qa_c, ka_c, va_c, qb_c, kb_c, vb_c, rb_c, lf_c, lb_c,
     qc_c, kc_c, vc_c, mga_c, mgb_c, mgc_c) = split_projection(uc @ w_in)

    ka_ch, va_ch = split_heads(ka_c, NA_HEADS), split_heads(va_c, NA_HEADS)
    ya = neighbourhood_attention(split_heads(qa, NA_HEADS), split_heads(ka, NA_HEADS),
                                 split_heads(va, NA_HEADS), ka_ch, va_ch, rpb).reshape(B, T, NA_WIDTH)

    kb_ch, vb_ch = split_heads(kb_c, GLA_HEADS), split_heads(vb_c, GLA_HEADS)
    gf_c, gb_c = gla_log_gate(lf_c, wg_f, bg_f), gla_log_gate(lb_c, wg_b, bg_b)
    s0 = jnp.zeros((B, GLA_HEADS, GLA_DK // GLA_HEADS, GLA_DV // GLA_HEADS), jnp.float32)
    if with_ctx_out:
        qb_ch = split_heads(qb_c, GLA_HEADS)
        oc_f, s_f = gla_scan(qb_ch, kb_ch, vb_ch, gf_c, s0)
        oc_b, s_b = gla_scan(rev(qb_ch), rev(kb_ch), rev(vb_ch), rev(gb_c), s0)
        yb_c = gla_output(oc_f + rev(oc_b), rb_c, gla_g)
    else:
        s_f = gla_final_state(kb_ch, vb_ch, gf_c, s0)
        s_b = gla_final_state(rev(kb_ch), rev(vb_ch), rev(gb_c), s0)
    qb_h, kb_h, vb_h = split_heads(qb, GLA_HEADS), split_heads(kb, GLA_HEADS), split_heads(vb, GLA_HEADS)
    gf, gbk = gla_log_gate(lf, wg_f, bg_f), gla_log_gate(lb, wg_b, bg_b)
    o_f, _ = gla_scan(qb_h, kb_h, vb_h, gf, s_f)
    o_b, _ = gla_scan(rev(qb_h), rev(kb_h), rev(vb_h), rev(gbk), s_b)
    yb = gla_output(o_f + rev(o_b), rb, gla_g)

    grp = GQA_HEADS // GQA_KV_HEADS
    q_h = axial_rope(rmsnorm(split_heads(qc, GQA_HEADS), qn_g), row, col)
    k_h = axial_rope(rmsnorm(split_heads(kc, GQA_KV_HEADS), kn_g), row, col)
    k_ch = rmsnorm(split_heads(kc_c, GQA_KV_HEADS), kn_g)
    v_ch = split_heads(vc_c, GQA_KV_HEADS)
    k_all = jnp.concatenate([k_ch, k_h], axis=1)
    v_all = jnp.concatenate([v_ch, split_heads(vc, GQA_KV_HEADS)], axis=1)
    yc = attend_blocked(q_h.reshape(B, T, GQA_KV_HEADS, grp, HEAD_DIM), k_all, v_all).reshape(B, T, GQA_WIDTH)

    m_lat = merge_branches(ya, yb, yc, mga, mgb, mgc, wb_a, wb_b, wb_c, w_out)
    if not with_ctx_out:
        return m_lat, None

    ya_c = attend(split_heads(qa_c, NA_HEADS)[:, :, :, None, :], ka_ch, va_ch).reshape(B, S, NA_WIDTH)
    q_ch = rmsnorm(split_heads(qc_c, GQA_HEADS), qn_g).reshape(B, S, GQA_KV_HEADS, grp, HEAD_DIM)
    yc_c = attend(q_ch, k_ch, v_ch).reshape(B, S, GQA_WIDTH)
    m_ctx = merge_branches(ya_c, yb_c, yc_c, mga_c, mgb_c, mgc_c, wb_a, wb_b, wb_c, w_out)
    return m_lat, m_ctx


def expert_choice_ffn(x, w_router, w_gate, w_up, w_down):
    B, T, Dm = x.shape
    cap = EC_CAPACITY_FACTOR * T // N_EXPERTS
    aff = jax.nn.softmax((x @ w_router).astype(jnp.float32), axis=-1)
    vals, idx = lax.top_k(jnp.swapaxes(aff, 1, 2), cap)
    xs = jax.vmap(lambda xb, ib: xb[ib])(x, idx)
    h = jax.nn.silu(jnp.einsum('becd,edf->becf', xs, w_gate)) * jnp.einsum('becd,edf->becf', xs, w_up)
    y = jnp.einsum('becf,efd->becd', h, w_down) * vals[..., None].astype(x.dtype)

    def scatter_one(yb, ib):
        return jnp.zeros((T, Dm), yb.dtype).at[ib.reshape(-1)].add(yb.reshape(-1, Dm))

    return jax.vmap(scatter_one)(y, idx)


def _normal(k, shape, scale):
    return jax.random.normal(k, shape, jnp.float32) * scale


def setup_inputs(seed: int = 0) -> dict:
    key = jax.random.key(seed)
    k = jax.random.split(key, 26)
    L, D = DEPTH, D_MODEL
    return {
        "x": _normal(k[0], (BATCH, SEQ, D), 1.0),
        "c": _normal(k[1], (BATCH, D), 1.0),
        "ctx": _normal(k[2], (BATCH, CTX_LEN, D), 1.0),
        "c_ctx": _normal(k[3], (D,), 1.0),
        "w_ada": _normal(k[4], (L, D, 6 * D), 0.5 * D ** -0.5),
        "b_ada": _normal(k[5], (L, 6 * D), 0.01),
        "norm1_g": 1.0 + _normal(k[6], (L, D), 0.02),
        "norm2_g": 1.0 + _normal(k[7], (L, D), 0.02),
        "w_in": _normal(k[8], (L, D, IN_COLS), D ** -0.5),
        "na_rpb": _normal(k[9], (L, NA_HEADS, 2 * NA_KH - 1, 2 * NA_KW - 1), 0.1),
        "gla_wg_f": _normal(k[10], (L, GLA_LOWRANK, GLA_DK), GLA_LOWRANK ** -0.5),
        "gla_bg_f": _normal(k[11], (L, GLA_DK), 0.1),
        "gla_wg_b": _normal(k[12], (L, GLA_LOWRANK, GLA_DK), GLA_LOWRANK ** -0.5),
        "gla_bg_b": _normal(k[13], (L, GLA_DK), 0.1),
        "gla_norm_g": 1.0 + _normal(k[14], (L, GLA_DV // GLA_HEADS), 0.02),
        "gqa_qn_g": 1.0 + _normal(k[15], (L, HEAD_DIM), 0.02),
        "gqa_kn_g": 1.0 + _normal(k[16], (L, HEAD_DIM), 0.02),
        "w_branch_a": _normal(k[17], (L, NA_WIDTH, D), NA_WIDTH ** -0.5),
        "w_branch_b": _normal(k[18], (L, GLA_DV, D), GLA_DV ** -0.5),
        "w_branch_c": _normal(k[19], (L, GQA_WIDTH, D), GQA_WIDTH ** -0.5),
        "w_out": _normal(k[20], (L, D, D), D ** -0.5),
        "w_router": _normal(k[21], (L, D, N_EXPERTS), D ** -0.5),
        "w_e_gate": _normal(k[22], (L, N_EXPERTS, D, EXPERT_FF), D ** -0.5),
        "w_e_up": _normal(k[23], (L, N_EXPERTS, D, EXPERT_FF), D ** -0.5),
        "w_e_down": _normal(k[24], (L, N_EXPERTS, EXPERT_FF, D), EXPERT_FF ** -0.5),
        "final_norm_g": 1.0 + _normal(k[25], (D,), 0.02),
    }


def reference(x, c, ctx, c_ctx, w_ada, b_ada, norm1_g, norm2_g, w_in, na_rpb,
              gla_wg_f, gla_bg_f, gla_wg_b, gla_bg_b, gla_norm_g, gqa_qn_g, gqa_kn_g,
              w_branch_a, w_branch_b, w_branch_c, w_out, w_router, w_e_gate, w_e_up,
              w_e_down, final_norm_g):
    T = x.shape[1]
    t = jnp.arange(T)
    row = t // GRID_W
    col = t % GRID_W
    xc = ctx
    for l in range(DEPTH):
        last = l == DEPTH - 1
        sh1, sc1, g1, sh2, sc2, g2 = adaln(c, w_ada[l], b_ada[l])
        sh1c, sc1c, g1c, sh2c, sc2c, g2c = adaln(c_ctx[None], w_ada[l], b_ada[l])
        u = modulate(x, norm1_g[l], sh1, sc1)
        uc = modulate(xc, norm1_g[l], sh1c, sc1c)
        m, mc = hybrid_mixer(u, uc, w_in[l], na_rpb[l], gla_wg_f[l], gla_bg_f[l], gla_wg_b[l],
                             gla_bg_b[l], gla_norm_g[l], gqa_qn_g[l], gqa_kn_g[l],
                             w_branch_a[l], w_branch_b[l], w_branch_c[l], w_out[l],
                             row, col, not last)
        x = x + g1 * m
        x = x + g2 * expert_choice_ffn(modulate(x, norm2_g[l], sh2, sc2),
                                       w_router[l], w_e_gate[l], w_e_up[l], w_e_down[l])
        if not last:
            xc = xc + g1c * mc
            xc = xc + g2c * expert_choice_ffn(modulate(xc, norm2_g[l], sh2c, sc2c),
                                              w_router[l], w_e_gate[l], w_e_up[l], w_e_down[l])
    return rmsnorm(x, final_norm_g)
```

```cpp
#include <hip/hip_runtime.h>
#include <stdint.h>
#include <stdio.h>


typedef unsigned short bf16_t;
typedef short bf16x8 __attribute__((ext_vector_type(8)));
typedef float f32x4 __attribute__((ext_vector_type(4)));
typedef unsigned u32x4 __attribute__((ext_vector_type(4)));
typedef unsigned u32x2 __attribute__((ext_vector_type(2)));
#define LAS __attribute__((address_space(3)))

constexpr int DM = 1024, NB = 8, TL = 4096, SC = 256, NL = 4;
constexpr int NLAT = NB * TL, NCTX = NB * SC, MT = NLAT + NCTX;
constexpr int INC = 5152, PC = 5376;
constexpr int C_QA = 0, C_KA = 256, C_VA = 512, C_QB = 768, C_KB = 896, C_VB = 1024, C_RB = 1280, C_G = 1536,
              C_QC = 1792, C_KC = 2048, C_VC = 2176, C_MG = 2304;
constexpr int NE = 16, FF = 2048, CAPL = 512, CAPC = 32, EROWS = NB * CAPL + NB * CAPC;
constexpr int NCH = 68;
constexpr int NTHREADS = 512;
constexpr float EPS = 1e-6f;
constexpr float S8_W = 256.f, S8_X = 8.f, S8_H = 4.f, S8_U = 8.f;

__device__ __forceinline__ unsigned cvt_pk_bf16_hw(float lo, float hi) { unsigned r; asm("v_cvt_pk_bf16_f32 %0, %1, %2" : "=v"(r) : "v"(lo), "v"(hi)); return r; }
__device__ __forceinline__ bf16_t f2bf(float f) { return (bf16_t)(cvt_pk_bf16_hw(f, f) & 0xFFFFu); }
__device__ __forceinline__ float bf2f(bf16_t b) { return __uint_as_float(((unsigned)b) << 16); }
__device__ __forceinline__ unsigned pack2(float lo, float hi) { return cvt_pk_bf16_hw(lo, hi); }
__device__ __forceinline__ float bflo(unsigned w) { return __uint_as_float(w << 16); }
__device__ __forceinline__ float bfhi(unsigned w) { return __uint_as_float(w & 0xFFFF0000u); }
__device__ __forceinline__ float siluf(float x) { return x * __builtin_amdgcn_rcpf(1.f + __expf(-x)); }
__device__ __forceinline__ float logsig16(float z) { return (fminf(z, 0.f) - __logf(1.f + __expf(-fabsf(z)))) * (1.f / 16.f); }
__device__ __forceinline__ float wave_sum(float v) {
#pragma unroll
    for (int o = 32; o > 0; o >>= 1) v += __shfl_xor(v, o);
    return v;
}
__device__ __forceinline__ int ltid() { int t = threadIdx.x; asm volatile("" : "+v"(t)); return t; }
__device__ __forceinline__ int lbid() { int t = blockIdx.x; asm volatile("" : "+s"(t)); return t; }
__device__ __forceinline__ int lgrid() { int t = gridDim.x; asm volatile("" : "+s"(t)); return t; }
__device__ __forceinline__ LAS unsigned char* llds3(LAS unsigned char* p) { asm volatile("" : "+s"(p)); return p; }
__device__ __forceinline__ int mod_row(int R) { return R < NLAT ? (R >> 12) : NB; }

struct Params {
    const float* in[26];
    float* out;
    float* X; bf16_t* U; float* MOD; bf16_t* P; bf16_t* YCAT; bf16_t* MPRE;
    float* AFF; int* SRCROW; float* VAL; int* SLOTOF;
    unsigned char* XS; unsigned char* H; bf16_t* Y;
    float* DST; float* DEC; bf16_t* ST; unsigned char* PG; unsigned char* U8W; unsigned char* WING8; bf16_t* DLT;
    bf16_t* WIN; bf16_t* WB; bf16_t* WOUT; unsigned char* WGU; unsigned char* WD;
    unsigned* bar;
};
enum { I_X = 0, I_C, I_CTX, I_CCTX, I_WADA, I_BADA, I_N1G, I_N2G, I_WIN, I_RPB, I_WGF, I_BGF, I_WGB, I_BGB, I_GLAG, I_QNG, I_KNG,
       I_WBA, I_WBB, I_WBC, I_WOUT, I_WR, I_WEG, I_WEU, I_WED, I_FNG };

typedef const __attribute__((address_space(4))) Params* KP;
__device__ __forceinline__ KP kparams() {
    KP kp = (KP)__builtin_amdgcn_kernarg_segment_ptr();
    asm volatile("" : "+s"(kp) :: "memory");
    return kp;
}
#define XB_TMO      128
#define XB_XCNT(j)  (256  + 64 * (j))
#define XB_XSUB(j)  (1280 + 64 * (j))
#define XB_XGEN(j)  (2304 + 64 * (j))
#define XB_TOP      3328
#define XB_TOPGEN   3392
#define XCD_BAR_WORDS 3456
#define XB_SPIN_CAP (1u << 22)
#define QUEUE_WORDS (16 * 64)
__device__ __forceinline__ unsigned xb_ld(unsigned* p)              { return __hip_atomic_load(p, __ATOMIC_RELAXED, __HIP_MEMORY_SCOPE_AGENT); }
__device__ __forceinline__ unsigned xb_add(unsigned* p, unsigned v) { return __hip_atomic_fetch_add(p, v, __ATOMIC_RELAXED, __HIP_MEMORY_SCOPE_AGENT); }
__device__ __forceinline__ unsigned xb_xcc_id() { return (unsigned)__builtin_amdgcn_s_getreg((3 << 11) | 20) & 0xFu; }
#define XB_SPIN(cond, bar) do { unsigned _sp = 0; while (cond) { __builtin_amdgcn_s_sleep(1); \
    if ((++_sp & 255u) == 0u) { if (xb_ld(&(bar)[XB_TMO])) break; if (_sp > XB_SPIN_CAP) { atomicAdd(&(bar)[XB_TMO], 1u); break; } } } } while (0)
struct XcdBarrier { unsigned* bar; unsigned x; volatile LAS unsigned* st; };
__device__ __forceinline__ XcdBarrier xcd_barrier_post(unsigned* bar, volatile LAS unsigned* st) {
    XcdBarrier b; b.bar = bar; b.x = xb_xcc_id(); b.st = st;
    if (threadIdx.x == 0) (void)xb_add(&bar[XB_XCNT(b.x)], 1u);
    return b;
}
__device__ __forceinline__ void xcd_barrier_complete(unsigned* bar, unsigned x, unsigned& nloc, unsigned& nx) {
    const unsigned G = gridDim.x * gridDim.y * gridDim.z;
    unsigned sum, cnt, mine, sp = 0u;
    for (;;) {
        sum = 0u; cnt = 0u; mine = 0u;
#pragma unroll
        for (unsigned j = 0; j < 16; ++j) { const unsigned c = xb_ld(&bar[XB_XCNT(j)]); sum += c; cnt += (c > 0u) ? 1u : 0u; mine = (j == x) ? c : mine; }
        if (sum == G) break;
        __builtin_amdgcn_s_sleep(1);
        if ((++sp & 255u) == 0u) { if (xb_ld(&bar[XB_TMO])) break; if (sp > XB_SPIN_CAP) { atomicAdd(&bar[XB_TMO], 1u); break; } }
    }
    nloc = mine > 0u ? mine : 1u; nx = cnt > 0u ? cnt : 1u;
}
__device__ __forceinline__ void xcd_barrier(const XcdBarrier& b) {
    asm volatile("s_waitcnt vmcnt(0)" ::: "memory");
    __syncthreads();
    if (threadIdx.x == 0) {
        unsigned* bar = b.bar;
        __builtin_amdgcn_s_waitcnt(0);
        unsigned nloc = b.st[0], nx = b.st[1];
        if (nloc == 0u) { xcd_barrier_complete(bar, b.x, nloc, nx); b.st[0] = nloc; b.st[1] = nx; }
        const unsigned old = xb_add(&bar[XB_XSUB(b.x)], 1u);
        const unsigned gen = old / nloc;
        if (old + 1u == (gen + 1u) * nloc) {
            __builtin_amdgcn_fence(__ATOMIC_RELEASE, "agent");
            asm volatile("s_waitcnt vmcnt(0)" ::: "memory");
            const unsigned og = xb_add(&bar[XB_TOP], 1u);
            const unsigned tg = og / nx;
            if (og + 1u == (tg + 1u) * nx) xb_add(&bar[XB_TOPGEN], 1u);
            else XB_SPIN(xb_ld(&bar[XB_TOPGEN]) == tg, bar);
            __builtin_amdgcn_fence(__ATOMIC_ACQUIRE, "agent");
            xb_add(&bar[XB_XGEN(b.x)], 1u);
            asm volatile("s_waitcnt vmcnt(0)" ::: "memory");
        } else {
            XB_SPIN(xb_ld(&bar[XB_XGEN(b.x)]) == gen, bar);
            __builtin_amdgcn_fence(__ATOMIC_ACQUIRE, "agent");
            asm volatile("s_waitcnt vmcnt(0)" ::: "memory");
        }
    }
    __syncthreads();
}

#ifndef PG8_TID
#define PG8_TID ltid()
#endif
namespace pg8 {
constexpr int BM = 256, BK = 64, HALF = 128, HTB = HALF * BK * 2, STAGE_BYTES = 8 * HTB;
__host__ __device__ __forceinline__ int lds_byte(int r, int c) { const int st = (r >> 4) * 2 + (c >> 5), rr = r & 15, cc = c & 31, ob = rr * 64 + cc * 2; return st * 1024 + (ob ^ (((ob >> 9) & 1) << 5)); }
__host__ __device__ __forceinline__ void stage_rc(int b, int& R, int& C) { const int st = b / 1024, sb = b % 1024, swz = sb ^ (((sb >> 9) & 1) << 5); R = (st >> 1) * 16 + swz / 64; C = (st & 1) * 32 + (swz % 64) / 2; }
__host__ __device__ __forceinline__ int perm32(int rho) { const int n = rho >> 4, i = rho & 15; return 8 * (i >> 2) + 4 * n + (i & 3); }
struct Unit { const char* A; const char* B; int row0, col0, aux, keep; const int* G; };
__device__ __forceinline__ unsigned cvt_pk_bf16(float lo, float hi) { unsigned r; asm volatile("v_cvt_pk_bf16_f32 %0, %1, %2" : "=v"(r) : "v"(lo), "v"(hi)); return r; }

typedef int v8i __attribute__((ext_vector_type(8)));
typedef int v4i __attribute__((ext_vector_type(4)));
__device__ __forceinline__ void glds16s(unsigned voff, const void* sbase, unsigned lds_dst) { unsigned keep;
    asm volatile("s_mov_b32 %0, m0\n\ts_mov_b32 m0, %3\n\ts_nop 0\n\tglobal_load_lds_dwordx4 %1, %2\n\ts_mov_b32 m0, %0" : "=&s"(keep) : "v"(voff), "s"(sbase), "s"(lds_dst) : "memory"); }
__device__ __forceinline__ void glds4s(unsigned voff, const void* sbase, unsigned lds_dst) { unsigned keep;
    asm volatile("s_mov_b32 %0, m0\n\ts_mov_b32 m0, %3\n\ts_nop 0\n\tglobal_load_lds_dword %1, %2\n\ts_mov_b32 m0, %0" : "=&s"(keep) : "v"(voff), "s"(sbase), "s"(lds_dst) : "memory"); }
template <class Epi, class Sched, bool ALIGN_EPI, bool SP2, bool FP8 = false, bool GATHER = false>
__device__ __forceinline__ void gemm_phase(LAS unsigned char* lds, const int ldaB, const int ldbB, const int nt_in, const Sched& S, const Epi& E) {
    int nt = nt_in; asm volatile("" : "+s"(nt));
    const int tid = PG8_TID, wid = __builtin_amdgcn_readfirstlane(tid >> 6), lane = tid & 63, wr = wid >> 2, wc = wid & 3, fr = lane & 15, fq = lane >> 4;
    unsigned voffA[2], voffB[2];
#pragma unroll
    for (int i = 0; i < 2; ++i) { int R, C; stage_rc(tid * 16 + i * 8192, R, C); const int Rb = Epi::PERM ? ((R & ~31) + perm32(R & 31)) : R;
        voffA[i] = (unsigned)(R * ldaB + C * 2); voffB[i] = (unsigned)(Rb * ldbB + C * 2); }
    const size_t kstep = (size_t)(BK * 2);
    const size_t hstepA = (size_t)HALF * ldaB, hstepB = (size_t)HALF * ldbB;
    const unsigned ldsw = (unsigned)wid * 1024u, ldsbase = (unsigned)__builtin_amdgcn_readfirstlane((int)(unsigned)(uintptr_t)lds);
    const int aoff = lds_byte(wr * 64 + fr, fq * 8), boff = lds_byte(wc * 32 + fr, fq * 8);
#define PG8_SA(b, h) (((b) * 2 + (h)) * HTB)
#define PG8_SB(b, h) ((4 + (b) * 2 + (h)) * HTB)
#define PG8_STAGE(bufoff, gbase, voff) do { _Pragma("unroll") for (int _i = 0; _i < 2; ++_i) \
        glds16s((voff)[_i], (const void*)(gbase), ldsbase + (unsigned)(bufoff) + ldsw + _i * 8192); } while (0)
    unsigned vc[2][2], vn[2][2]; int gR[2], gC[2];
#pragma unroll
    for (int i = 0; i < 2; ++i) { int R, C; stage_rc(tid * 16 + i * 8192, R, C); gR[i] = R; gC[i] = C * 2; vc[0][i] = vc[1][i] = vn[0][i] = vn[1][i] = 0u; }
    LAS int* gidx = (LAS int*)(lds + STAGE_BYTES);
#define PG8_GIDX(dst, buf) do { _Pragma("unroll") for (int h_ = 0; h_ < 2; ++h_) _Pragma("unroll") for (int i_ = 0; i_ < 2; ++i_) dst[h_][i_] = (unsigned)(gidx[(buf) * 256 + h_ * HALF + gR[i_]] * ldaB + gC[i_]); } while (0)
#define PG8_STAGE_A(b, h, base, nx) do { if constexpr (GATHER) { if (nx) PG8_STAGE(PG8_SA(b, h), base, vn[h]); else PG8_STAGE(PG8_SA(b, h), base, vc[h]); } \
        else PG8_STAGE(PG8_SA(b, h), (base) + (h) * hstepA, voffA); } while (0)
#define PG8_LDA(dst, b, h) do { _Pragma("unroll") for (int m = 0; m < 4; ++m) { dst[m].lo = *(const LAS v4i*)(lds + PG8_SA(b, h) + aoff + m * 2048); dst[m].hi = *(const LAS v4i*)(lds + PG8_SA(b, h) + aoff + m * 2048 + 1024); } } while (0)
#define PG8_LDB(dst, b, h) do { _Pragma("unroll") for (int n = 0; n < 2; ++n) { dst[n].lo = *(const LAS v4i*)(lds + PG8_SB(b, h) + boff + n * 2048); dst[n].hi = *(const LAS v4i*)(lds + PG8_SB(b, h) + boff + n * 2048 + 1024); } } while (0)
#define PG8_MMA(ai, bj, At, Bt) do { __builtin_amdgcn_s_setprio(1); _Pragma("unroll") for (int m = 0; m < 4; ++m) _Pragma("unroll") for (int n = 0; n < 2; ++n) { \
        if constexpr (FP8) asm volatile("v_mfma_scale_f32_16x16x128_f8f6f4 %0, %1, %2, %0, %3, %3 op_sel_hi:[0,0,0]" : "+v"(acc[ai][bj][m][n]) : "v"(Bt[n]), "v"(At[m]), "v"(sc8)); \
        else { const v4i bl_ = Bt[n].lo, bh_ = Bt[n].hi, al_ = At[m].lo, ah_ = At[m].hi;     \
               acc[ai][bj][m][n] = __builtin_amdgcn_mfma_f32_16x16x32_bf16(__builtin_bit_cast(bf16x8, bl_), __builtin_bit_cast(bf16x8, al_), acc[ai][bj][m][n], 0, 0, 0); \
               acc[ai][bj][m][n] = __builtin_amdgcn_mfma_f32_16x16x32_bf16(__builtin_bit_cast(bf16x8, bh_), __builtin_bit_cast(bf16x8, ah_), acc[ai][bj][m][n], 0, 0, 0); } } __builtin_amdgcn_s_setprio(0); } while (0)
#define PG8_WAIT_V(n) asm volatile("s_waitcnt vmcnt(" #n ")" ::: "memory")
#define PG8_WAIT_L(n) asm volatile("s_waitcnt lgkmcnt(" #n ")" ::: "memory")
#define PG8_BAR __builtin_amdgcn_s_barrier()
#define PG8_SCHED __builtin_amdgcn_sched_barrier(0)
    Unit cur, nxt; int ui = 0;
    if (!S.next(0, cur)) return;
    f32x4 acc[2][2][4][2];
#pragma unroll
    for (int a = 0; a < 2; ++a)
#pragma unroll
        for (int b = 0; b < 2; ++b)
#pragma unroll
            for (int m = 0; m < 4; ++m)
#pragma unroll
                for (int n = 0; n < 2; ++n) acc[a][b][m][n] = (f32x4){0.f, 0.f, 0.f, 0.f};
    v8i At[4], B0[2], B1[2];
    int sc8 = 0x7F7F7F7F; asm volatile("" : "+v"(sc8));
    const char* cA = cur.A; const char* cB = cur.B;
    if constexpr (GATHER) {
        if (tid < 256) gidx[tid] = cur.G[tid];
        asm volatile("s_waitcnt vmcnt(0) lgkmcnt(0)" ::: "memory"); PG8_BAR; asm volatile("" ::: "memory");
        PG8_GIDX(vc, 0);
    }
    if constexpr (SP2) {
        PG8_STAGE(PG8_SB(0, 0), cB, voffB); PG8_STAGE(PG8_SB(0, 1), cB + hstepB, voffB); PG8_STAGE_A(0, 0, cA, false); PG8_STAGE_A(0, 1, cA, false);
        if (wr == 1) PG8_BAR;
        PG8_WAIT_V(2); PG8_BAR;
        PG8_STAGE(PG8_SB(1, 0), cB + kstep, voffB); PG8_STAGE_A(1, 0, cA + kstep, false); PG8_STAGE(PG8_SB(1, 1), cB + hstepB + kstep, voffB);
        PG8_WAIT_V(6); PG8_BAR;
    } else {
        PG8_STAGE(PG8_SB(0, 0), cB, voffB); PG8_STAGE(PG8_SA(0, 0), cA, voffA); PG8_STAGE(PG8_SB(0, 1), cB + hstepB, voffB); PG8_STAGE(PG8_SA(0, 1), cA + hstepA, voffA);
        if (wr == 1) PG8_BAR;
        PG8_WAIT_V(4); PG8_BAR;
        PG8_STAGE(PG8_SB(1, 0), cB + kstep, voffB); PG8_STAGE(PG8_SA(1, 0), cA + kstep, voffA); PG8_STAGE(PG8_SB(1, 1), cB + hstepB + kstep, voffB);
        PG8_WAIT_V(6); PG8_BAR;
    }
    for (;;) {
        const bool has_next = S.next(ui + 1, nxt);
        const char* nA = has_next ? nxt.A : cA; const char* nB = has_next ? nxt.B : cB;
        if constexpr (GATHER) { if (has_next && wid < 4) glds4s((unsigned)lane * 4u, (const void*)(nxt.G + wid * 64), ldsbase + (unsigned)STAGE_BYTES + (unsigned)(((ui + 1) & 1) * 1024 + wid * 256)); }
#pragma unroll 1
        for (int t = 0; t < nt; t += 2) {
            const bool last = (t == nt - 2);
            const char* a1 = cA + (size_t)(t + 1) * kstep;
            const char* a2 = last ? nA : cA + (size_t)(t + 2) * kstep; const char* b2 = last ? nB : cB + (size_t)(t + 2) * kstep;
            const char* a3 = a2 + kstep; const char* b3 = b2 + kstep;
            if constexpr (SP2) {
            if constexpr (GATHER) { if (last) { if (has_next) PG8_GIDX(vn, (ui + 1) & 1); else { vn[0][0] = vc[0][0]; vn[0][1] = vc[0][1]; vn[1][0] = vc[1][0]; vn[1][1] = vc[1][1]; } } }
            PG8_LDB(B0, 0, 0); PG8_LDB(B1, 0, 1); PG8_SCHED; PG8_LDA(At, 0, 0); PG8_STAGE_A(1, 1, a1, false);
            PG8_WAIT_V(8); PG8_WAIT_L(0); PG8_BAR; PG8_MMA(0, 0, At, B0); PG8_MMA(0, 1, At, B1); PG8_BAR; PG8_SCHED;
            PG8_LDA(At, 0, 1); PG8_STAGE(PG8_SB(0, 0), b2, voffB); PG8_STAGE(PG8_SB(0, 1), b2 + hstepB, voffB); PG8_STAGE_A(0, 0, a2, last);
            PG8_WAIT_V(8); PG8_WAIT_L(0); PG8_BAR; PG8_MMA(1, 0, At, B0); PG8_MMA(1, 1, At, B1); PG8_BAR; PG8_SCHED;
            PG8_LDB(B0, 1, 0); PG8_LDB(B1, 1, 1); PG8_SCHED; PG8_LDA(At, 1, 0); PG8_STAGE_A(0, 1, a2, last);
            PG8_WAIT_V(8); PG8_WAIT_L(0); PG8_BAR; PG8_MMA(0, 0, At, B0); PG8_MMA(0, 1, At, B1); PG8_BAR; PG8_SCHED;
            PG8_LDA(At, 1, 1); PG8_STAGE(PG8_SB(1, 0), b3, voffB); PG8_STAGE(PG8_SB(1, 1), b3 + hstepB, voffB); PG8_STAGE_A(1, 0, a3, last);
            PG8_WAIT_V(8); PG8_WAIT_L(0); PG8_BAR; PG8_MMA(1, 0, At, B0); PG8_MMA(1, 1, At, B1); PG8_BAR; PG8_SCHED;
            } else {
            PG8_LDB(B0, 0, 0); PG8_SCHED; PG8_LDA(At, 0, 0); PG8_STAGE(PG8_SA(1, 1), a1 + hstepA, voffA);
            PG8_WAIT_L(8); PG8_BAR; PG8_WAIT_L(0); PG8_MMA(0, 0, At, B0); PG8_BAR; PG8_SCHED;
            PG8_LDB(B1, 0, 1); PG8_STAGE(PG8_SB(0, 0), b2, voffB);
            PG8_BAR; PG8_WAIT_L(0); PG8_MMA(0, 1, At, B1); PG8_BAR;
            PG8_LDA(At, 0, 1); PG8_STAGE(PG8_SA(0, 0), a2, voffA);
            PG8_BAR; PG8_WAIT_L(0); PG8_MMA(1, 0, At, B0); PG8_BAR; PG8_SCHED;
            PG8_STAGE(PG8_SB(0, 1), b2 + hstepB, voffB);
            PG8_WAIT_V(6); PG8_BAR; PG8_MMA(1, 1, At, B1); PG8_BAR;
            PG8_LDB(B0, 1, 0); PG8_SCHED; PG8_LDA(At, 1, 0); PG8_STAGE(PG8_SA(0, 1), a2 + hstepA, voffA);
            PG8_WAIT_L(8); PG8_BAR; PG8_WAIT_L(0); PG8_MMA(0, 0, At, B0); PG8_BAR; PG8_SCHED;
            PG8_LDB(B1, 1, 1); PG8_STAGE(PG8_SB(1, 0), b3, voffB);
            PG8_BAR; PG8_WAIT_L(0); PG8_MMA(0, 1, At, B1); PG8_BAR;
            PG8_LDA(At, 1, 1); PG8_STAGE(PG8_SA(1, 0), a3, voffA);
            PG8_BAR; PG8_WAIT_L(0); PG8_MMA(1, 0, At, B0); PG8_BAR; PG8_SCHED;
            PG8_STAGE(PG8_SB(1, 1), b3 + hstepB, voffB);
            PG8_WAIT_V(6); PG8_BAR; PG8_MMA(1, 1, At, B1); PG8_BAR;
            }
        }
        if constexpr (FP8) asm volatile("s_nop 15\n\ts_nop 15" ::: "memory");
        if constexpr (ALIGN_EPI) { if (wr == 0) PG8_BAR; }
        E(acc, cur, wr, wc, fr, fq);
        if (!has_next) break;
        if (!(Epi::KEEP && cur.keep)) {
#pragma unroll
        for (int a = 0; a < 2; ++a)
#pragma unroll
            for (int b = 0; b < 2; ++b)
#pragma unroll
                for (int m = 0; m < 4; ++m)
#pragma unroll
                    for (int n = 0; n < 2; ++n) acc[a][b][m][n] = (f32x4){0.f, 0.f, 0.f, 0.f};
        }
        cur = nxt; cA = nA; cB = nB; ++ui;
        if constexpr (GATHER) { vc[0][0] = vn[0][0]; vc[0][1] = vn[0][1]; vc[1][0] = vn[1][0]; vc[1][1] = vn[1][1]; }
        if constexpr (ALIGN_EPI) { if (wr == 1) PG8_BAR; }
    }
    PG8_WAIT_V(0);
    if constexpr (!ALIGN_EPI) { if (wr == 0) PG8_BAR; }
    PG8_BAR;
#undef PG8_SA
#undef PG8_SB
#undef PG8_STAGE
#undef PG8_STAGE_A
#undef PG8_GIDX
#undef PG8_LDA
#undef PG8_LDB
#undef PG8_MMA
#undef PG8_WAIT_V
#undef PG8_WAIT_L
#undef PG8_BAR
#undef PG8_SCHED
}

struct PlainOrder {
    const char* A; const char* B; size_t astep, bstep; int nM, nN, G, c;
    __device__ __forceinline__ bool next(int i, Unit& u) const {
        const int L = i * G + c; if (L >= nM * nN) return false;
        const int nig = 8 * nN, gid = L / nig, fm = gid * 8, gsz = (nM - fm) < 8 ? (nM - fm) : 8;
        const int pm = fm + ((L % nig) % gsz), pn = (L % nig) / gsz;
        u.A = A + (size_t)pm * astep; u.B = B + (size_t)pn * bstep; u.row0 = pm * 256; u.col0 = pn * 256; u.aux = 0; u.keep = 0; u.G = nullptr; return true;
    }
};
struct MergeOrder {
    const char* A; const char* B; size_t astep, bstep; int nM, nN, G, c;
    __device__ __forceinline__ bool next(int i, Unit& u) const {
        const int t = i / 3, seg = i - 3 * t;
        const int L = t * G + c; if (L >= nM * nN) return false;
        const int nig = 8 * nN, gid = L / nig, fm = gid * 8, gsz = (nM - fm) < 8 ? (nM - fm) : 8;
        const int pm = fm + ((L % nig) % gsz), pn = (L % nig) / gsz;
        u.A = A + (size_t)pm * astep + seg * 512; u.B = B + (size_t)pn * bstep + seg * 512; u.row0 = pm * 256; u.col0 = pn * 256; u.aux = seg; u.keep = seg < 2; u.G = nullptr; return true;
    }
};
struct ExpertOrder {
    const char* A; const char* B; size_t astep, bstep, aexp, bexp; int nM, nN, G, c; const int* rows;
    __device__ __forceinline__ bool next(int i, Unit& u) const {
        const int L = i * G + c, per = nM * nN; if (L >= NE * per) return false;
        const int e = L / per, r = L - e * per;
        const int nig = 8 * nN, gid = r / nig, fm = gid * 8, gsz = (nM - fm) < 8 ? (nM - fm) : 8;
        const int pm = fm + ((r % nig) % gsz), pn = (r % nig) / gsz;
        u.A = A + (size_t)e * aexp + (size_t)pm * astep; u.B = B + (size_t)e * bexp + (size_t)pn * bstep; u.row0 = e * EROWS + pm * 256; u.col0 = pn * 256; u.aux = e; u.keep = 0; u.G = rows ? rows + u.row0 : nullptr; return true;
    }
};
__device__ __forceinline__ unsigned q8(float g) {
    const float sg = __builtin_amdgcn_rcpf(1.f + __builtin_amdgcn_exp2f(g * -1.4426950408889634f));
    return (unsigned)__builtin_amdgcn_fmed3f(sg * 255.f + 0.5f, 1.f, 255.f);
}
struct EpiIn {
    static constexpr bool PERM = true, KEEP = false;
    bf16_t* P; unsigned char* PG;
    __device__ __forceinline__ void operator()(f32x4 (&acc)[2][2][4][2], const Unit& u, int wr, int wc, int fr, int fq) const {
        const int row0 = u.row0 + wr * 64 + fr, cl = u.col0 + wc * 32 + 8 * fq; const bool mg = u.col0 >= C_MG;
        if (mg) {
#pragma unroll
            for (int ai = 0; ai < 2; ++ai)
#pragma unroll
                for (int m = 0; m < 4; ++m) { unsigned char* rowp = PG + (size_t)(row0 + ai * HALF + m * 16) * 3072 + (cl - C_MG);
#pragma unroll
                    for (int bj = 0; bj < 2; ++bj) { const f32x4 v0 = acc[ai][bj][m][0], v1 = acc[ai][bj][m][1]; u32x2 w;
                        w.x = q8(v0[0]) | (q8(v0[1]) << 8) | (q8(v0[2]) << 16) | (q8(v0[3]) << 24); w.y = q8(v1[0]) | (q8(v1[1]) << 8) | (q8(v1[2]) << 16) | (q8(v1[3]) << 24);
                        *(u32x2*)(rowp + bj * HALF) = w; } }
        } else {
#pragma unroll
            for (int ai = 0; ai < 2; ++ai)
#pragma unroll
                for (int m = 0; m < 4; ++m) { bf16_t* rowp = P + (size_t)(row0 + ai * HALF + m * 16) * PC + cl;
#pragma unroll
                    for (int bj = 0; bj < 2; ++bj) { const f32x4 v0 = acc[ai][bj][m][0], v1 = acc[ai][bj][m][1]; u32x4 w; w.x = cvt_pk_bf16(v0[0], v0[1]); w.y = cvt_pk_bf16(v0[2], v0[3]); w.z = cvt_pk_bf16(v1[0], v1[1]); w.w = cvt_pk_bf16(v1[2], v1[3]);
                        *(u32x4*)(rowp + bj * HALF) = w; } }
        }
    }
};
__device__ __forceinline__ float ub(unsigned w, int i) { return (float)((w >> (8 * i)) & 0xFFu); }
struct EpiMerge {
    static constexpr bool PERM = true, KEEP = true;
    const unsigned char* PG; bf16_t* MPRE;
    __device__ __forceinline__ void operator()(f32x4 (&acc)[2][2][4][2], const Unit& u, int wr, int wc, int fr, int fq) const {
        const int row0 = u.row0 + wr * 64 + fr, cl = u.col0 + wc * 32 + 8 * fq, seg = u.aux;
#pragma unroll
        for (int ai = 0; ai < 2; ++ai) {
            u32x2 g0[4][2], g1[4][2];
#pragma unroll
            for (int m = 0; m < 4; ++m) { const unsigned char* gp = PG + (size_t)(row0 + ai * HALF + m * 16) * 3072 + seg * 1024 + cl;
#pragma unroll
                for (int bj = 0; bj < 2; ++bj) { g0[m][bj] = *(const u32x2*)(gp + bj * HALF); g1[m][bj] = (seg < 2) ? *(const u32x2*)(gp + 1024 + bj * HALF) : (u32x2){0u, 0u}; } }
            __builtin_amdgcn_sched_barrier(0);
#pragma unroll
            for (int m = 0; m < 4; ++m) { const int row = row0 + ai * HALF + m * 16;
#pragma unroll
                for (int bj = 0; bj < 2; ++bj) {
                    float f[8];
#pragma unroll
                    for (int e = 0; e < 4; ++e) { f[e] = ub(g0[m][bj].x, e); f[4 + e] = ub(g0[m][bj].y, e); }
                    if (seg < 2) {
#pragma unroll
                        for (int e = 0; e < 4; ++e) { f[e] *= __builtin_amdgcn_rcpf(ub(g1[m][bj].x, e)); f[4 + e] *= __builtin_amdgcn_rcpf(ub(g1[m][bj].y, e)); }
                        acc[ai][bj][m][0] *= (f32x4){f[0], f[1], f[2], f[3]}; acc[ai][bj][m][1] *= (f32x4){f[4], f[5], f[6], f[7]};
                    } else {
                        const f32x4 v0 = acc[ai][bj][m][0] * (1.f / 255.f), v1 = acc[ai][bj][m][1] * (1.f / 255.f); u32x4 w;
                        w.x = cvt_pk_bf16(v0[0] * f[0], v0[1] * f[1]); w.y = cvt_pk_bf16(v0[2] * f[2], v0[3] * f[3]); w.z = cvt_pk_bf16(v1[0] * f[4], v1[1] * f[5]); w.w = cvt_pk_bf16(v1[2] * f[6], v1[3] * f[7]);
                        *(u32x4*)(MPRE + (size_t)row * DM + cl + bj * HALF) = w; }
                } }
        }
    }
};
struct EpiOut {
    static constexpr bool PERM = true, KEEP = false;
    bf16_t* D; const float* mod;
    __device__ __forceinline__ void operator()(f32x4 (&acc)[2][2][4][2], const Unit& u, int wr, int wc, int fr, int fq) const {
        const int row0 = u.row0 + wr * 64 + fr, cl = u.col0 + wc * 32 + 8 * fq;
        const float* g1 = mod + mod_row(u.row0) * 6144 + 2048 + cl;
        f32x4 gv[2][2];
#pragma unroll
        for (int bj = 0; bj < 2; ++bj)
#pragma unroll
            for (int n = 0; n < 2; ++n) gv[bj][n] = *(const f32x4*)(g1 + bj * HALF + n * 4);
#pragma unroll
        for (int ai = 0; ai < 2; ++ai)
#pragma unroll
            for (int m = 0; m < 4; ++m) { bf16_t* rowp = D + (size_t)(row0 + ai * HALF + m * 16) * DM + cl;
#pragma unroll
                for (int bj = 0; bj < 2; ++bj) { const f32x4 v0 = acc[ai][bj][m][0] * gv[bj][0], v1 = acc[ai][bj][m][1] * gv[bj][1]; u32x4 w; w.x = cvt_pk_bf16(v0[0], v0[1]); w.y = cvt_pk_bf16(v0[2], v0[3]); w.z = cvt_pk_bf16(v1[0], v1[1]); w.w = cvt_pk_bf16(v1[2], v1[3]);
                    *(u32x4*)(rowp + bj * HALF) = w; } }
    }
};
__device__ __forceinline__ float clamp8(float v) { return __builtin_amdgcn_fmed3f(v, -448.f, 448.f); }
__device__ __forceinline__ unsigned pk4_fp8(float a, float b, float c, float d) { int w = 0; a = clamp8(a); b = clamp8(b); c = clamp8(c); d = clamp8(d); w = __builtin_amdgcn_cvt_pk_fp8_f32(a, b, w, false); w = __builtin_amdgcn_cvt_pk_fp8_f32(c, d, w, true); return (unsigned)w; }
struct EpiGate8 {
    static constexpr bool PERM = true, KEEP = false;
    unsigned char* PG; float s;
    __device__ __forceinline__ void operator()(f32x4 (&acc)[2][2][4][2], const Unit& u, int wr, int wc, int fr, int fq) const {
        const int row0 = u.row0 + wr * 64 + fr, cl = u.col0 + wc * 32 + 8 * fq;
#pragma unroll
        for (int ai = 0; ai < 2; ++ai)
#pragma unroll
            for (int m = 0; m < 4; ++m) { unsigned char* rowp = PG + (size_t)(row0 + ai * HALF + m * 16) * 3072 + cl;
#pragma unroll
                for (int bj = 0; bj < 2; ++bj) { const f32x4 v0 = acc[ai][bj][m][0] * s, v1 = acc[ai][bj][m][1] * s; u32x2 w;
                    w.x = q8(v0[0]) | (q8(v0[1]) << 8) | (q8(v0[2]) << 16) | (q8(v0[3]) << 24); w.y = q8(v1[0]) | (q8(v1[1]) << 8) | (q8(v1[2]) << 16) | (q8(v1[3]) << 24);
                    *(u32x2*)(rowp + bj * HALF) = w; } }
    }
};
struct EpiGU8 {
    static constexpr bool PERM = true, KEEP = false;
    unsigned char* H; float s, hs;
    __device__ __forceinline__ void operator()(f32x4 (&acc)[2][2][4][2], const Unit& u, int wr, int wc, int fr, int fq) const {
        const int row0 = u.row0 + wr * 64 + fr, hc = (u.col0 >> 1) + wc * 32 + 8 * fq;
#pragma unroll
        for (int ai = 0; ai < 2; ++ai)
#pragma unroll
            for (int m = 0; m < 4; ++m) { const f32x4 g0 = acc[ai][0][m][0], g1 = acc[ai][0][m][1], u0 = acc[ai][1][m][0] * (s * s * hs), u1 = acc[ai][1][m][1] * (s * s * hs); u32x2 w;
                const float ne = -s * 1.4426950408889634f;
#define GU8_(g, u) ((g) * (u) * __builtin_amdgcn_rcpf(1.f + __builtin_amdgcn_exp2f((g) * ne)))
                w.x = pk4_fp8(GU8_(g0[0], u0[0]), GU8_(g0[1], u0[1]), GU8_(g0[2], u0[2]), GU8_(g0[3], u0[3]));
                w.y = pk4_fp8(GU8_(g1[0], u1[0]), GU8_(g1[1], u1[1]), GU8_(g1[2], u1[2]), GU8_(g1[3], u1[3]));
#undef GU8_
                *(u32x2*)(H + (size_t)(row0 + ai * HALF + m * 16) * FF + hc) = w; }
    }
};
struct EpiDown {
    static constexpr bool PERM = true, KEEP = false;
    bf16_t* Y; float s;
    __device__ __forceinline__ void operator()(f32x4 (&acc)[2][2][4][2], const Unit& u, int wr, int wc, int fr, int fq) const {
        const int row0 = u.row0 + wr * 64 + fr, cl = u.col0 + wc * 32 + 8 * fq;
#pragma unroll
        for (int ai = 0; ai < 2; ++ai)
#pragma unroll
            for (int m = 0; m < 4; ++m) { bf16_t* rowp = Y + (size_t)(row0 + ai * HALF + m * 16) * DM + cl;
#pragma unroll
                for (int bj = 0; bj < 2; ++bj) { const f32x4 v0 = acc[ai][bj][m][0] * s, v1 = acc[ai][bj][m][1] * s; u32x4 w; w.x = cvt_pk_bf16(v0[0], v0[1]); w.y = cvt_pk_bf16(v0[2], v0[3]); w.z = cvt_pk_bf16(v1[0], v1[1]); w.w = cvt_pk_bf16(v1[2], v1[3]);
                    *(u32x4*)(rowp + bj * HALF) = w; } }
    }
};
}

__device__ __forceinline__ void st_adaln(KP p, unsigned char* lds) {
    float* sc = (float*)lds;
    float* red = sc + 9 * 1024;
    const int tid = ltid(), wid = tid >> 6, lane = tid & 63;
    __syncthreads();
    for (int i = tid; i < 9 * 1024; i += NTHREADS) { const int r = i >> 10, k = i & 1023; const float v = r < 8 ? p->in[I_C][r * 1024 + k] : p->in[I_CCTX][k]; sc[i] = siluf(v); }
    __syncthreads();
    for (int u = lbid(); u < NL * 96; u += lgrid()) {
        const int l = u / 96, n = (u % 96) * 64 + lane;
        const float* w = p->in[I_WADA] + (size_t)l * 1024 * 6144 + n;
        float a[9];
#pragma unroll
        for (int r = 0; r < 9; ++r) a[r] = 0.f;
#pragma unroll 16
        for (int k = wid * 128; k < wid * 128 + 128; ++k) {
            const float wv = w[(size_t)k * 6144];
#pragma unroll
            for (int r = 0; r < 9; ++r) a[r] += sc[r * 1024 + k] * wv;
        }
#pragma unroll
        for (int r = 0; r < 9; ++r) red[(wid * 9 + r) * 64 + lane] = a[r];
        __syncthreads();
        for (int i = tid; i < 9 * 64; i += NTHREADS) {
            const int r = i >> 6, c = i & 63; float s = 0.f;
#pragma unroll
            for (int w8 = 0; w8 < 8; ++w8) s += red[(w8 * 9 + r) * 64 + c];
            const int nn = (u % 96) * 64 + c;
            p->MOD[((size_t)l * 9 + r) * 6144 + nn] = s + p->in[I_BADA][l * 6144 + nn];
        }
        __syncthreads();
    }
}
template <class RowMap>
__device__ __forceinline__ void cvt_tile(float* tile, const float* src, int N, int k0, int n0, bf16_t* dst, int ldd, int koff, const RowMap& rm, float scale = 1.f) {
    const int tid = ltid();
    __syncthreads();
#pragma unroll
    for (int i = 0; i < 8; ++i) { const int idx = i * NTHREADS + tid, kk = idx >> 6, nn = idx & 63; tile[kk * 65 + nn] = (n0 + nn < N) ? src[(size_t)(k0 + kk) * N + n0 + nn] * scale : 0.f; }
    __syncthreads();
    const int nn = tid >> 3, kc = tid & 7; const int dr = rm(n0 + nn);
    if (n0 + nn < N && dr >= 0) {
        u32x4 w; const float* t = tile + (kc * 8) * 65 + nn;
        w.x = pack2(t[0], t[65]); w.y = pack2(t[130], t[195]); w.z = pack2(t[260], t[325]); w.w = pack2(t[390], t[455]);
        *(u32x4*)(dst + (size_t)dr * ldd + koff + k0 + kc * 8) = w;
    }
}
template <int KT, class RowMap>
__device__ __forceinline__ void cvt_tile8(float* tile, const float* src, int N, int k0, int n0, unsigned char* dst, int ldd, const RowMap& rm, float scale) {
    const int tid = ltid();
    __syncthreads();
#pragma unroll
    for (int i = 0; i < KT / 32; ++i) { const int idx = i * NTHREADS + tid, kk = idx >> 4, n4 = (idx & 15) * 4;
        const f32x4 v = (n0 + n4 < N) ? *(const f32x4*)(src + (size_t)(k0 + kk) * N + n0 + n4) : (f32x4){0.f, 0.f, 0.f, 0.f};
        float* t = tile + kk * 65 + n4; t[0] = v[0] * scale; t[1] = v[1] * scale; t[2] = v[2] * scale; t[3] = v[3] * scale; }
    __syncthreads();
    const int nn = tid >> 3, kc = tid & 7; const int dr = (n0 + nn < N) ? rm(n0 + nn) : -1;
    if (dr >= 0) {
#pragma unroll
        for (int h = 0; h < KT / 64; ++h) { u32x2 w; const float* t = tile + (h * 64 + kc * 8) * 65 + nn;
            w.x = pg8::pk4_fp8(t[0], t[65], t[130], t[195]); w.y = pg8::pk4_fp8(t[260], t[325], t[390], t[455]);
            *(u32x2*)(dst + (size_t)dr * ldd + k0 + h * 64 + kc * 8) = w; } }
}
__device__ __forceinline__ void store_row_fp8(unsigned char* dst, const f32x4 (&x)[4], int lane, float sc) {
#pragma unroll
    for (int i = 0; i < 4; ++i) *(unsigned*)(dst + lane * 4 + 256 * i) = pg8::pk4_fp8(x[i][0] * sc, x[i][1] * sc, x[i][2] * sc, x[i][3] * sc);
}
struct MapIn  { __device__ __forceinline__ int operator()(int n) const { return n < 1536 ? n : ((n < 1568 || n >= 2080) ? -1 : n + 224); } };
struct MapInG { __device__ __forceinline__ int operator()(int n) const { return n >= 2080 ? n - 2080 : -1; } };
struct MapId  { __device__ __forceinline__ int operator()(int n) const { return n; } };
struct MapGU  { int up; __device__ __forceinline__ int operator()(int n) const { return (n >> 7) * 256 + up * 128 + (n & 127); } };
constexpr int CV_IN = 16 * 81, CV_WB = 3 * 64, CV_OUT = 256, CV_G = 16 * 128, CV_D = 16 * 128, CV_LAYER = CV_IN + CV_WB + CV_OUT + 2 * CV_G + CV_D;
__device__ __forceinline__ void st_convert(KP p, unsigned char* lds, int l_lo, int l_hi) {
    float* tile = (float*)lds;
    for (int u = l_lo * CV_LAYER + lbid(); u < l_hi * CV_LAYER; u += lgrid()) {
        const int l = u / CV_LAYER; int r = u % CV_LAYER;
        if (r < CV_IN) { const int nt_ = r % 81;
            if (nt_ <= 32) cvt_tile(tile, p->in[I_WIN] + (size_t)l * DM * INC, INC, (r / 81) * 64, nt_ * 64, p->WIN + (size_t)l * PC * DM, DM, 0, MapIn(), nt_ < 4 ? 0.125f * 1.4426950408889634f : 1.f);
            if (nt_ >= 32) cvt_tile8<64>(tile, p->in[I_WIN] + (size_t)l * DM * INC, INC, (r / 81) * 64, nt_ * 64, p->WING8 + (size_t)l * 3072 * DM, DM, MapInG(), S8_W);
            continue; }
        r -= CV_IN;
        if (r < CV_WB) { const int br = r / 64, t = r % 64; cvt_tile(tile, p->in[I_WBA + br] + (size_t)l * 256 * DM, DM, (t / 16) * 64, (t % 16) * 64, p->WB + (size_t)l * DM * 768, 768, br * 256, MapId()); continue; }
        r -= CV_WB;
        if (r < CV_OUT) { cvt_tile(tile, p->in[I_WOUT] + (size_t)l * DM * DM, DM, (r / 16) * 64, (r % 16) * 64, p->WOUT + (size_t)l * DM * DM, DM, 0, MapId()); continue; }
        r -= CV_OUT;
        if (r < 2 * CV_G) { const int up = r / CV_G, rr = r % CV_G, e = rr / 128, t = rr % 128;
            cvt_tile8<256>(tile, p->in[up ? I_WEU : I_WEG] + ((size_t)l * NE + e) * DM * FF, FF, (t / 32) * 256, (t % 32) * 64, p->WGU + ((size_t)l * NE + e) * 2 * FF * DM, DM, MapGU{up}, S8_W); continue; }
        r -= 2 * CV_G;
        { const int e = r / 128, t = r % 128; cvt_tile8<256>(tile, p->in[I_WED] + ((size_t)l * NE + e) * FF * DM, DM, (t / 16) * 256, (t % 16) * 64, p->WD + ((size_t)l * NE + e) * DM * FF, FF, MapId(), S8_W); }
    }
}
__device__ __forceinline__ void st_fold(KP p) {
    for (int i = lbid() * NTHREADS + ltid(); i < NL * 256 * DM; i += lgrid() * NTHREADS) {
        const int l = i / (256 * DM), r = i % (256 * DM), nn = r / DM, k = r % DM, dir = nn >> 7, n = nn & 127;
        const float* wi = p->in[I_WIN] + ((size_t)l * DM + k) * INC + 1536 + dir * 16;
        const float* wg = p->in[dir ? I_WGB : I_WGF] + (size_t)l * 16 * 128 + n;
        float s = 0.f;
#pragma unroll
        for (int j = 0; j < 16; ++j) s += wi[j] * wg[j * 128];
        p->WIN[((size_t)l * PC + C_G + nn) * DM + k] = f2bf(s);
    }
}
__device__ __forceinline__ void norm_mod_row(f32x4 (&x)[4], const float* g, const float* sh, const float* sc, int lane) {
    float ss = 0.f;
#pragma unroll
    for (int i = 0; i < 4; ++i) ss += x[i][0] * x[i][0] + x[i][1] * x[i][1] + x[i][2] * x[i][2] + x[i][3] * x[i][3];
    ss = wave_sum(ss);
    const float rs = rsqrtf(ss * (1.f / DM) + EPS);
#pragma unroll
    for (int i = 0; i < 4; ++i) {
        const int c = lane * 4 + 256 * i;
        const f32x4 gv = *(const f32x4*)(g + c), sv = *(const f32x4*)(sh + c), cv = *(const f32x4*)(sc + c);
        x[i] = (x[i] * rs) * gv * (cv + 1.f) + sv;
    }
}
__device__ __forceinline__ void store_row_bf16(bf16_t* dst, const f32x4 (&x)[4], int lane) {
#pragma unroll
    for (int i = 0; i < 4; ++i) { u32x2 w; w.x = pack2(x[i][0], x[i][1]); w.y = pack2(x[i][2], x[i][3]); *(u32x2*)(dst + lane * 4 + 256 * i) = w; }
}
__device__ __forceinline__ void store_row_fp8(unsigned char* dst, const f32x4 (&x)[4], int lane, float sc);
__device__ __forceinline__ void add_delta_row(f32x4 (&x)[4], const bf16_t* d, int lane) {
#pragma unroll
    for (int i = 0; i < 4; ++i) { const u32x2 w = *(const u32x2*)(d + lane * 4 + 256 * i); x[i][0] += bflo(w.x); x[i][1] += bfhi(w.x); x[i][2] += bflo(w.y); x[i][3] += bfhi(w.y); }
}
__device__ __forceinline__ void st_norm1(KP p, int l) {
    const int wid = ltid() >> 6, lane = ltid() & 63;
    const float* mod = p->MOD + (size_t)l * 9 * 6144; const float* g = p->in[I_N1G] + l * DM;
    for (int R = lbid() * 8 + wid; R < MT; R += lgrid() * 8) {
        const float* src = R < NLAT ? p->in[I_X] + (size_t)R * DM : p->in[I_CTX] + (size_t)(R - NLAT) * DM;
        f32x4 x[4];
#pragma unroll
        for (int i = 0; i < 4; ++i) { x[i] = *(const f32x4*)(src + lane * 4 + 256 * i); *(f32x4*)(p->X + (size_t)R * DM + lane * 4 + 256 * i) = x[i]; }
        const float* m = mod + mod_row(R) * 6144;
        norm_mod_row(x, g, m, m + 1024, lane);
        store_row_bf16(p->U + (size_t)R * DM, x, lane);
        store_row_fp8(p->U8W + (size_t)R * DM, x, lane, S8_U);
    }
}

__device__ __forceinline__ void st_qkrope(KP p, int l, unsigned char* lds) {
    float* tab = (float*)lds;
    const int tid = ltid(), wid = tid >> 6, lane = tid & 63;
    __syncthreads();
    for (int i = tid; i < 1024; i += NTHREADS) { const int pos = i >> 4, f = i & 15; const float inv = powf(10000.f, -(float)f / 16.f); const float a = (float)pos * inv; tab[i] = cosf(a); tab[1024 + i] = sinf(a); }
    __syncthreads();
    const float qg = p->in[I_QNG][l * 64 + lane] * (0.125f * 1.4426950408889634f), kg = p->in[I_KNG][l * 64 + lane];
    const int f = lane & 15;
    const int stride = lgrid() * 8;
    for (int R0 = lbid() * 8 + wid; R0 < MT; R0 += 2 * stride) {
        const int R1 = R0 + stride; const bool has1 = R1 < MT;
        bf16_t* p0 = p->P + (size_t)R0 * PC + C_QC + lane; bf16_t* p1 = p->P + (size_t)(has1 ? R1 : R0) * PC + C_QC + lane;
        float v0[6], v1[6];
#pragma unroll
        for (int j = 0; j < 6; ++j) { v0[j] = bf2f(p0[j * 64]); v1[j] = bf2f(p1[j * 64]); }
#pragma unroll
        for (int rr = 0; rr < 2; ++rr) {
            const int R = rr ? R1 : R0; if (rr && !has1) break;
            bf16_t* pp = rr ? p1 : p0;
#pragma unroll
            for (int j = 0; j < 6; ++j) {
                float v = rr ? v1[j] : v0[j];
                const float ss = wave_sum(v * v);
                v = v * rsqrtf(ss * (1.f / 64.f) + EPS) * (j < 4 ? qg : kg);
                if (R < NLAT) {
                    const int t = R & (TL - 1), pos = (lane < 32) ? (t >> 6) : (t & 63);
                    const float other = __shfl_xor(v, 16);
                    const float c = tab[pos * 16 + f], sn = tab[1024 + pos * 16 + f];
                    v = (lane & 16) ? (v * c + other * sn) : (v * c - other * sn);
                }
                pp[j * 64] = f2bf(v);
            }
        }
    }
}

namespace att {
typedef float f32x16 __attribute__((ext_vector_type(16)));
typedef short s16x4 __attribute__((ext_vector_type(4)));
constexpr int NSLOT = 3, SLOTB = 8192;
constexpr int LDS_K = 0, LDS_V = NSLOT * SLOTB, LDS_WS = 2 * NSLOT * SLOTB, LDS_OST = LDS_WS + 8 * 64 * 4, LDS_BIAS = LDS_OST + 8 * 4096, LDS_TOTAL = LDS_BIAS + 16 * 32 * 4;
constexpr float C2 = 0.125f * 1.4426950408889634f;
constexpr float LOG2E = 1.4426950408889634f;
constexpr float THR = 8.f;
__device__ __forceinline__ int crow(int r, int hi) { return (r & 3) + 8 * (r >> 2) + 4 * hi; }
__device__ __forceinline__ void glds16(const void* gsrc, unsigned lds_dst) { unsigned keep;
    asm volatile("s_mov_b32 %0, m0\n\ts_mov_b32 m0, %2\n\ts_nop 0\n\tglobal_load_lds_dwordx4 %1, off\n\ts_mov_b32 m0, %0" : "=&s"(keep) : "v"(gsrc), "s"(lds_dst) : "memory"); }
__device__ __forceinline__ unsigned cvtpk(float lo, float hi) { unsigned r; asm volatile("v_cvt_pk_bf16_f32 %0, %1, %2" : "=v"(r) : "v"(lo), "v"(hi)); return r; }
#define ATT_WAIT_BAR(N) asm volatile("s_waitcnt vmcnt(" #N ") lgkmcnt(0)\n\ts_barrier" ::: "memory")
__device__ __forceinline__ void qkt(f32x16& p0, f32x16& p1, const LAS unsigned char* Kslot, const bf16x8* qr, const f32x16& negm, int r32, int hi) {
    const LAS unsigned char* kb = Kslot + hi * 1024 + r32 * 16;
#pragma unroll
    for (int d0 = 0; d0 < 4; ++d0) {
        const bf16x8 b0 = *(const LAS bf16x8*)(kb + d0 * 2048);
        const bf16x8 b1 = *(const LAS bf16x8*)(kb + d0 * 2048 + 512);
        if (d0 == 0) { p0 = __builtin_amdgcn_mfma_f32_32x32x16_bf16(b0, qr[0], negm, 0, 0, 0); p1 = __builtin_amdgcn_mfma_f32_32x32x16_bf16(b1, qr[0], negm, 0, 0, 0); }
        else { p0 = __builtin_amdgcn_mfma_f32_32x32x16_bf16(b0, qr[d0], p0, 0, 0, 0); p1 = __builtin_amdgcn_mfma_f32_32x32x16_bf16(b1, qr[d0], p1, 0, 0, 0); }
    }
}
__device__ __forceinline__ float rowmax(const f32x16& p0, const f32x16& p1) {
    float a = fmaxf(fmaxf(p0[0], p0[1]), p1[0]), b = fmaxf(fmaxf(p0[2], p0[3]), p1[1]); a = fmaxf(fmaxf(a, p1[2]), p1[3]);
#pragma unroll
    for (int r = 4; r < 16; r += 4) { a = fmaxf(fmaxf(a, p0[r]), p0[r + 1]); b = fmaxf(fmaxf(b, p0[r + 2]), p0[r + 3]); a = fmaxf(fmaxf(a, p1[r]), p1[r + 1]); b = fmaxf(fmaxf(b, p1[r + 2]), p1[r + 3]); }
    const float m = fmaxf(a, b);
    auto rr = __builtin_amdgcn_permlane32_swap(__float_as_uint(m), __float_as_uint(m), false, false);
    return fmaxf(__uint_as_float(rr[0]), __uint_as_float(rr[1]));
}
__device__ __forceinline__ void pv(f32x16* o, int vb, bf16x8 pa0, bf16x8 pa1, bf16x8 pa2, bf16x8 pa3) {
#pragma unroll
    for (int d0 = 0; d0 < 2; ++d0) { s16x4 lo[4], hi[4];
#pragma unroll
        for (int ks = 0; ks < 4; ++ks) {
            asm volatile("ds_read_b64_tr_b16 %0,%1 offset:%c2" : "=&v"(lo[ks]) : "v"(vb), "i"(d0 * 4096 + ks * 1024) : "memory");
            asm volatile("ds_read_b64_tr_b16 %0,%1 offset:%c2" : "=&v"(hi[ks]) : "v"(vb), "i"(d0 * 4096 + ks * 1024 + 512) : "memory"); }
        asm volatile("s_waitcnt lgkmcnt(0)" ::: "memory"); __builtin_amdgcn_sched_barrier(0);
#define ATT_PK(k) (bf16x8){lo[k][0], lo[k][1], lo[k][2], lo[k][3], hi[k][0], hi[k][1], hi[k][2], hi[k][3]}
        o[d0] = __builtin_amdgcn_mfma_f32_32x32x16_bf16(pa0, ATT_PK(0), o[d0], 0, 0, 0);
        o[d0] = __builtin_amdgcn_mfma_f32_32x32x16_bf16(pa1, ATT_PK(1), o[d0], 0, 0, 0);
        o[d0] = __builtin_amdgcn_mfma_f32_32x32x16_bf16(pa2, ATT_PK(2), o[d0], 0, 0, 0);
        o[d0] = __builtin_amdgcn_mfma_f32_32x32x16_bf16(pa3, ATT_PK(3), o[d0], 0, 0, 0);
#undef ATT_PK
    }
}
struct Desc {
    const bf16_t* Q;
    const bf16_t* KV;
    bf16_t* O;
    int kcol, vcol;
    int NT;
    int ctx_row0;
    int lat_row0;
    int rlo;
    int qrow;
};
template <int MODE>
__device__ __forceinline__ void attn_unit(const Desc& D, LAS unsigned char* shm) {
    const int tid = ltid(), lane = tid & 63, r32 = lane & 31, hi = lane >> 5; const int wid = __builtin_amdgcn_readfirstlane(tid >> 6);
    const unsigned lds0 = (unsigned)(uintptr_t)shm;
    LAS float* wsf = (LAS float*)(shm + LDS_WS) + wid * 64;
    const bf16_t* Qw = D.Q + (size_t)(wid * 32) * PC;
    bf16x8 qr[4];
#pragma unroll
    for (int d0 = 0; d0 < 4; ++d0) qr[d0] = *(const bf16x8*)(Qw + (size_t)r32 * PC + d0 * 16 + hi * 8);
    const bf16_t* kbase = D.KV + D.kcol + wid * 8 + (size_t)lane * PC;
    const bf16_t* vbase = D.KV + D.vcol + (wid >> 2) * 32 + (lane & 3) * 8 + (size_t)(16 * (wid & 3) + (lane >> 2)) * PC;
    const unsigned kdst = lds0 + LDS_K + wid * 1024, vdst = lds0 + LDS_V + wid * 1024;
    const int NT = D.NT;
#define ATT_TROW(t) ((t) < 4 ? D.ctx_row0 + 64 * (t) : D.lat_row0 + 64 * ((t) - 4))
#define ATT_DMA(t, slotoff) do { const int t_ = (t) < NT ? (t) : NT - 1; const size_t ro_ = (size_t)ATT_TROW(t_) * PC; \
        glds16(kbase + ro_, (unsigned)__builtin_amdgcn_readfirstlane(kdst + (slotoff))); glds16(vbase + ro_, (unsigned)__builtin_amdgcn_readfirstlane(vdst + (slotoff))); } while (0)
    ATT_DMA(0, 0); ATT_DMA(1, SLOTB);
    const int vb0 = (int)(lds0 + LDS_V) + ((lane >> 4) & 1) * 32 + (lane & 3) * 8 + (4 * hi + ((lane & 15) >> 2)) * 64;
    float mhat = 0.f, l_reg = 0.f; f32x16 o[2]; o[0] = f32x16{}; o[1] = f32x16{}; f32x16 negm = f32x16{};
    const int rq = D.qrow + (wid >> 1), cq = (wid & 1) * 32 + r32;
    const int rs = min(max(rq - 4, 0), 56), cs = min(max(cq - 8, 0), 48);
    const int L0 = 4 * hi - cq + 15, L1 = 4 * hi - cs;
    const LAS float* btab = (const LAS float*)(shm + LDS_BIAS);
    int slot = 0;
    for (int t = 0; t < NT; ++t) {
        ATT_WAIT_BAR(2);
        { const int s2 = slot == 0 ? 2 * SLOTB : slot - SLOTB; ATT_DMA(t + 2, s2); }
        bool active = true; int kr = 0;
        if (MODE == 1 && t >= 4) { kr = D.rlo + (t - 4); active = (kr >= rs) && (kr < rs + 8); }
        if (active) {
            f32x16 p0, p1;
            qkt(p0, p1, shm + LDS_K + slot, qr, negm, r32, hi);
            if (MODE == 1 && t >= 4) {
                const LAS float* brow = btab + (kr - rq + 7) * 32;
#pragma unroll
                for (int r = 0; r < 16; ++r) { const int kc = (r & 3) + 8 * (r >> 2);
                    { const int ix = L0 + kc, iv = L1 + kc; const float bv = brow[min(max(ix, 0), 30)]; p0[r] = ((unsigned)iv < 16u) ? p0[r] + bv : -INFINITY; }
                    { const int ix = L0 + kc + 32, iv = L1 + kc + 32; const float bv = brow[min(max(ix, 0), 30)]; p1[r] = ((unsigned)iv < 16u) ? p1[r] + bv : -INFINITY; } }
            }
            const float rm = rowmax(p0, p1);
            bool resc = false;
            if (t == 0) { mhat = rm;
#pragma unroll
                for (int r = 0; r < 16; ++r) { p0[r] -= rm; p1[r] -= rm; negm[r] = -mhat; }
            } else if (__any(rm > THR)) { const float dl = fmaxf(rm, 0.f); mhat += dl;
#pragma unroll
                for (int r = 0; r < 16; ++r) { p0[r] -= dl; p1[r] -= dl; negm[r] = -mhat; }
                const float f = __builtin_amdgcn_exp2f(-dl); l_reg *= f; if (hi == 0) wsf[r32] = f; resc = true; }
            float sacc = 0.f;
#pragma unroll
            for (int r = 0; r < 16; ++r) { p0[r] = __builtin_amdgcn_exp2f(p0[r]); p1[r] = __builtin_amdgcn_exp2f(p1[r]); sacc += p0[r] + p1[r]; }
            l_reg += sacc;
            u32x4 pw0, pw1, pw2, pw3;
            pw0 = (u32x4){cvtpk(p0[0], p0[1]), cvtpk(p0[2], p0[3]), cvtpk(p0[4], p0[5]), cvtpk(p0[6], p0[7])};
            pw1 = (u32x4){cvtpk(p0[8], p0[9]), cvtpk(p0[10], p0[11]), cvtpk(p0[12], p0[13]), cvtpk(p0[14], p0[15])};
            pw2 = (u32x4){cvtpk(p1[0], p1[1]), cvtpk(p1[2], p1[3]), cvtpk(p1[4], p1[5]), cvtpk(p1[6], p1[7])};
            pw3 = (u32x4){cvtpk(p1[8], p1[9]), cvtpk(p1[10], p1[11]), cvtpk(p1[12], p1[13]), cvtpk(p1[14], p1[15])};
            if (resc) { asm volatile("s_waitcnt lgkmcnt(0)" ::: "memory");
#pragma unroll
                for (int r = 0; r < 16; ++r) { const float f = wsf[crow(r, hi)]; o[0][r] *= f; o[1][r] *= f; } }
            __builtin_amdgcn_sched_barrier(0);
            pv(o, vb0 + slot, __builtin_bit_cast(bf16x8, pw0), __builtin_bit_cast(bf16x8, pw1), __builtin_bit_cast(bf16x8, pw2), __builtin_bit_cast(bf16x8, pw3));
        }
        slot = slot == 2 * SLOTB ? 0 : slot + SLOTB;
    }
    { auto rr = __builtin_amdgcn_permlane32_swap(__float_as_uint(l_reg), __float_as_uint(l_reg), false, false); l_reg = __uint_as_float(rr[0]) + __uint_as_float(rr[1]); }
    if (hi == 0) wsf[32 + r32] = l_reg;
    asm volatile("s_waitcnt lgkmcnt(0)" ::: "memory");
    float rli[16];
#pragma unroll
    for (int r = 0; r < 16; ++r) rli[r] = __builtin_amdgcn_rcpf(wsf[32 + crow(r, hi)]);
    bf16_t* Ow = D.O + (size_t)(wid * 32) * 768;
    { LAS bf16_t* stg = (LAS bf16_t*)(shm + LDS_OST) + wid * 2048;
#pragma unroll
      for (int r = 0; r < 16; ++r) { const int orow = crow(r, hi);
#pragma unroll
          for (int d0 = 0; d0 < 2; ++d0) stg[orow * 64 + d0 * 32 + r32] = f2bf(o[d0][r] * rli[r]); }
      asm volatile("s_waitcnt lgkmcnt(0)" ::: "memory");
#pragma unroll
      for (int i = 0; i < 4; ++i) { const int row = i * 8 + (lane >> 3), ch = lane & 7; const u32x4 v = *(const LAS u32x4*)(stg + row * 64 + ch * 8); *(u32x4*)(Ow + (size_t)row * 768 + ch * 8) = v; } }
    asm volatile("s_waitcnt vmcnt(0) lgkmcnt(0)\n\ts_barrier" ::: "memory");
#undef ATT_TROW
#undef ATT_DMA
}
}
__device__ __forceinline__ void attn_one(KP p, int l, int u, bool na, LAS unsigned char* shm);
__device__ __forceinline__ void st_attn(KP p, int l, bool with_ctx, bool na, LAS unsigned char* shm) {
    const int tid = ltid();
    if (na) {
        asm volatile("s_waitcnt lgkmcnt(0)\n\ts_barrier" ::: "memory");
        LAS float* bt = (LAS float*)(shm + att::LDS_BIAS);
        (void)bt;
    }
    const int nlat = NB * 4 * 16, nun = nlat + (with_ctx ? NB * 4 : 0);
    for (int u = lbid(); u < nun; u += lgrid()) attn_one(p, l, u, na, shm);
}
__device__ __forceinline__ void attn_one(KP p, int l, int u, bool na, LAS unsigned char* shm) {
    const int tid = ltid(); const int nlat = NB * 4 * 16;
    {
        att::Desc D;
        const bool isc = u >= nlat; const int uu = isc ? u - nlat : u;
        const int b = isc ? uu >> 2 : uu >> 6, h = isc ? uu & 3 : (uu >> 4) & 3, qb = isc ? 0 : uu & 15;
        const int qrow0 = isc ? NLAT + b * SC : b * TL + qb * 256;
        D.ctx_row0 = NLAT + b * SC; D.NT = 4; D.lat_row0 = b * TL; D.rlo = 0; D.qrow = qb * 4;
        if (na) {
            D.Q = p->P + (size_t)qrow0 * PC + C_QA + h * 64; D.KV = p->P; D.kcol = C_KA + h * 64; D.vcol = C_VA + h * 64; D.O = p->YCAT + (size_t)qrow0 * 768 + h * 64;
            if (!isc) { const int rlo = min(max(qb * 4 - 4, 0), 56), rhi = min(max(qb * 4 - 1, 0), 56) + 7; D.rlo = rlo; D.lat_row0 = b * TL + rlo * 64; D.NT = 4 + (rhi - rlo + 1);
                LAS float* bt = (LAS float*)(shm + att::LDS_BIAS); const float* rpb = p->in[I_RPB] + ((size_t)l * 4 + h) * 15 * 31;
                if (tid < 15 * 32) { const int dr = tid >> 5, dc = tid & 31; bt[tid] = dc < 31 ? rpb[dr * 31 + dc] * att::LOG2E : 0.f; }
                asm volatile("s_waitcnt lgkmcnt(0)\n\ts_barrier" ::: "memory");
                att::attn_unit<1>(D, shm);
            } else att::attn_unit<0>(D, shm);
        } else {
            const int kvh = h >> 1;
            D.Q = p->P + (size_t)qrow0 * PC + C_QC + h * 64; D.KV = p->P; D.kcol = C_KC + kvh * 64; D.vcol = C_VC + kvh * 64; D.O = p->YCAT + (size_t)qrow0 * 768 + 512 + h * 64;
            if (!isc) D.NT = 68;
            att::attn_unit<0>(D, shm);
        }
    }
}

__device__ __forceinline__ int gla_row(int b, int c, int j) { return c < 4 ? NLAT + b * SC + c * 64 + j : b * TL + (c - 4) * 64 + j; }
namespace gla {
constexpr int G_OFF = 0, KT_OFF = 65536, VTS_OFF = 65536 + 36864, QD_OFF = 65536, KI_OFF = 65536 + 40960, VTO_OFF = 0, X_OFF = 65536, LDS_TOTAL = 65536 + 81920;
typedef short s16x4 __attribute__((ext_vector_type(4)));
__device__ __forceinline__ f32x4 mfma16(bf16x8 a, bf16x8 b, f32x4 c) { return __builtin_amdgcn_mfma_f32_16x16x32_bf16(a, b, c, 0, 0, 0); }
__device__ __forceinline__ void gates_cumsum(KP p, int l, int b, int c, LAS unsigned char* shm, int tid) {
    LAS float* Gs = (LAS float*)(shm + G_OFF);
    { const int j = tid >> 3, part = tid & 7; const bf16_t* src = p->P + (size_t)gla_row(b, c, j) * PC + C_G + part * 32;
      const float* bias = (part < 4 ? p->in[I_BGF] + l * 128 + part * 32 : p->in[I_BGB] + l * 128 + (part - 4) * 32);
#pragma unroll
      for (int q = 0; q < 4; ++q) { const u32x4 w = *(const u32x4*)(src + q * 8); const f32x4 b0 = *(const f32x4*)(bias + q * 8), b1 = *(const f32x4*)(bias + q * 8 + 4);
          LAS float* d = Gs + j * 256 + part * 32 + q * 8;
          *(LAS f32x4*)d = (f32x4){logsig16(bflo(w.x) + b0[0]), logsig16(bfhi(w.x) + b0[1]), logsig16(bflo(w.y) + b0[2]), logsig16(bfhi(w.y) + b0[3])};
          *(LAS f32x4*)(d + 4) = (f32x4){logsig16(bflo(w.z) + b1[0]), logsig16(bfhi(w.z) + b1[1]), logsig16(bflo(w.w) + b1[2]), logsig16(bfhi(w.w) + b1[3])}; } }
    __syncthreads();
    if (tid < 256) {
        float v[64];
#pragma unroll
        for (int j = 0; j < 64; ++j) v[j] = Gs[j * 256 + tid];
        if (tid < 128) {
#pragma unroll
            for (int j = 1; j < 64; ++j) v[j] += v[j - 1];
        } else {
#pragma unroll
            for (int j = 62; j >= 0; --j) v[j] += v[j + 1];
        }
#pragma unroll
        for (int j = 0; j < 64; ++j) Gs[j * 256 + tid] = v[j];
    }
    __syncthreads();
}
__device__ __forceinline__ void build_vt(KP p, int b, int c, LAS unsigned char* vt, int tid) {
    const int j = tid & 63, w = tid >> 6; const bf16_t* src = p->P + (size_t)gla_row(b, c, j) * PC + C_VB + w * 32;
    LAS bf16_t* dst = (LAS bf16_t*)(vt + (w >> 1) * 9216 + ((w & 1) * 32) * 144) + j;
#pragma unroll
    for (int q = 0; q < 4; ++q) { const u32x4 x = *(const u32x4*)(src + q * 8);
        dst[(q * 8 + 0) * 72] = (bf16_t)(x.x & 0xFFFF); dst[(q * 8 + 1) * 72] = (bf16_t)(x.x >> 16); dst[(q * 8 + 2) * 72] = (bf16_t)(x.y & 0xFFFF); dst[(q * 8 + 3) * 72] = (bf16_t)(x.y >> 16);
        dst[(q * 8 + 4) * 72] = (bf16_t)(x.z & 0xFFFF); dst[(q * 8 + 5) * 72] = (bf16_t)(x.z >> 16); dst[(q * 8 + 6) * 72] = (bf16_t)(x.w & 0xFFFF); dst[(q * 8 + 7) * 72] = (bf16_t)(x.w >> 16); }
}
}
__device__ __forceinline__ void gla_states_one(KP p, int l, int u, LAS unsigned char* shm);
__device__ __forceinline__ void st_gla_states2(KP p, int l, LAS unsigned char* shm) {
    const int tid = ltid(), lane = tid & 63, l15 = lane & 15, kg = lane >> 4; const int w = __builtin_amdgcn_readfirstlane(tid >> 6);
    LAS float* Gs = (LAS float*)(shm + gla::G_OFF);
    for (int u = lbid(); u < NB * NCH; u += lgrid()) gla_states_one(p, l, u, shm);
    __syncthreads();
}
__device__ __forceinline__ void gla_states_one(KP p, int l, int u, LAS unsigned char* shm) {
    const int tid = ltid(), lane = tid & 63, l15 = lane & 15, kg = lane >> 4; const int w = __builtin_amdgcn_readfirstlane(tid >> 6);
    LAS float* Gs = (LAS float*)(shm + gla::G_OFF);
    {
        const int b = u / NCH, c = u % NCH;
        __syncthreads();
        gla::gates_cumsum(p, l, b, c, shm, tid);
        {
          const int dir = w >> 2, h = w & 3, j = lane; const bf16_t* src = p->P + (size_t)gla_row(b, c, j) * PC + C_KB + h * 32;
          LAS bf16_t* dst = (LAS bf16_t*)(shm + gla::KT_OFF + w * 4608) + j;
          const LAS float* gb = Gs + j * 256 + dir * 128 + h * 32; const LAS float* gl = Gs + (dir ? 0 : 63) * 256 + dir * 128 + h * 32;
#pragma unroll
          for (int q = 0; q < 4; ++q) { const u32x4 x = *(const u32x4*)(src + q * 8); const unsigned xs[4] = {x.x, x.y, x.z, x.w};
#pragma unroll
              for (int e = 0; e < 8; ++e) { const int kk = q * 8 + e; const float kv = (e & 1) ? bfhi(xs[e >> 1]) : bflo(xs[e >> 1]);
                  dst[kk * 72] = f2bf(kv * __expf(gl[kk] - gb[kk])); } } }
        gla::build_vt(p, b, c, shm + gla::VTS_OFF, tid);
        if (tid < 256) { const int dir = tid >> 7, h = (tid >> 5) & 3, kk = tid & 31; p->DEC[((((size_t)b * 2 + dir) * NCH + c) * 4 + h) * 32 + kk] = __expf(Gs[(dir ? 0 : 63) * 256 + tid]); }
        __syncthreads();
        { const int dir = w >> 2, h = w & 3;
          const LAS unsigned char* vt = shm + gla::VTS_OFF + h * 9216; const LAS unsigned char* kt = shm + gla::KT_OFF + w * 4608;
          float* dst = p->DST + ((((size_t)b * 2 + dir) * NCH + c) * 4 + h) * 2048;
#pragma unroll
          for (int ki = 0; ki < 2; ++ki) { const bf16x8 kb0 = *(const LAS bf16x8*)(kt + (ki * 16 + l15) * 144 + kg * 16), kb1 = *(const LAS bf16x8*)(kt + (ki * 16 + l15) * 144 + 64 + kg * 16);
#pragma unroll
              for (int vi = 0; vi < 4; ++vi) { const bf16x8 va0 = *(const LAS bf16x8*)(vt + (vi * 16 + l15) * 144 + kg * 16), va1 = *(const LAS bf16x8*)(vt + (vi * 16 + l15) * 144 + 64 + kg * 16);
                  f32x4 acc = (f32x4){0.f, 0.f, 0.f, 0.f}; acc = gla::mfma16(va0, kb0, acc); acc = gla::mfma16(va1, kb1, acc);
                  *(f32x4*)(dst + (ki * 16 + l15) * 64 + vi * 16 + 4 * kg) = acc; } } }
    }
    __syncthreads();
}
__device__ __forceinline__ void st_gla_scan2(KP p) {
    for (int i = lbid() * NTHREADS + ltid(); i < NB * 2 * 4 * 2048; i += lgrid() * NTHREADS) {
        const int e = i & 2047, h = (i >> 11) & 3, dir = (i >> 13) & 1, b = i >> 14, kk = e >> 6;
        float s = 0.f;
#pragma unroll 1
        for (int n0 = 0; n0 < NCH; n0 += 17) {
            float d[17], dc[17]; size_t base[17];
#pragma unroll
            for (int q = 0; q < 17; ++q) { const int n = n0 + q; const int c = dir == 0 ? n : (n < 4 ? 3 - n : 71 - n);
                base[q] = (((size_t)b * 2 + dir) * NCH + c) * 4 + h; d[q] = p->DST[base[q] * 2048 + e]; dc[q] = p->DEC[base[q] * 32 + kk]; }
#pragma unroll
            for (int q = 0; q < 17; ++q) { p->ST[base[q] * 2048 + e] = f2bf(s); s = dc[q] * s + d[q]; }
        }
    }
}
__device__ __forceinline__ void st_gla_out2(KP p, int l, bool with_ctx, LAS unsigned char* shm) {
    const int tid = ltid(), lane = tid & 63, l15 = lane & 15, kg = lane >> 4; const int w = __builtin_amdgcn_readfirstlane(tid >> 6);
    LAS float* Gs = (LAS float*)(shm + gla::G_OFF);
    const float qs = 0.17677669529663687f;
    for (int u = lbid(); u < NB * NCH; u += lgrid()) {
        const int b = u / NCH, c = u % NCH;
        if (!with_ctx && c < 4) continue;
        __syncthreads();
        gla::gates_cumsum(p, l, b, c, shm, tid);
        {
          const int j = tid >> 3, part = tid & 7, h = part >> 1, kk0 = (part & 1) * 16; const size_t ro = (size_t)gla_row(b, c, j) * PC;
          const u32x4 q0 = *(const u32x4*)(p->P + ro + C_QB + part * 16), q1 = *(const u32x4*)(p->P + ro + C_QB + part * 16 + 8);
          const u32x4 k0 = *(const u32x4*)(p->P + ro + C_KB + part * 16), k1 = *(const u32x4*)(p->P + ro + C_KB + part * 16 + 8);
          const unsigned qx[8] = {q0.x, q0.y, q0.z, q0.w, q1.x, q1.y, q1.z, q1.w}, kx[8] = {k0.x, k0.y, k0.z, k0.w, k1.x, k1.y, k1.z, k1.w};
#pragma unroll
          for (int dir = 0; dir < 2; ++dir) { const LAS float* gb = Gs + j * 256 + dir * 128 + part * 16; unsigned qo[8], ko[8];
#pragma unroll
              for (int e = 0; e < 8; ++e) { const float g0 = gb[2 * e], g1 = gb[2 * e + 1];
                  qo[e] = pack2(bflo(qx[e]) * qs * __expf(g0), bfhi(qx[e]) * qs * __expf(g1)); ko[e] = pack2(bflo(kx[e]) * __expf(-g0), bfhi(kx[e]) * __expf(-g1)); }
              LAS unsigned char* qd = shm + gla::QD_OFF + (dir * 4 + h) * 5120 + j * 80 + kk0 * 2; LAS unsigned char* ki = shm + gla::KI_OFF + (dir * 4 + h) * 5120 + j * 80 + kk0 * 2;
              *(LAS u32x4*)qd = (u32x4){qo[0], qo[1], qo[2], qo[3]}; *(LAS u32x4*)(qd + 16) = (u32x4){qo[4], qo[5], qo[6], qo[7]};
              *(LAS u32x4*)ki = (u32x4){ko[0], ko[1], ko[2], ko[3]}; *(LAS u32x4*)(ki + 16) = (u32x4){ko[4], ko[5], ko[6], ko[7]}; } }
        __syncthreads();
        gla::build_vt(p, b, c, shm + gla::VTO_OFF, tid);
        __syncthreads();
        const int dir = w >> 2, h = w & 3;
        f32x4 acc[4][4];
#pragma unroll
        for (int ti = 0; ti < 4; ++ti)
#pragma unroll
            for (int vi = 0; vi < 4; ++vi) acc[ti][vi] = (f32x4){0.f, 0.f, 0.f, 0.f};
        { const LAS unsigned char* qd = shm + gla::QD_OFF + w * 5120; const LAS unsigned char* ki = shm + gla::KI_OFF + w * 5120; const LAS unsigned char* vt = shm + gla::VTO_OFF + h * 9216;
          const bf16_t* st = p->ST + ((((size_t)b * 2 + dir) * NCH + c) * 4 + h) * 2048;
          bf16x8 sfr[4];
#pragma unroll
          for (int vi = 0; vi < 4; ++vi) {
#pragma unroll
              for (int j = 0; j < 8; ++j) sfr[vi][j] = (short)st[(kg * 8 + j) * 64 + vi * 16 + l15]; }
#pragma unroll
          for (int ti = 0; ti < 4; ++ti) {
              const bf16x8 qf = *(const LAS bf16x8*)(qd + (ti * 16 + l15) * 80 + kg * 16);
              const int ig = ti * 16 + l15;
              unsigned pk[4][2];
#pragma unroll
              for (int tj = 0; tj < 4; ++tj) {
                  const bf16x8 kf = *(const LAS bf16x8*)(ki + (tj * 16 + l15) * 80 + kg * 16);
                  f32x4 a2 = gla::mfma16(kf, qf, (f32x4){0.f, 0.f, 0.f, 0.f});
#pragma unroll
                  for (int jj = 0; jj < 4; ++jj) { const int jg = tj * 16 + 4 * kg + jj; const bool ok = dir == 0 ? (jg <= ig) : (jg >= ig); a2[jj] = ok ? a2[jj] : 0.f; }
                  pk[tj][0] = pack2(a2[0], a2[1]); pk[tj][1] = pack2(a2[2], a2[3]);
              }
#pragma unroll
              for (int s2 = 0; s2 < 2; ++s2) {
                  const u32x4 bw = (u32x4){pk[2 * s2][0], pk[2 * s2][1], pk[2 * s2 + 1][0], pk[2 * s2 + 1][1]}; const bf16x8 bfr = __builtin_bit_cast(bf16x8, bw);
#pragma unroll
                  for (int vi = 0; vi < 4; ++vi) {
                      const LAS unsigned char* vr = vt + (vi * 16 + l15) * 144 + kg * 8;
                      const u32x2 lo = *(const LAS u32x2*)(vr + (2 * s2) * 32), hi2 = *(const LAS u32x2*)(vr + (2 * s2 + 1) * 32);
                      const u32x4 aw = (u32x4){lo.x, lo.y, hi2.x, hi2.y};
                      acc[ti][vi] = gla::mfma16(__builtin_bit_cast(bf16x8, aw), bfr, acc[ti][vi]);
                  }
              }
#pragma unroll
              for (int vi = 0; vi < 4; ++vi) acc[ti][vi] = gla::mfma16(sfr[vi], qf, acc[ti][vi]);
          } }
        __syncthreads();
        { LAS f32x4* xo = (LAS f32x4*)(shm + gla::X_OFF + w * 8192);
#pragma unroll
          for (int t2 = 0; t2 < 2; ++t2)
#pragma unroll
              for (int vi = 0; vi < 4; ++vi) xo[(t2 * 4 + vi) * 64 + lane] = dir == 0 ? acc[2 + t2][vi] : acc[t2][vi]; }
        __syncthreads();
        { const LAS f32x4* xi = (const LAS f32x4*)(shm + gla::X_OFF + (w ^ 4) * 8192);
          const float* gg = p->in[I_GLAG] + l * 64;
#pragma unroll
          for (int t2 = 0; t2 < 2; ++t2) {
              f32x4 o[4]; float ss = 0.f;
#pragma unroll
              for (int vi = 0; vi < 4; ++vi) { o[vi] = (dir == 0 ? acc[t2][vi] : acc[2 + t2][vi]) + xi[(t2 * 4 + vi) * 64 + lane]; ss += o[vi][0] * o[vi][0] + o[vi][1] * o[vi][1] + o[vi][2] * o[vi][2] + o[vi][3] * o[vi][3]; }
              ss += __shfl_xor(ss, 16); ss += __shfl_xor(ss, 32);
              const float rs = rsqrtf(ss * (1.f / 64.f) + EPS);
              const int R = gla_row(b, c, (dir * 2 + t2) * 16 + l15);
#pragma unroll
              for (int vi = 0; vi < 4; ++vi) { const int col = h * 64 + vi * 16 + 4 * kg; const u32x2 rw = *(const u32x2*)(p->P + (size_t)R * PC + C_RB + col); const f32x4 gv = *(const f32x4*)(gg + vi * 16 + 4 * kg);
                  u32x2 yw; yw.x = pack2(o[vi][0] * rs * gv[0] * siluf(bflo(rw.x)), o[vi][1] * rs * gv[1] * siluf(bfhi(rw.x))); yw.y = pack2(o[vi][2] * rs * gv[2] * siluf(bflo(rw.y)), o[vi][3] * rs * gv[3] * siluf(bfhi(rw.y)));
                  *(u32x2*)(p->YCAT + (size_t)R * 768 + 256 + col) = yw; }
          } }
    }
    __syncthreads();
}

__device__ __forceinline__ void st_norm2_router(KP p, int l, bool with_ctx, unsigned char* lds) {
    float* W2 = (float*)lds;
    const int tid = ltid(), wid = tid >> 6, lane = tid & 63;
    __syncthreads();
    for (int i_ = tid; i_ < DM * NE; i_ += NTHREADS) { const int col = i_ >> 4, e = i_ & 15, ln = (col & 255) >> 2, q = col & 3, i = col >> 8;
        W2[(((i * 4 + q) * 64) + ln) * 20 + e] = p->in[I_WR][(size_t)l * DM * NE + i_]; }
    __syncthreads();
    const float* mod = p->MOD + (size_t)l * 9 * 6144; const float* g = p->in[I_N2G] + l * DM;
    const int nrows = with_ctx ? MT : NLAT, stride = lgrid() * 8;
    const bool b5 = lane & 32, b4 = lane & 16, b3 = lane & 8, b2 = lane & 4;
    const int my_e = (b5 ? 8 : 0) + (b4 ? 4 : 0) + (b3 ? 2 : 0) + (b2 ? 1 : 0);
    for (int R0 = lbid() * 8 + wid; R0 < nrows; R0 += 2 * stride) {
        const int R1 = R0 + stride; const bool has1 = R1 < nrows; const int R1c = has1 ? R1 : R0;
        f32x4 x0[4], x1[4];
#pragma unroll
        for (int i = 0; i < 4; ++i) { x0[i] = *(const f32x4*)(p->X + (size_t)R0 * DM + lane * 4 + 256 * i); x1[i] = *(const f32x4*)(p->X + (size_t)R1c * DM + lane * 4 + 256 * i); }
        add_delta_row(x0, p->DLT + (size_t)R0 * DM, lane); add_delta_row(x1, p->DLT + (size_t)R1c * DM, lane);
        const float* m0 = mod + mod_row(R0) * 6144; const float* m1 = mod + mod_row(R1c) * 6144;
        float ss0 = 0.f, ss1 = 0.f;
#pragma unroll
        for (int i = 0; i < 4; ++i) { ss0 += x0[i][0] * x0[i][0] + x0[i][1] * x0[i][1] + x0[i][2] * x0[i][2] + x0[i][3] * x0[i][3]; ss1 += x1[i][0] * x1[i][0] + x1[i][1] * x1[i][1] + x1[i][2] * x1[i][2] + x1[i][3] * x1[i][3]; }
#pragma unroll
        for (int o = 32; o > 0; o >>= 1) { ss0 += __shfl_xor(ss0, o); ss1 += __shfl_xor(ss1, o); }
        const float rs0 = rsqrtf(ss0 * (1.f / DM) + EPS), rs1 = rsqrtf(ss1 * (1.f / DM) + EPS);
#pragma unroll
        for (int i = 0; i < 4; ++i) {
            const int c = lane * 4 + 256 * i; const f32x4 gv = *(const f32x4*)(g + c);
            x0[i] = (x0[i] * rs0) * gv * (*(const f32x4*)(m0 + 4096 + c) + 1.f) + *(const f32x4*)(m0 + 3072 + c);
            x1[i] = (x1[i] * rs1) * gv * (*(const f32x4*)(m1 + 4096 + c) + 1.f) + *(const f32x4*)(m1 + 3072 + c);
        }
        store_row_fp8((unsigned char*)p->U + (size_t)R0 * DM, x0, lane, S8_X);
        if (has1) store_row_fp8((unsigned char*)p->U + (size_t)R1 * DM, x1, lane, S8_X);
        f32x4 a0[4], a1[4];
#pragma unroll
        for (int j = 0; j < 4; ++j) { a0[j] = (f32x4){0.f, 0.f, 0.f, 0.f}; a1[j] = (f32x4){0.f, 0.f, 0.f, 0.f}; }
#pragma unroll
        for (int i = 0; i < 4; ++i)
#pragma unroll
            for (int q = 0; q < 4; ++q) { const f32x4* wv = (const f32x4*)(W2 + (((i * 4 + q) * 64) + lane) * 20); const float xa = x0[i][q], xb = x1[i][q];
#pragma unroll
                for (int j = 0; j < 4; ++j) { const f32x4 w4 = wv[j]; a0[j] += w4 * xa; a1[j] += w4 * xb; }
                if (q & 1) __builtin_amdgcn_sched_barrier(0); }
        float l0, l1;
        { float u0[8], u1[8];
#pragma unroll
          for (int k = 0; k < 8; ++k) { const float k0 = a0[k >> 2][k & 3], h0 = a0[2 + (k >> 2)][k & 3], k1 = a1[k >> 2][k & 3], h1 = a1[2 + (k >> 2)][k & 3];
              u0[k] = (b5 ? h0 : k0) + __shfl_xor(b5 ? k0 : h0, 32); u1[k] = (b5 ? h1 : k1) + __shfl_xor(b5 ? k1 : h1, 32); }
          float v0[4], v1[4];
#pragma unroll
          for (int k = 0; k < 4; ++k) { v0[k] = (b4 ? u0[4 + k] : u0[k]) + __shfl_xor(b4 ? u0[k] : u0[4 + k], 16); v1[k] = (b4 ? u1[4 + k] : u1[k]) + __shfl_xor(b4 ? u1[k] : u1[4 + k], 16); }
          float w0[2], w1[2];
#pragma unroll
          for (int k = 0; k < 2; ++k) { w0[k] = (b3 ? v0[2 + k] : v0[k]) + __shfl_xor(b3 ? v0[k] : v0[2 + k], 8); w1[k] = (b3 ? v1[2 + k] : v1[k]) + __shfl_xor(b3 ? v1[k] : v1[2 + k], 8); }
          l0 = (b2 ? w0[1] : w0[0]) + __shfl_xor(b2 ? w0[0] : w0[1], 4); l1 = (b2 ? w1[1] : w1[0]) + __shfl_xor(b2 ? w1[0] : w1[1], 4);
          l0 += __shfl_xor(l0, 2); l1 += __shfl_xor(l1, 2); l0 += __shfl_xor(l0, 1); l1 += __shfl_xor(l1, 1); }
        float mx0 = l0, mx1 = l1;
#pragma unroll
        for (int o = 32; o >= 4; o >>= 1) { mx0 = fmaxf(mx0, __shfl_xor(mx0, o)); mx1 = fmaxf(mx1, __shfl_xor(mx1, o)); }
        const float ex0 = expf(l0 - mx0), ex1 = expf(l1 - mx1); float s0 = ex0, s1 = ex1;
#pragma unroll
        for (int o = 32; o >= 4; o >>= 1) { s0 += __shfl_xor(s0, o); s1 += __shfl_xor(s1, o); }
        if ((lane & 3) == 0) { p->AFF[(size_t)R0 * 16 + my_e] = ex0 / s0; if (has1) p->AFF[(size_t)R1 * 16 + my_e] = ex1 / s1; }
    }
}

__device__ __forceinline__ int block_sum_i(int v, int* red, int tid) {
    const int lane = tid & 63, wid = tid >> 6;
#pragma unroll
    for (int o = 32; o > 0; o >>= 1) v += __shfl_xor(v, o);
    __syncthreads();
    if (lane == 0) red[wid] = v;
    __syncthreads();
    int s = 0;
#pragma unroll
    for (int w = 0; w < 8; ++w) s += red[w];
    return s;
}
__device__ __forceinline__ int block_excl_scan_i(int v, int* red, int tid) {
    const int lane = tid & 63, wid = tid >> 6;
    int inc = v;
#pragma unroll
    for (int o = 1; o < 64; o <<= 1) { const int t = __shfl_up(inc, o); if (lane >= o) inc += t; }
    __syncthreads();
    if (lane == 63) red[wid] = inc;
    __syncthreads();
    int base = 0;
#pragma unroll
    for (int w = 0; w < 8; ++w) base += (w < wid) ? red[w] : 0;
    return base + inc - v;
}
__device__ __forceinline__ void st_topk(KP p, bool with_ctx, unsigned char* lds) {
    int* red = (int*)lds;
    const int tid = ltid();
    const int nun = NB * NE * (with_ctx ? 2 : 1);
    for (int u = lbid(); u < nun; u += lgrid()) {
        const int grp = u / (NB * NE), b = (u / NE) % NB, e = u % NE;
        const int n = grp ? SC : TL, cap = grp ? CAPC : CAPL, per = grp ? 1 : 8;
        const int rowbase = grp ? NLAT + b * SC : b * TL;
        unsigned key[8];
#pragma unroll
        for (int i = 0; i < 8; ++i) { const int t = tid * per + i; key[i] = (i < per && t < n) ? __float_as_uint(p->AFF[(size_t)(rowbase + t) * 16 + e]) : 0u; }
        unsigned prefix = 0u;
        { const int lane_ = tid & 63, wid_ = tid >> 6; int* rq = red + 16;
          __syncthreads();
          for (int step = 0; step < 16; ++step) {
              const int bit = step == 0 ? 30 : 30 - 2 * step;
              const unsigned c1 = prefix | (1u << bit), c2 = step == 0 ? 0xFFFFFFFFu : prefix | (2u << bit), c3 = step == 0 ? 0xFFFFFFFFu : prefix | (3u << bit);
              int a = 0, b3 = 0;
#pragma unroll
              for (int i = 0; i < 8; ++i) { a += (key[i] >= c1 ? 1 : 0) + (key[i] >= c2 ? 65536 : 0); b3 += key[i] >= c3 ? 1 : 0; }
#pragma unroll
              for (int o = 32; o > 0; o >>= 1) { a += __shfl_xor(a, o); b3 += __shfl_xor(b3, o); }
              int* slot = rq + (step & 1) * 16;
              if (lane_ == 0) { slot[wid_ * 2] = a; slot[wid_ * 2 + 1] = b3; }
              __syncthreads();
              int sa = 0, sb = 0;
#pragma unroll
              for (int w8 = 0; w8 < 8; ++w8) { sa += slot[w8 * 2]; sb += slot[w8 * 2 + 1]; }
              const int n1 = sa & 0xFFFF, n2 = sa >> 16, n3 = sb;
              prefix = (n3 >= cap) ? c3 : (n2 >= cap) ? c2 : (n1 >= cap) ? c1 : prefix;
          } }
        int ngt = 0, neq = 0;
#pragma unroll
        for (int i = 0; i < 8; ++i) { ngt += key[i] > prefix ? 1 : 0; neq += (key[i] == prefix && key[i] != 0u) ? 1 : 0; }
        const int need = cap - block_sum_i(ngt, red, tid);
        int eqbase = block_excl_scan_i(neq, red, tid);
        int sel[8]; int nsel = 0;
#pragma unroll
        for (int i = 0; i < 8; ++i) { const bool eq = key[i] == prefix && key[i] != 0u; sel[i] = (key[i] > prefix || (eq && eqbase < need)) ? 1 : 0; eqbase += eq ? 1 : 0; nsel += sel[i]; }
        int slot = block_excl_scan_i(nsel, red, tid);
        const int ebase = e * EROWS + (grp ? NB * CAPL + b * CAPC : b * CAPL);
#pragma unroll
        for (int i = 0; i < 8; ++i) { const int t = tid * per + i;
            if (i < per && t < n) { const int R = rowbase + t;
                if (sel[i]) { const int er = ebase + slot; p->SRCROW[er] = R; p->VAL[er] = __uint_as_float(key[i]); p->SLOTOF[(size_t)R * 16 + e] = er; ++slot; }
                else p->SLOTOF[(size_t)R * 16 + e] = -1; } }
        __syncthreads();
    }
}
__device__ __forceinline__ void st_combine(KP p, int l, bool with_ctx) {
    const int wid = ltid() >> 6, lane = ltid() & 63;
    const float* mod = p->MOD + (size_t)l * 9 * 6144;
    const int nrows = with_ctx ? MT : NLAT, stride = lgrid() * 8;
    int R = lbid() * 8 + wid;
    int so_n = -1; float sv_n = 0.f; f32x4 x_n[4];
    if (R < nrows) {
        so_n = p->SLOTOF[(size_t)R * 16 + (lane & 15)]; sv_n = so_n >= 0 ? p->VAL[so_n] : 0.f;
#pragma unroll
        for (int i = 0; i < 4; ++i) x_n[i] = *(const f32x4*)(p->X + (size_t)R * DM + lane * 4 + 256 * i);
        add_delta_row(x_n, p->DLT + (size_t)R * DM, lane);
    }
    for (; R < nrows; R += stride) {
        const int so = so_n; const float sv = sv_n; f32x4 x[4];
#pragma unroll
        for (int i = 0; i < 4; ++i) x[i] = x_n[i];
        const int Rn = R + stride;
        if (Rn < nrows) {
            so_n = p->SLOTOF[(size_t)Rn * 16 + (lane & 15)]; sv_n = so_n >= 0 ? p->VAL[so_n] : 0.f;
#pragma unroll
            for (int i = 0; i < 4; ++i) x_n[i] = *(const f32x4*)(p->X + (size_t)Rn * DM + lane * 4 + 256 * i);
            add_delta_row(x_n, p->DLT + (size_t)Rn * DM, lane);
        }
        unsigned mask = (unsigned)(__ballot(so >= 0) & 0xFFFFull);
        f32x4 a[4];
#pragma unroll
        for (int i = 0; i < 4; ++i) a[i] = (f32x4){0.f, 0.f, 0.f, 0.f};
        while (mask) {
            const int e0 = __builtin_ctz(mask); mask &= mask - 1;
            const bool two = mask != 0; const int e1 = two ? __builtin_ctz(mask) : e0; if (two) mask &= mask - 1;
            const int er0 = __shfl(so, e0), er1 = __shfl(so, e1); const float v0 = __shfl(sv, e0), v1 = two ? __shfl(sv, e1) : 0.f;
            const bf16_t* y0 = p->Y + (size_t)er0 * DM + lane * 4; const bf16_t* y1 = p->Y + (size_t)er1 * DM + lane * 4;
            u32x2 w0[4], w1[4];
#pragma unroll
            for (int i = 0; i < 4; ++i) { w0[i] = *(const u32x2*)(y0 + 256 * i); w1[i] = *(const u32x2*)(y1 + 256 * i); }
#pragma unroll
            for (int i = 0; i < 4; ++i) { a[i][0] += v0 * bflo(w0[i].x) + v1 * bflo(w1[i].x); a[i][1] += v0 * bfhi(w0[i].x) + v1 * bfhi(w1[i].x); a[i][2] += v0 * bflo(w0[i].y) + v1 * bflo(w1[i].y); a[i][3] += v0 * bfhi(w0[i].y) + v1 * bfhi(w1[i].y); }
        }
        const float* m = mod + mod_row(R) * 6144;
#pragma unroll
        for (int i = 0; i < 4; ++i) { const int c = lane * 4 + 256 * i; x[i] += *(const f32x4*)(m + 5120 + c) * a[i]; }
        if (l + 1 < NL) {
#pragma unroll
            for (int i = 0; i < 4; ++i) *(f32x4*)(p->X + (size_t)R * DM + lane * 4 + 256 * i) = x[i];
            const float* m2 = p->MOD + (size_t)(l + 1) * 9 * 6144 + mod_row(R) * 6144;
            norm_mod_row(x, p->in[I_N1G] + (l + 1) * DM, m2, m2 + 1024, lane);
            store_row_bf16(p->U + (size_t)R * DM, x, lane);
            store_row_fp8(p->U8W + (size_t)R * DM, x, lane, S8_U);
        } else {
            float ss = 0.f;
#pragma unroll
            for (int i = 0; i < 4; ++i) ss += x[i][0] * x[i][0] + x[i][1] * x[i][1] + x[i][2] * x[i][2] + x[i][3] * x[i][3];
            ss = wave_sum(ss); const float rs = rsqrtf(ss * (1.f / DM) + EPS);
#pragma unroll
            for (int i = 0; i < 4; ++i) { const int c = lane * 4 + 256 * i; *(f32x4*)(p->out + (size_t)R * DM + c) = x[i] * rs * *(const f32x4*)(p->in[I_FNG] + c); }
        }
    }
}

constexpr int LDS_BYTES = 160 * 1024;
#define PHASE_BEGIN { KP p = kparams(); LAS unsigned char* lds3 = llds3(lds0); unsigned char* lds = (unsigned char*)lds3; const int G = lgrid(), c0_ = lbid(), c = (G % 8 == 0) ? (c0_ % 8) * (G / 8) + c0_ / 8 : c0_;     (void)p; (void)lds; (void)lds3; (void)G; (void)c;
#define PHASE_END   xcd_barrier(bar); }
#ifndef DUPMASK
#define DUPMASK 0
#endif
#define RUN(bit, ...) do { __VA_ARGS__; if ((DUPMASK >> (bit)) & 1) { xcd_barrier(bar); __VA_ARGS__; } } while (0)
__global__ void __launch_bounds__(NTHREADS, 2) fwd(Params p_unused) {
    extern __shared__ __attribute__((aligned(16))) unsigned char lds_raw[];
    LAS unsigned char* lds0 = (LAS unsigned char*)lds_raw + 16;
    volatile LAS unsigned* xbw = (volatile LAS unsigned*)lds_raw;
    if (threadIdx.x == 0) { xbw[0] = 0u; xbw[1] = 0u; xbw[2] = 0u; xbw[3] = 0u; }
    __syncthreads();
    XcdBarrier bar = xcd_barrier_post(kparams()->bar, xbw);
    PHASE_BEGIN RUN(12, st_adaln(p, lds)); RUN(0, st_convert(p, lds, 0, NL)); RUN(13, st_fold(p)); PHASE_END
    PHASE_BEGIN RUN(14, st_norm1(p, 0)); PHASE_END
    for (int l = 0; l < NL; ++l) {
        const bool wc = l + 1 < NL;
        PHASE_BEGIN pg8::PlainOrder S{(const char*)p->U, (const char*)(p->WIN + (size_t)l * PC * DM), (size_t)256 * DM * 2, (size_t)256 * DM * 2, MT / 256, C_MG / 256, G, c};
                    pg8::EpiIn E{p->P, p->PG};
                    const int c8 = (c + 56) % G;
                    pg8::PlainOrder S8{(const char*)p->U8W, (const char*)(p->WING8 + (size_t)l * 3072 * DM), (size_t)256 * DM, (size_t)256 * DM, (wc ? MT : NLAT) / 256, 3072 / 256, G, c8};
                    pg8::EpiGate8 E8{p->PG, 1.f / (S8_U * S8_W)};
                    RUN(1, pg8::gemm_phase<pg8::EpiIn, pg8::PlainOrder, true, true>(lds3, DM * 2, DM * 2, DM / 64, S, E); pg8::gemm_phase<pg8::EpiGate8, pg8::PlainOrder, true, true, true>(lds3, DM, DM, DM / 128, S8, E8)); PHASE_END
        PHASE_BEGIN st_qkrope(p, l, lds);
                    { unsigned* head = p->bar + XCD_BAR_WORDS + l * 64; volatile LAS unsigned* qw = (volatile LAS unsigned*)lds_raw + 2;
                      const int nNA = NB * 4 * 16, nGS = NB * NCH, nTot = nNA + nGS + (wc ? NB * 4 : 0);
                      for (;;) {
                          __syncthreads();
                          if (ltid() == 0) *qw = __hip_atomic_fetch_add(head, 1u, __ATOMIC_RELAXED, __HIP_MEMORY_SCOPE_AGENT);
                          __syncthreads();
                          const int u = (int)*qw;
                          if (u >= nTot) break;
                          if (u < nNA) attn_one(p, l, u, true, lds3);
                          else if (u < nNA + nGS) gla_states_one(p, l, u - nNA, lds3);
                          else attn_one(p, l, nNA + (u - nNA - nGS), true, lds3);
                      } }
                    PHASE_END
        PHASE_BEGIN st_gla_scan2(p);
                    { unsigned* head = p->bar + XCD_BAR_WORDS + (4 + l) * 64; volatile LAS unsigned* qw = (volatile LAS unsigned*)lds_raw + 2;
                      const int nTot = NB * 4 * 16 + (wc ? NB * 4 : 0);
                      for (;;) {
                          __syncthreads();
                          if (ltid() == 0) *qw = __hip_atomic_fetch_add(head, 1u, __ATOMIC_RELAXED, __HIP_MEMORY_SCOPE_AGENT);
                          __syncthreads();
                          const int u = (int)*qw;
                          if (u >= nTot) break;
                          attn_one(p, l, u, false, lds3);
                      } }
                    PHASE_END
        PHASE_BEGIN RUN(5, st_gla_out2(p, l, wc, lds3)); PHASE_END
        PHASE_BEGIN pg8::MergeOrder S{(const char*)p->YCAT, (const char*)(p->WB + (size_t)l * DM * 768), (size_t)256 * 768 * 2, (size_t)256 * 768 * 2, (wc ? MT : NLAT) / 256, DM / 256, G, c};
                    pg8::EpiMerge E{p->PG, p->MPRE};
                    RUN(6, pg8::gemm_phase<pg8::EpiMerge, pg8::MergeOrder, true, true>(lds3, 768 * 2, 768 * 2, 256 / 64, S, E)); PHASE_END
        PHASE_BEGIN pg8::PlainOrder S{(const char*)p->MPRE, (const char*)(p->WOUT + (size_t)l * DM * DM), (size_t)256 * DM * 2, (size_t)256 * DM * 2, (wc ? MT : NLAT) / 256, DM / 256, G, c};
                    pg8::EpiOut E{p->DLT, p->MOD + (size_t)l * 9 * 6144};
                    pg8::gemm_phase<pg8::EpiOut, pg8::PlainOrder, true, true>(lds3, DM * 2, DM * 2, DM / 64, S, E); PHASE_END
        PHASE_BEGIN RUN(7, st_norm2_router(p, l, wc, lds)); PHASE_END
        PHASE_BEGIN RUN(8, st_topk(p, wc, lds)); PHASE_END
        PHASE_BEGIN pg8::ExpertOrder S{(const char*)p->U, (const char*)(p->WGU + (size_t)l * NE * 2 * FF * DM), 0, (size_t)256 * DM, 0, (size_t)2 * FF * DM, wc ? 17 : 16, 16, G, c, p->SRCROW};
                    pg8::EpiGU8 E{p->H, 1.f / (S8_W * S8_X), S8_H};
                    RUN(10, pg8::gemm_phase<pg8::EpiGU8, pg8::ExpertOrder, true, true, true, true>(lds3, DM, DM, DM / 128, S, E)); PHASE_END
        PHASE_BEGIN pg8::ExpertOrder S{(const char*)p->H, (const char*)(p->WD + (size_t)l * NE * DM * FF), (size_t)256 * FF, (size_t)256 * FF, (size_t)EROWS * FF, (size_t)DM * FF, wc ? 17 : 16, 4, G, c, nullptr};
                    pg8::EpiDown E{p->Y, 1.f / (S8_W * S8_H)};
                    RUN(11, pg8::gemm_phase<pg8::EpiDown, pg8::ExpertOrder, true, true, true>(lds3, FF, FF, FF / 128, S, E)); PHASE_END
        PHASE_BEGIN st_combine(p, l, wc); PHASE_END
    }
}

extern "C" void kernel_launch(void* const* d_in, const int* in_sizes, int n_in, void* d_out, int out_size, void* d_ws, size_t ws_size, hipStream_t stream) {
    Params p{};
    for (int i = 0; i < 26; ++i) p.in[i] = (const float*)d_in[i];
    p.out = (float*)d_out;
    unsigned char* w = (unsigned char*)d_ws; size_t off = 0;
    auto take = [&](size_t bytes) { unsigned char* r = w + off; off += (bytes + 255) & ~(size_t)255; return r; };
    p.bar = (unsigned*)take((XCD_BAR_WORDS + QUEUE_WORDS) * 4);
    p.X = (float*)take((size_t)MT * DM * 4);
    p.U = (bf16_t*)take((size_t)MT * DM * 2);
    p.MOD = (float*)take((size_t)NL * 9 * 6144 * 4);
    p.MPRE = (bf16_t*)take((size_t)MT * DM * 2);
    p.AFF = (float*)take((size_t)MT * 16 * 4);
    p.SRCROW = (int*)take((size_t)NE * EROWS * 4);
    p.VAL = (float*)take((size_t)NE * EROWS * 4);
    p.SLOTOF = (int*)take((size_t)MT * 16 * 4);
    p.WIN = (bf16_t*)take((size_t)NL * PC * DM * 2);
    p.WB = (bf16_t*)take((size_t)NL * DM * 768 * 2);
    p.WOUT = (bf16_t*)take((size_t)NL * DM * DM * 2);
    p.WGU = (unsigned char*)take((size_t)NL * NE * 2 * FF * DM);
    p.WD = (unsigned char*)take((size_t)NL * NE * DM * FF);
    p.U8W = (unsigned char*)take((size_t)MT * DM);
    p.DLT = (bf16_t*)take((size_t)MT * DM * 2);
    p.WING8 = (unsigned char*)take((size_t)NL * 3072 * DM);
    const size_t r1 = off;
    p.P = (bf16_t*)take((size_t)MT * PC * 2);
    p.YCAT = (bf16_t*)take((size_t)MT * 768 * 2);
    p.DST = (float*)take((size_t)NB * 2 * NCH * 4 * 2048 * 4);
    p.DEC = (float*)take((size_t)NB * 2 * NCH * 4 * 32 * 4);
    p.ST = (bf16_t*)take((size_t)NB * 2 * NCH * 4 * 2048 * 2);
    p.PG = (unsigned char*)take((size_t)MT * 3072);
    const size_t r1_end = off;
    off = r1;
    p.XS = (unsigned char*)take((size_t)NE * EROWS * DM);
    p.H = (unsigned char*)take((size_t)NE * EROWS * FF);
    p.Y = (bf16_t*)take((size_t)NE * EROWS * DM * 2);
    if (off < r1_end) off = r1_end;
    if (off > ws_size) { fprintf(stderr, "workspace too small: need %zu have %zu\n", off, ws_size); return; }
    static int grid = 0;
    if (!grid) {
        (void)hipFuncSetAttribute((const void*)fwd, hipFuncAttributeMaxDynamicSharedMemorySize, LDS_BYTES);
        int dev = 0, cus = 0, per_cu = 0;
        (void)hipGetDevice(&dev);
        (void)hipDeviceGetAttribute(&cus, hipDeviceAttributeMultiprocessorCount, dev);
        (void)hipOccupancyMaxActiveBlocksPerMultiprocessor(&per_cu, fwd, NTHREADS, LDS_BYTES);
        if (per_cu < 1) fprintf(stderr, "occupancy query says %d blocks per CU\n", per_cu);
        grid = cus;
    }
    (void)hipMemsetAsync(p.bar, 0, (XCD_BAR_WORDS + QUEUE_WORDS) * 4, stream);
    hipLaunchKernelGGL(fwd, dim3(grid), dim3(NTHREADS), LDS_BYTES, stream, p);
}
```

```cpp
#include <hip/hip_runtime.h>
#include <stdint.h>
#include <stdio.h>


typedef unsigned short bf16_t;
typedef short bf16x8 __attribute__((ext_vector_type(8)));
typedef float f32x4 __attribute__((ext_vector_type(4)));
typedef unsigned u32x4 __attribute__((ext_vector_type(4)));
typedef unsigned u32x2 __attribute__((ext_vector_type(2)));
#define LAS __attribute__((address_space(3)))

constexpr int DM = 1024, NB = 8, TL = 4096, SC = 256, NL = 4;
constexpr int NLAT = NB * TL, NCTX = NB * SC, MT = NLAT + NCTX;
constexpr int INC = 5152, PC = 5376;
constexpr int C_QA = 0, C_KA = 256, C_VA = 512, C_QB = 768, C_KB = 896, C_VB = 1024, C_RB = 1280, C_G = 1536,
              C_QC = 1792, C_KC = 2048, C_VC = 2176, C_MG = 2304;
constexpr int NE = 16, FF = 2048, CAPL = 512, CAPC = 32, EROWS = NB * CAPL + NB * CAPC;
constexpr int NCH = 68;
constexpr int NTHREADS = 512;
constexpr float EPS = 1e-6f;
constexpr float S8_W = 256.f, S8_X = 8.f, S8_H = 4.f, S8_U = 8.f;

__device__ __forceinline__ unsigned cvt_pk_bf16_hw(float lo, float hi) { unsigned r; asm("v_cvt_pk_bf16_f32 %0, %1, %2" : "=v"(r) : "v"(lo), "v"(hi)); return r; }
__device__ __forceinline__ bf16_t f2bf(float f) { return (bf16_t)(cvt_pk_bf16_hw(f, f) & 0xFFFFu); }
__device__ __forceinline__ float bf2f(bf16_t b) { return __uint_as_float(((unsigned)b) << 16); }
__device__ __forceinline__ unsigned pack2(float lo, float hi) { return cvt_pk_bf16_hw(lo, hi); }
__device__ __forceinline__ float bflo(unsigned w) { return __uint_as_float(w << 16); }
__device__ __forceinline__ float bfhi(unsigned w) { return __uint_as_float(w & 0xFFFF0000u); }
__device__ __forceinline__ float siluf(float x) { return x * __builtin_amdgcn_rcpf(1.f + __expf(-x)); }
__device__ __forceinline__ float logsig16(float z) { return (fminf(z, 0.f) - __logf(1.f + __expf(-fabsf(z)))) * (1.f / 16.f); }
__device__ __forceinline__ float wave_sum(float v) {
#pragma unroll
    for (int o = 32; o > 0; o >>= 1) v += __shfl_xor(v, o);
    return v;
}
__device__ __forceinline__ int ltid() { int t = threadIdx.x; asm volatile("" : "+v"(t)); return t; }
__device__ __forceinline__ int lbid() { int t = blockIdx.x; asm volatile("" : "+s"(t)); return t; }
__device__ __forceinline__ int lgrid() { int t = gridDim.x; asm volatile("" : "+s"(t)); return t; }
__device__ __forceinline__ LAS unsigned char* llds3(LAS unsigned char* p) { asm volatile("" : "+s"(p)); return p; }
__device__ __forceinline__ int mod_row(int R) { return R < NLAT ? (R >> 12) : NB; }

struct Params {
    const float* in[26];
    float* out;
    float* X; bf16_t* U; float* MOD; bf16_t* P; bf16_t* YCAT; bf16_t* MPRE;
    float* AFF; int* SRCROW; float* VAL; int* SLOTOF;
    unsigned char* XS; unsigned char* H; bf16_t* Y;
    float* DST; float* DEC; bf16_t* ST; unsigned char* PG; unsigned char* U8W; unsigned char* WING8;
    bf16_t* WIN; bf16_t* WB; bf16_t* WOUT; unsigned char* WGU; unsigned char* WD;
    unsigned* bar;
};
enum { I_X = 0, I_C, I_CTX, I_CCTX, I_WADA, I_BADA, I_N1G, I_N2G, I_WIN, I_RPB, I_WGF, I_BGF, I_WGB, I_BGB, I_GLAG, I_QNG, I_KNG,
       I_WBA, I_WBB, I_WBC, I_WOUT, I_WR, I_WEG, I_WEU, I_WED, I_FNG };

typedef const __attribute__((address_space(4))) Params* KP;
__device__ __forceinline__ KP kparams() {
    KP kp = (KP)__builtin_amdgcn_kernarg_segment_ptr();
    asm volatile("" : "+s"(kp) :: "memory");
    return kp;
}
#define XB_TMO      128
#define XB_XCNT(j)  (256  + 64 * (j))
#define XB_XSUB(j)  (1280 + 64 * (j))
#define XB_XGEN(j)  (2304 + 64 * (j))
#define XB_TOP      3328
#define XB_TOPGEN   3392
#define XCD_BAR_WORDS 3456
#define XB_SPIN_CAP (1u << 22)
#define QUEUE_WORDS (16 * 64)
__device__ __forceinline__ unsigned xb_ld(unsigned* p)              { return __hip_atomic_load(p, __ATOMIC_RELAXED, __HIP_MEMORY_SCOPE_AGENT); }
__device__ __forceinline__ unsigned xb_add(unsigned* p, unsigned v) { return __hip_atomic_fetch_add(p, v, __ATOMIC_RELAXED, __HIP_MEMORY_SCOPE_AGENT); }
__device__ __forceinline__ unsigned xb_xcc_id() { return (unsigned)__builtin_amdgcn_s_getreg((3 << 11) | 20) & 0xFu; }
#define XB_SPIN(cond, bar) do { unsigned _sp = 0; while (cond) { __builtin_amdgcn_s_sleep(1); \
    if ((++_sp & 255u) == 0u) { if (xb_ld(&(bar)[XB_TMO])) break; if (_sp > XB_SPIN_CAP) { atomicAdd(&(bar)[XB_TMO], 1u); break; } } } } while (0)
struct XcdBarrier { unsigned* bar; unsigned x; volatile LAS unsigned* st; };
__device__ __forceinline__ XcdBarrier xcd_barrier_post(unsigned* bar, volatile LAS unsigned* st) {
    XcdBarrier b; b.bar = bar; b.x = xb_xcc_id(); b.st = st;
    if (threadIdx.x == 0) (void)xb_add(&bar[XB_XCNT(b.x)], 1u);
    return b;
}
__device__ __forceinline__ void xcd_barrier_complete(unsigned* bar, unsigned x, unsigned& nloc, unsigned& nx) {
    const unsigned G = gridDim.x * gridDim.y * gridDim.z;
    unsigned sum, cnt, mine, sp = 0u;
    for (;;) {
        sum = 0u; cnt = 0u; mine = 0u;
#pragma unroll
        for (unsigned j = 0; j < 16; ++j) { const unsigned c = xb_ld(&bar[XB_XCNT(j)]); sum += c; cnt += (c > 0u) ? 1u : 0u; mine = (j == x) ? c : mine; }
        if (sum == G) break;
        __builtin_amdgcn_s_sleep(1);
        if ((++sp & 255u) == 0u) { if (xb_ld(&bar[XB_TMO])) break; if (sp > XB_SPIN_CAP) { atomicAdd(&bar[XB_TMO], 1u); break; } }
    }
    nloc = mine > 0u ? mine : 1u; nx = cnt > 0u ? cnt : 1u;
}
__device__ __forceinline__ void xcd_barrier(const XcdBarrier& b) {
    asm volatile("s_waitcnt vmcnt(0)" ::: "memory");
    __syncthreads();
    if (threadIdx.x == 0) {
        unsigned* bar = b.bar;
        __builtin_amdgcn_s_waitcnt(0);
        unsigned nloc = b.st[0], nx = b.st[1];
        if (nloc == 0u) { xcd_barrier_complete(bar, b.x, nloc, nx); b.st[0] = nloc; b.st[1] = nx; }
        const unsigned old = xb_add(&bar[XB_XSUB(b.x)], 1u);
        const unsigned gen = old / nloc;
        if (old + 1u == (gen + 1u) * nloc) {
            __builtin_amdgcn_fence(__ATOMIC_RELEASE, "agent");
            asm volatile("s_waitcnt vmcnt(0)" ::: "memory");
            const unsigned og = xb_add(&bar[XB_TOP], 1u);
            const unsigned tg = og / nx;
            if (og + 1u == (tg + 1u) * nx) xb_add(&bar[XB_TOPGEN], 1u);
            else XB_SPIN(xb_ld(&bar[XB_TOPGEN]) == tg, bar);
            __builtin_amdgcn_fence(__ATOMIC_ACQUIRE, "agent");
            xb_add(&bar[XB_XGEN(b.x)], 1u);
            asm volatile("s_waitcnt vmcnt(0)" ::: "memory");
        } else {
            XB_SPIN(xb_ld(&bar[XB_XGEN(b.x)]) == gen, bar);
            __builtin_amdgcn_fence(__ATOMIC_ACQUIRE, "agent");
            asm volatile("s_waitcnt vmcnt(0)" ::: "memory");
        }
    }
    __syncthreads();
}

#ifndef PG8_TID
#define PG8_TID ltid()
#endif
namespace pg8 {
constexpr int BM = 256, BK = 64, HALF = 128, HTB = HALF * BK * 2, STAGE_BYTES = 8 * HTB;
__host__ __device__ __forceinline__ int lds_byte(int r, int c) { const int st = (r >> 4) * 2 + (c >> 5), rr = r & 15, cc = c & 31, ob = rr * 64 + cc * 2; return st * 1024 + (ob ^ (((ob >> 9) & 1) << 5)); }
__host__ __device__ __forceinline__ void stage_rc(int b, int& R, int& C) { const int st = b / 1024, sb = b % 1024, swz = sb ^ (((sb >> 9) & 1) << 5); R = (st >> 1) * 16 + swz / 64; C = (st & 1) * 32 + (swz % 64) / 2; }
__host__ __device__ __forceinline__ int perm32(int rho) { const int n = rho >> 4, i = rho & 15; return 8 * (i >> 2) + 4 * n + (i & 3); }
struct Unit { const char* A; const char* B; int row0, col0, aux, keep; const int* G; };
__device__ __forceinline__ unsigned cvt_pk_bf16(float lo, float hi) { unsigned r; asm volatile("v_cvt_pk_bf16_f32 %0, %1, %2" : "=v"(r) : "v"(lo), "v"(hi)); return r; }

typedef int v8i __attribute__((ext_vector_type(8)));
typedef int v4i __attribute__((ext_vector_type(4)));
__device__ __forceinline__ void glds16s(unsigned voff, const void* sbase, unsigned lds_dst) { unsigned keep;
    asm volatile("s_mov_b32 %0, m0\n\ts_mov_b32 m0, %3\n\ts_nop 0\n\tglobal_load_lds_dwordx4 %1, %2\n\ts_mov_b32 m0, %0" : "=&s"(keep) : "v"(voff), "s"(sbase), "s"(lds_dst) : "memory"); }
__device__ __forceinline__ void glds4s(unsigned voff, const void* sbase, unsigned lds_dst) { unsigned keep;
    asm volatile("s_mov_b32 %0, m0\n\ts_mov_b32 m0, %3\n\ts_nop 0\n\tglobal_load_lds_dword %1, %2\n\ts_mov_b32 m0, %0" : "=&s"(keep) : "v"(voff), "s"(sbase), "s"(lds_dst) : "memory"); }
template <class Epi, class Sched, bool ALIGN_EPI, bool SP2, bool FP8 = false, bool GATHER = false>
__device__ __forceinline__ void gemm_phase(LAS unsigned char* lds, const int ldaB, const int ldbB, const int nt_in, const Sched& S, const Epi& E) {
    int nt = nt_in; asm volatile("" : "+s"(nt));
    const int tid = PG8_TID, wid = __builtin_amdgcn_readfirstlane(tid >> 6), lane = tid & 63, wr = wid >> 2, wc = wid & 3, fr = lane & 15, fq = lane >> 4;
    unsigned voffA[2], voffB[2];
#pragma unroll
    for (int i = 0; i < 2; ++i) { int R, C; stage_rc(tid * 16 + i * 8192, R, C); const int Rb = Epi::PERM ? ((R & ~31) + perm32(R & 31)) : R;
        voffA[i] = (unsigned)(R * ldaB + C * 2); voffB[i] = (unsigned)(Rb * ldbB + C * 2); }
    const size_t kstep = (size_t)(BK * 2);
    const size_t hstepA = (size_t)HALF * ldaB, hstepB = (size_t)HALF * ldbB;
    const unsigned ldsw = (unsigned)wid * 1024u, ldsbase = (unsigned)__builtin_amdgcn_readfirstlane((int)(unsigned)(uintptr_t)lds);
    const int aoff = lds_byte(wr * 64 + fr, fq * 8), boff = lds_byte(wc * 32 + fr, fq * 8);
#define PG8_SA(b, h) (((b) * 2 + (h)) * HTB)
#define PG8_SB(b, h) ((4 + (b) * 2 + (h)) * HTB)
#define PG8_STAGE(bufoff, gbase, voff) do { _Pragma("unroll") for (int _i = 0; _i < 2; ++_i) \
        glds16s((voff)[_i], (const void*)(gbase), ldsbase + (unsigned)(bufoff) + ldsw + _i * 8192); } while (0)
    unsigned vc[2][2], vn[2][2]; int gR[2], gC[2];
#pragma unroll
    for (int i = 0; i < 2; ++i) { int R, C; stage_rc(tid * 16 + i * 8192, R, C); gR[i] = R; gC[i] = C * 2; vc[0][i] = vc[1][i] = vn[0][i] = vn[1][i] = 0u; }
    LAS int* gidx = (LAS int*)(lds + STAGE_BYTES);
#define PG8_GIDX(dst, buf) do { _Pragma("unroll") for (int h_ = 0; h_ < 2; ++h_) _Pragma("unroll") for (int i_ = 0; i_ < 2; ++i_) dst[h_][i_] = (unsigned)(gidx[(buf) * 256 + h_ * HALF + gR[i_]] * ldaB + gC[i_]); } while (0)
#define PG8_STAGE_A(b, h, base, nx) do { if constexpr (GATHER) { if (nx) PG8_STAGE(PG8_SA(b, h), base, vn[h]); else PG8_STAGE(PG8_SA(b, h), base, vc[h]); } \
        else PG8_STAGE(PG8_SA(b, h), (base) + (h) * hstepA, voffA); } while (0)
#define PG8_LDA(dst, b, h) do { _Pragma("unroll") for (int m = 0; m < 4; ++m) { dst[m].lo = *(const LAS v4i*)(lds + PG8_SA(b, h) + aoff + m * 2048); dst[m].hi = *(const LAS v4i*)(lds + PG8_SA(b, h) + aoff + m * 2048 + 1024); } } while (0)
#define PG8_LDB(dst, b, h) do { _Pragma("unroll") for (int n = 0; n < 2; ++n) { dst[n].lo = *(const LAS v4i*)(lds + PG8_SB(b, h) + boff + n * 2048); dst[n].hi = *(const LAS v4i*)(lds + PG8_SB(b, h) + boff + n * 2048 + 1024); } } while (0)
#define PG8_MMA(ai, bj, At, Bt) do { __builtin_amdgcn_s_setprio(1); _Pragma("unroll") for (int m = 0; m < 4; ++m) _Pragma("unroll") for (int n = 0; n < 2; ++n) { \
        if constexpr (FP8) asm volatile("v_mfma_scale_f32_16x16x128_f8f6f4 %0, %1, %2, %0, %3, %3 op_sel_hi:[0,0,0]" : "+v"(acc[ai][bj][m][n]) : "v"(Bt[n]), "v"(At[m]), "v"(sc8)); \
        else { const v4i bl_ = Bt[n].lo, bh_ = Bt[n].hi, al_ = At[m].lo, ah_ = At[m].hi;     \
               acc[ai][bj][m][n] = __builtin_amdgcn_mfma_f32_16x16x32_bf16(__builtin_bit_cast(bf16x8, bl_), __builtin_bit_cast(bf16x8, al_), acc[ai][bj][m][n], 0, 0, 0); \
               acc[ai][bj][m][n] = __builtin_amdgcn_mfma_f32_16x16x32_bf16(__builtin_bit_cast(bf16x8, bh_), __builtin_bit_cast(bf16x8, ah_), acc[ai][bj][m][n], 0, 0, 0); } } __builtin_amdgcn_s_setprio(0); } while (0)
#define PG8_WAIT_V(n) asm volatile("s_waitcnt vmcnt(" #n ")" ::: "memory")
#define PG8_WAIT_L(n) asm volatile("s_waitcnt lgkmcnt(" #n ")" ::: "memory")
#define PG8_BAR __builtin_amdgcn_s_barrier()
#define PG8_SCHED __builtin_amdgcn_sched_barrier(0)
    Unit cur, nxt; int ui = 0;
    if (!S.next(0, cur)) return;
    f32x4 acc[2][2][4][2];
#pragma unroll
    for (int a = 0; a < 2; ++a)
#pragma unroll
        for (int b = 0; b < 2; ++b)
#pragma unroll
            for (int m = 0; m < 4; ++m)
#pragma unroll
                for (int n = 0; n < 2; ++n) acc[a][b][m][n] = (f32x4){0.f, 0.f, 0.f, 0.f};
    v8i At[4], B0[2], B1[2];
    int sc8 = 0x7F7F7F7F; asm volatile("" : "+v"(sc8));
    const char* cA = cur.A; const char* cB = cur.B;
    if constexpr (GATHER) {
        if (tid < 256) gidx[tid] = cur.G[tid];
        asm volatile("s_waitcnt vmcnt(0) lgkmcnt(0)" ::: "memory"); PG8_BAR; asm volatile("" ::: "memory");
        PG8_GIDX(vc, 0);
    }
    if constexpr (SP2) {
        PG8_STAGE(PG8_SB(0, 0), cB, voffB); PG8_STAGE(PG8_SB(0, 1), cB + hstepB, voffB); PG8_STAGE_A(0, 0, cA, false); PG8_STAGE_A(0, 1, cA, false);
        if (wr == 1) PG8_BAR;
        PG8_WAIT_V(2); PG8_BAR;
        PG8_STAGE(PG8_SB(1, 0), cB + kstep, voffB); PG8_STAGE_A(1, 0, cA + kstep, false); PG8_STAGE(PG8_SB(1, 1), cB + hstepB + kstep, voffB);
        PG8_WAIT_V(6); PG8_BAR;
    } else {
        PG8_STAGE(PG8_SB(0, 0), cB, voffB); PG8_STAGE(PG8_SA(0, 0), cA, voffA); PG8_STAGE(PG8_SB(0, 1), cB + hstepB, voffB); PG8_STAGE(PG8_SA(0, 1), cA + hstepA, voffA);
        if (wr == 1) PG8_BAR;
        PG8_WAIT_V(4); PG8_BAR;
        PG8_STAGE(PG8_SB(1, 0), cB + kstep, voffB); PG8_STAGE(PG8_SA(1, 0), cA + kstep, voffA); PG8_STAGE(PG8_SB(1, 1), cB + hstepB + kstep, voffB);
        PG8_WAIT_V(6); PG8_BAR;
    }
    for (;;) {
        const bool has_next = S.next(ui + 1, nxt);
        const char* nA = has_next ? nxt.A : cA; const char* nB = has_next ? nxt.B : cB;
        if constexpr (GATHER) { if (has_next && wid < 4) glds4s((unsigned)lane * 4u, (const void*)(nxt.G + wid * 64), ldsbase + (unsigned)STAGE_BYTES + (unsigned)(((ui + 1) & 1) * 1024 + wid * 256)); }
#pragma unroll 1
        for (int t = 0; t < nt; t += 2) {
            const bool last = (t == nt - 2);
            const char* a1 = cA + (size_t)(t + 1) * kstep;
            const char* a2 = last ? nA : cA + (size_t)(t + 2) * kstep; const char* b2 = last ? nB : cB + (size_t)(t + 2) * kstep;
            const char* a3 = a2 + kstep; const char* b3 = b2 + kstep;
            if constexpr (SP2) {
            if constexpr (GATHER) { if (last) { if (has_next) PG8_GIDX(vn, (ui + 1) & 1); else { vn[0][0] = vc[0][0]; vn[0][1] = vc[0][1]; vn[1][0] = vc[1][0]; vn[1][1] = vc[1][1]; } } }
            PG8_LDB(B0, 0, 0); PG8_LDB(B1, 0, 1); PG8_SCHED; PG8_LDA(At, 0, 0); PG8_STAGE_A(1, 1, a1, false);
            PG8_WAIT_V(8); PG8_WAIT_L(0); PG8_BAR; PG8_MMA(0, 0, At, B0); PG8_MMA(0, 1, At, B1); PG8_BAR; PG8_SCHED;
            PG8_LDA(At, 0, 1); PG8_STAGE(PG8_SB(0, 0), b2, voffB); PG8_STAGE(PG8_SB(0, 1), b2 + hstepB, voffB); PG8_STAGE_A(0, 0, a2, last);
            PG8_WAIT_V(8); PG8_WAIT_L(0); PG8_BAR; PG8_MMA(1, 0, At, B0); PG8_MMA(1, 1, At, B1); PG8_BAR; PG8_SCHED;
            PG8_LDB(B0, 1, 0); PG8_LDB(B1, 1, 1); PG8_SCHED; PG8_LDA(At, 1, 0); PG8_STAGE_A(0, 1, a2, last);
            PG8_WAIT_V(8); PG8_WAIT_L(0); PG8_BAR; PG8_MMA(0, 0, At, B0); PG8_MMA(0, 1, At, B1); PG8_BAR; PG8_SCHED;
            PG8_LDA(At, 1, 1); PG8_STAGE(PG8_SB(1, 0), b3, voffB); PG8_STAGE(PG8_SB(1, 1), b3 + hstepB, voffB); PG8_STAGE_A(1, 0, a3, last);
            PG8_WAIT_V(8); PG8_WAIT_L(0); PG8_BAR; PG8_MMA(1, 0, At, B0); PG8_MMA(1, 1, At, B1); PG8_BAR; PG8_SCHED;
            } else {
            PG8_LDB(B0, 0, 0); PG8_SCHED; PG8_LDA(At, 0, 0); PG8_STAGE(PG8_SA(1, 1), a1 + hstepA, voffA);
            PG8_WAIT_L(8); PG8_BAR; PG8_WAIT_L(0); PG8_MMA(0, 0, At, B0); PG8_BAR; PG8_SCHED;
            PG8_LDB(B1, 0, 1); PG8_STAGE(PG8_SB(0, 0), b2, voffB);
            PG8_BAR; PG8_WAIT_L(0); PG8_MMA(0, 1, At, B1); PG8_BAR;
            PG8_LDA(At, 0, 1); PG8_STAGE(PG8_SA(0, 0), a2, voffA);
            PG8_BAR; PG8_WAIT_L(0); PG8_MMA(1, 0, At, B0); PG8_BAR; PG8_SCHED;
            PG8_STAGE(PG8_SB(0, 1), b2 + hstepB, voffB);
            PG8_WAIT_V(6); PG8_BAR; PG8_MMA(1, 1, At, B1); PG8_BAR;
            PG8_LDB(B0, 1, 0); PG8_SCHED; PG8_LDA(At, 1, 0); PG8_STAGE(PG8_SA(0, 1), a2 + hstepA, voffA);
            PG8_WAIT_L(8); PG8_BAR; PG8_WAIT_L(0); PG8_MMA(0, 0, At, B0); PG8_BAR; PG8_SCHED;
            PG8_LDB(B1, 1, 1); PG8_STAGE(PG8_SB(1, 0), b3, voffB);
            PG8_BAR; PG8_WAIT_L(0); PG8_MMA(0, 1, At, B1); PG8_BAR;
            PG8_LDA(At, 1, 1); PG8_STAGE(PG8_SA(1, 0), a3, voffA);
            PG8_BAR; PG8_WAIT_L(0); PG8_MMA(1, 0, At, B0); PG8_BAR; PG8_SCHED;
            PG8_STAGE(PG8_SB(1, 1), b3 + hstepB, voffB);
            PG8_WAIT_V(6); PG8_BAR; PG8_MMA(1, 1, At, B1); PG8_BAR;
            }
        }
        if constexpr (FP8) asm volatile("s_nop 15\n\ts_nop 15" ::: "memory");
        if constexpr (ALIGN_EPI) { if (wr == 0) PG8_BAR; }
        E(acc, cur, wr, wc, fr, fq);
        if (!has_next) break;
        if (!(Epi::KEEP && cur.keep)) {
#pragma unroll
        for (int a = 0; a < 2; ++a)
#pragma unroll
            for (int b = 0; b < 2; ++b)
#pragma unroll
                for (int m = 0; m < 4; ++m)
#pragma unroll
                    for (int n = 0; n < 2; ++n) acc[a][b][m][n] = (f32x4){0.f, 0.f, 0.f, 0.f};
        }
        cur = nxt; cA = nA; cB = nB; ++ui;
        if constexpr (GATHER) { vc[0][0] = vn[0][0]; vc[0][1] = vn[0][1]; vc[1][0] = vn[1][0]; vc[1][1] = vn[1][1]; }
        if constexpr (ALIGN_EPI) { if (wr == 1) PG8_BAR; }
    }
    PG8_WAIT_V(0);
    if constexpr (!ALIGN_EPI) { if (wr == 0) PG8_BAR; }
    PG8_BAR;
#undef PG8_SA
#undef PG8_SB
#undef PG8_STAGE
#undef PG8_STAGE_A
#undef PG8_GIDX
#undef PG8_LDA
#undef PG8_LDB
#undef PG8_MMA
#undef PG8_WAIT_V
#undef PG8_WAIT_L
#undef PG8_BAR
#undef PG8_SCHED
}

struct PlainOrder {
    const char* A; const char* B; size_t astep, bstep; int nM, nN, G, c;
    __device__ __forceinline__ bool next(int i, Unit& u) const {
        const int L = i * G + c; if (L >= nM * nN) return false;
        const int nig = 8 * nN, gid = L / nig, fm = gid * 8, gsz = (nM - fm) < 8 ? (nM - fm) : 8;
        const int pm = fm + ((L % nig) % gsz), pn = (L % nig) / gsz;
        u.A = A + (size_t)pm * astep; u.B = B + (size_t)pn * bstep; u.row0 = pm * 256; u.col0 = pn * 256; u.aux = 0; u.keep = 0; u.G = nullptr; return true;
    }
};
struct MergeOrder {
    const char* A; const char* B; size_t astep, bstep; int nM, nN, G, c;
    __device__ __forceinline__ bool next(int i, Unit& u) const {
        const int t = i / 3, seg = i - 3 * t;
        const int L = t * G + c; if (L >= nM * nN) return false;
        const int nig = 8 * nN, gid = L / nig, fm = gid * 8, gsz = (nM - fm) < 8 ? (nM - fm) : 8;
        const int pm = fm + ((L % nig) % gsz), pn = (L % nig) / gsz;
        u.A = A + (size_t)pm * astep + seg * 512; u.B = B + (size_t)pn * bstep + seg * 512; u.row0 = pm * 256; u.col0 = pn * 256; u.aux = seg; u.keep = seg < 2; u.G = nullptr; return true;
    }
};
struct ExpertOrder {
    const char* A; const char* B; size_t astep, bstep, aexp, bexp; int nM, nN, G, c; const int* rows;
    __device__ __forceinline__ bool next(int i, Unit& u) const {
        const int L = i * G + c, per = nM * nN; if (L >= NE * per) return false;
        const int e = L / per, r = L - e * per;
        const int nig = 8 * nN, gid = r / nig, fm = gid * 8, gsz = (nM - fm) < 8 ? (nM - fm) : 8;
        const int pm = fm + ((r % nig) % gsz), pn = (r % nig) / gsz;
        u.A = A + (size_t)e * aexp + (size_t)pm * astep; u.B = B + (size_t)e * bexp + (size_t)pn * bstep; u.row0 = e * EROWS + pm * 256; u.col0 = pn * 256; u.aux = e; u.keep = 0; u.G = rows ? rows + u.row0 : nullptr; return true;
    }
};
__device__ __forceinline__ unsigned q8(float g) {
    const float sg = __builtin_amdgcn_rcpf(1.f + __builtin_amdgcn_exp2f(g * -1.4426950408889634f));
    return (unsigned)__builtin_amdgcn_fmed3f(sg * 255.f + 0.5f, 1.f, 255.f);
}
struct EpiIn {
    static constexpr bool PERM = true, KEEP = false;
    bf16_t* P; unsigned char* PG;
    __device__ __forceinline__ void operator()(f32x4 (&acc)[2][2][4][2], const Unit& u, int wr, int wc, int fr, int fq) const {
        const int row0 = u.row0 + wr * 64 + fr, cl = u.col0 + wc * 32 + 8 * fq; const bool mg = u.col0 >= C_MG;
        if (mg) {
#pragma unroll
            for (int ai = 0; ai < 2; ++ai)
#pragma unroll
                for (int m = 0; m < 4; ++m) { unsigned char* rowp = PG + (size_t)(row0 + ai * HALF + m * 16) * 3072 + (cl - C_MG);
#pragma unroll
                    for (int bj = 0; bj < 2; ++bj) { const f32x4 v0 = acc[ai][bj][m][0], v1 = acc[ai][bj][m][1]; u32x2 w;
                        w.x = q8(v0[0]) | (q8(v0[1]) << 8) | (q8(v0[2]) << 16) | (q8(v0[3]) << 24); w.y = q8(v1[0]) | (q8(v1[1]) << 8) | (q8(v1[2]) << 16) | (q8(v1[3]) << 24);
                        *(u32x2*)(rowp + bj * HALF) = w; } }
        } else {
#pragma unroll
            for (int ai = 0; ai < 2; ++ai)
#pragma unroll
                for (int m = 0; m < 4; ++m) { bf16_t* rowp = P + (size_t)(row0 + ai * HALF + m * 16) * PC + cl;
#pragma unroll
                    for (int bj = 0; bj < 2; ++bj) { const f32x4 v0 = acc[ai][bj][m][0], v1 = acc[ai][bj][m][1]; u32x4 w; w.x = cvt_pk_bf16(v0[0], v0[1]); w.y = cvt_pk_bf16(v0[2], v0[3]); w.z = cvt_pk_bf16(v1[0], v1[1]); w.w = cvt_pk_bf16(v1[2], v1[3]);
                        *(u32x4*)(rowp + bj * HALF) = w; } }
        }
    }
};
__device__ __forceinline__ float ub(unsigned w, int i) { return (float)((w >> (8 * i)) & 0xFFu); }
struct EpiMerge {
    static constexpr bool PERM = true, KEEP = true;
    const unsigned char* PG; bf16_t* MPRE;
    __device__ __forceinline__ void operator()(f32x4 (&acc)[2][2][4][2], const Unit& u, int wr, int wc, int fr, int fq) const {
        const int row0 = u.row0 + wr * 64 + fr, cl = u.col0 + wc * 32 + 8 * fq, seg = u.aux;
#pragma unroll
        for (int ai = 0; ai < 2; ++ai) {
            u32x2 g0[4][2], g1[4][2];
#pragma unroll
            for (int m = 0; m < 4; ++m) { const unsigned char* gp = PG + (size_t)(row0 + ai * HALF + m * 16) * 3072 + seg * 1024 + cl;
#pragma unroll
                for (int bj = 0; bj < 2; ++bj) { g0[m][bj] = *(const u32x2*)(gp + bj * HALF); g1[m][bj] = (seg < 2) ? *(const u32x2*)(gp + 1024 + bj * HALF) : (u32x2){0u, 0u}; } }
            __builtin_amdgcn_sched_barrier(0);
#pragma unroll
            for (int m = 0; m < 4; ++m) { const int row = row0 + ai * HALF + m * 16;
#pragma unroll
                for (int bj = 0; bj < 2; ++bj) {
                    float f[8];
#pragma unroll
                    for (int e = 0; e < 4; ++e) { f[e] = ub(g0[m][bj].x, e); f[4 + e] = ub(g0[m][bj].y, e); }
                    if (seg < 2) {
#pragma unroll
                        for (int e = 0; e < 4; ++e) { f[e] *= __builtin_amdgcn_rcpf(ub(g1[m][bj].x, e)); f[4 + e] *= __builtin_amdgcn_rcpf(ub(g1[m][bj].y, e)); }
                        acc[ai][bj][m][0] *= (f32x4){f[0], f[1], f[2], f[3]}; acc[ai][bj][m][1] *= (f32x4){f[4], f[5], f[6], f[7]};
                    } else {
                        const f32x4 v0 = acc[ai][bj][m][0] * (1.f / 255.f), v1 = acc[ai][bj][m][1] * (1.f / 255.f); u32x4 w;
                        w.x = cvt_pk_bf16(v0[0] * f[0], v0[1] * f[1]); w.y = cvt_pk_bf16(v0[2] * f[2], v0[3] * f[3]); w.z = cvt_pk_bf16(v1[0] * f[4], v1[1] * f[5]); w.w = cvt_pk_bf16(v1[2] * f[6], v1[3] * f[7]);
                        *(u32x4*)(MPRE + (size_t)row * DM + cl + bj * HALF) = w; }
                } }
        }
    }
};
struct EpiOut {
    static constexpr bool PERM = false, KEEP = false;
    float* X; const float* mod;
    __device__ __forceinline__ void operator()(f32x4 (&acc)[2][2][4][2], const Unit& u, int wr, int wc, int fr, int fq) const {
        const int row0 = u.row0 + wr * 64 + fr, col0 = u.col0 + wc * 32 + 4 * fq;
        const float* g1 = mod + mod_row(u.row0) * 6144 + 2048 + col0;
        f32x4 gv[2][2];
#pragma unroll
        for (int bj = 0; bj < 2; ++bj)
#pragma unroll
            for (int n = 0; n < 2; ++n) gv[bj][n] = *(const f32x4*)(g1 + bj * HALF + n * 16);
#pragma unroll
        for (int ai = 0; ai < 2; ++ai)
#pragma unroll
            for (int m = 0; m < 4; ++m) { float* rowp = X + (size_t)(row0 + ai * HALF + m * 16) * DM + col0;
#pragma unroll
                for (int bj = 0; bj < 2; ++bj)
#pragma unroll
                    for (int n = 0; n < 2; ++n) { float* xp = rowp + bj * HALF + n * 16; *(f32x4*)xp = *(const f32x4*)xp + gv[bj][n] * acc[ai][bj][m][n]; } }
    }
};
__device__ __forceinline__ float clamp8(float v) { return __builtin_amdgcn_fmed3f(v, -448.f, 448.f); }
__device__ __forceinline__ unsigned pk4_fp8(float a, float b, float c, float d) { int w = 0; a = clamp8(a); b = clamp8(b); c = clamp8(c); d = clamp8(d); w = __builtin_amdgcn_cvt_pk_fp8_f32(a, b, w, false); w = __builtin_amdgcn_cvt_pk_fp8_f32(c, d, w, true); return (unsigned)w; }
struct EpiGate8 {
    static constexpr bool PERM = true, KEEP = false;
    unsigned char* PG; float s;
    __device__ __forceinline__ void operator()(f32x4 (&acc)[2][2][4][2], const Unit& u, int wr, int wc, int fr, int fq) const {
        const int row0 = u.row0 + wr * 64 + fr, cl = u.col0 + wc * 32 + 8 * fq;
#pragma unroll
        for (int ai = 0; ai < 2; ++ai)
#pragma unroll
            for (int m = 0; m < 4; ++m) { unsigned char* rowp = PG + (size_t)(row0 + ai * HALF + m * 16) * 3072 + cl;
#pragma unroll
                for (int bj = 0; bj < 2; ++bj) { const f32x4 v0 = acc[ai][bj][m][0] * s, v1 = acc[ai][bj][m][1] * s; u32x2 w;
                    w.x = q8(v0[0]) | (q8(v0[1]) << 8) | (q8(v0[2]) << 16) | (q8(v0[3]) << 24); w.y = q8(v1[0]) | (q8(v1[1]) << 8) | (q8(v1[2]) << 16) | (q8(v1[3]) << 24);
                    *(u32x2*)(rowp + bj * HALF) = w; } }
    }
};
struct EpiGU8 {
    static constexpr bool PERM = true, KEEP = false;
    unsigned char* H; float s, hs;
    __device__ __forceinline__ void operator()(f32x4 (&acc)[2][2][4][2], const Unit& u, int wr, int wc, int fr, int fq) const {
        const int row0 = u.row0 + wr * 64 + fr, hc = (u.col0 >> 1) + wc * 32 + 8 * fq;
#pragma unroll
        for (int ai = 0; ai < 2; ++ai)
#pragma unroll
            for (int m = 0; m < 4; ++m) { const f32x4 g0 = acc[ai][0][m][0], g1 = acc[ai][0][m][1], u0 = acc[ai][1][m][0] * (s * s * hs), u1 = acc[ai][1][m][1] * (s * s * hs); u32x2 w;
                const float ne = -s * 1.4426950408889634f;
#define GU8_(g, u) ((g) * (u) * __builtin_amdgcn_rcpf(1.f + __builtin_amdgcn_exp2f((g) * ne)))
                w.x = pk4_fp8(GU8_(g0[0], u0[0]), GU8_(g0[1], u0[1]), GU8_(g0[2], u0[2]), GU8_(g0[3], u0[3]));
                w.y = pk4_fp8(GU8_(g1[0], u1[0]), GU8_(g1[1], u1[1]), GU8_(g1[2], u1[2]), GU8_(g1[3], u1[3]));
#undef GU8_
                *(u32x2*)(H + (size_t)(row0 + ai * HALF + m * 16) * FF + hc) = w; }
    }
};
struct EpiDown {
    static constexpr bool PERM = true, KEEP = false;
    bf16_t* Y; float s;
    __device__ __forceinline__ void operator()(f32x4 (&acc)[2][2][4][2], const Unit& u, int wr, int wc, int fr, int fq) const {
        const int row0 = u.row0 + wr * 64 + fr, cl = u.col0 + wc * 32 + 8 * fq;
#pragma unroll
        for (int ai = 0; ai < 2; ++ai)
#pragma unroll
            for (int m = 0; m < 4; ++m) { bf16_t* rowp = Y + (size_t)(row0 + ai * HALF + m * 16) * DM + cl;
#pragma unroll
                for (int bj = 0; bj < 2; ++bj) { const f32x4 v0 = acc[ai][bj][m][0] * s, v1 = acc[ai][bj][m][1] * s; u32x4 w; w.x = cvt_pk_bf16(v0[0], v0[1]); w.y = cvt_pk_bf16(v0[2], v0[3]); w.z = cvt_pk_bf16(v1[0], v1[1]); w.w = cvt_pk_bf16(v1[2], v1[3]);
                    *(u32x4*)(rowp + bj * HALF) = w; } }
    }
};
}

__device__ __forceinline__ void st_adaln(KP p, unsigned char* lds) {
    float* sc = (float*)lds;
    float* red = sc + 9 * 1024;
    const int tid = ltid(), wid = tid >> 6, lane = tid & 63;
    __syncthreads();
    for (int i = tid; i < 9 * 1024; i += NTHREADS) { const int r = i >> 10, k = i & 1023; const float v = r < 8 ? p->in[I_C][r * 1024 + k] : p->in[I_CCTX][k]; sc[i] = siluf(v); }
    __syncthreads();
    for (int u = lbid(); u < NL * 96; u += lgrid()) {
        const int l = u / 96, n = (u % 96) * 64 + lane;
        const float* w = p->in[I_WADA] + (size_t)l * 1024 * 6144 + n;
        float a[9];
#pragma unroll
        for (int r = 0; r < 9; ++r) a[r] = 0.f;
#pragma unroll 16
        for (int k = wid * 128; k < wid * 128 + 128; ++k) {
            const float wv = w[(size_t)k * 6144];
#pragma unroll
            for (int r = 0; r < 9; ++r) a[r] += sc[r * 1024 + k] * wv;
        }
#pragma unroll
        for (int r = 0; r < 9; ++r) red[(wid * 9 + r) * 64 + lane] = a[r];
        __syncthreads();
        for (int i = tid; i < 9 * 64; i += NTHREADS) {
            const int r = i >> 6, c = i & 63; float s = 0.f;
#pragma unroll
            for (int w8 = 0; w8 < 8; ++w8) s += red[(w8 * 9 + r) * 64 + c];
            const int nn = (u % 96) * 64 + c;
            p->MOD[((size_t)l * 9 + r) * 6144 + nn] = s + p->in[I_BADA][l * 6144 + nn];
        }
        __syncthreads();
    }
}
template <class RowMap>
__device__ __forceinline__ void cvt_tile(float* tile, const float* src, int N, int k0, int n0, bf16_t* dst, int ldd, int koff, const RowMap& rm, float scale = 1.f) {
    const int tid = ltid();
    __syncthreads();
#pragma unroll
    for (int i = 0; i < 8; ++i) { const int idx = i * NTHREADS + tid, kk = idx >> 6, nn = idx & 63; tile[kk * 65 + nn] = (n0 + nn < N) ? src[(size_t)(k0 + kk) * N + n0 + nn] * scale : 0.f; }
    __syncthreads();
    const int nn = tid >> 3, kc = tid & 7; const int dr = rm(n0 + nn);
    if (n0 + nn < N && dr >= 0) {
        u32x4 w; const float* t = tile + (kc * 8) * 65 + nn;
        w.x = pack2(t[0], t[65]); w.y = pack2(t[130], t[195]); w.z = pack2(t[260], t[325]); w.w = pack2(t[390], t[455]);
        *(u32x4*)(dst + (size_t)dr * ldd + koff + k0 + kc * 8) = w;
    }
}
template <int KT, class RowMap>
__device__ __forceinline__ void cvt_tile8(float* tile, const float* src, int N, int k0, int n0, unsigned char* dst, int ldd, const RowMap& rm, float scale) {
    const int tid = ltid();
    __syncthreads();
#pragma unroll
    for (int i = 0; i < KT / 32; ++i) { const int idx = i * NTHREADS + tid, kk = idx >> 4, n4 = (idx & 15) * 4;
        const f32x4 v = (n0 + n4 < N) ? *(const f32x4*)(src + (size_t)(k0 + kk) * N + n0 + n4) : (f32x4){0.f, 0.f, 0.f, 0.f};
        float* t = tile + kk * 65 + n4; t[0] = v[0] * scale; t[1] = v[1] * scale; t[2] = v[2] * scale; t[3] = v[3] * scale; }
    __syncthreads();
    const int nn = tid >> 3, kc = tid & 7; const int dr = (n0 + nn < N) ? rm(n0 + nn) : -1;
    if (dr >= 0) {
#pragma unroll
        for (int h = 0; h < KT / 64; ++h) { u32x2 w; const float* t = tile + (h * 64 + kc * 8) * 65 + nn;
            w.x = pg8::pk4_fp8(t[0], t[65], t[130], t[195]); w.y = pg8::pk4_fp8(t[260], t[325], t[390], t[455]);
            *(u32x2*)(dst + (size_t)dr * ldd + k0 + h * 64 + kc * 8) = w; } }
}
__device__ __forceinline__ void store_row_fp8(unsigned char* dst, const f32x4 (&x)[4], int lane, float sc) {
#pragma unroll
    for (int i = 0; i < 4; ++i) *(unsigned*)(dst + lane * 4 + 256 * i) = pg8::pk4_fp8(x[i][0] * sc, x[i][1] * sc, x[i][2] * sc, x[i][3] * sc);
}
struct MapIn  { __device__ __forceinline__ int operator()(int n) const { return n < 1536 ? n : ((n < 1568 || n >= 2080) ? -1 : n + 224); } };
struct MapInG { __device__ __forceinline__ int operator()(int n) const { return n >= 2080 ? n - 2080 : -1; } };
struct MapId  { __device__ __forceinline__ int operator()(int n) const { return n; } };
struct MapGU  { int up; __device__ __forceinline__ int operator()(int n) const { return (n >> 7) * 256 + up * 128 + (n & 127); } };
constexpr int CV_IN = 16 * 81, CV_WB = 3 * 64, CV_OUT = 256, CV_G = 16 * 128, CV_D = 16 * 128, CV_LAYER = CV_IN + CV_WB + CV_OUT + 2 * CV_G + CV_D;
__device__ __forceinline__ void st_convert(KP p, unsigned char* lds, int l_lo, int l_hi) {
    float* tile = (float*)lds;
    for (int u = l_lo * CV_LAYER + lbid(); u < l_hi * CV_LAYER; u += lgrid()) {
        const int l = u / CV_LAYER; int r = u % CV_LAYER;
        if (r < CV_IN) { const int nt_ = r % 81;
            if (nt_ <= 32) cvt_tile(tile, p->in[I_WIN] + (size_t)l * DM * INC, INC, (r / 81) * 64, nt_ * 64, p->WIN + (size_t)l * PC * DM, DM, 0, MapIn(), nt_ < 4 ? 0.125f * 1.4426950408889634f : 1.f);
            if (nt_ >= 32) cvt_tile8<64>(tile, p->in[I_WIN] + (size_t)l * DM * INC, INC, (r / 81) * 64, nt_ * 64, p->WING8 + (size_t)l * 3072 * DM, DM, MapInG(), S8_W);
            continue; }
        r -= CV_IN;
        if (r < CV_WB) { const int br = r / 64, t = r % 64; cvt_tile(tile, p->in[I_WBA + br] + (size_t)l * 256 * DM, DM, (t / 16) * 64, (t % 16) * 64, p->WB + (size_t)l * DM * 768, 768, br * 256, MapId()); continue; }
        r -= CV_WB;
        if (r < CV_OUT) { cvt_tile(tile, p->in[I_WOUT] + (size_t)l * DM * DM, DM, (r / 16) * 64, (r % 16) * 64, p->WOUT + (size_t)l * DM * DM, DM, 0, MapId()); continue; }
        r -= CV_OUT;
        if (r < 2 * CV_G) { const int up = r / CV_G, rr = r % CV_G, e = rr / 128, t = rr % 128;
            cvt_tile8<256>(tile, p->in[up ? I_WEU : I_WEG] + ((size_t)l * NE + e) * DM * FF, FF, (t / 32) * 256, (t % 32) * 64, p->WGU + ((size_t)l * NE + e) * 2 * FF * DM, DM, MapGU{up}, S8_W); continue; }
        r -= 2 * CV_G;
        { const int e = r / 128, t = r % 128; cvt_tile8<256>(tile, p->in[I_WED] + ((size_t)l * NE + e) * FF * DM, DM, (t / 16) * 256, (t % 16) * 64, p->WD + ((size_t)l * NE + e) * DM * FF, FF, MapId(), S8_W); }
    }
}
__device__ __forceinline__ void st_fold(KP p) {
    for (int i = lbid() * NTHREADS + ltid(); i < NL * 256 * DM; i += lgrid() * NTHREADS) {
        const int l = i / (256 * DM), r = i % (256 * DM), nn = r / DM, k = r % DM, dir = nn >> 7, n = nn & 127;
        const float* wi = p->in[I_WIN] + ((size_t)l * DM + k) * INC + 1536 + dir * 16;
        const float* wg = p->in[dir ? I_WGB : I_WGF] + (size_t)l * 16 * 128 + n;
        float s = 0.f;
#pragma unroll
        for (int j = 0; j < 16; ++j) s += wi[j] * wg[j * 128];
        p->WIN[((size_t)l * PC + C_G + nn) * DM + k] = f2bf(s);
    }
}
__device__ __forceinline__ void norm_mod_row(f32x4 (&x)[4], const float* g, const float* sh, const float* sc, int lane) {
    float ss = 0.f;
#pragma unroll
    for (int i = 0; i < 4; ++i) ss += x[i][0] * x[i][0] + x[i][1] * x[i][1] + x[i][2] * x[i][2] + x[i][3] * x[i][3];
    ss = wave_sum(ss);
    const float rs = rsqrtf(ss * (1.f / DM) + EPS);
#pragma unroll
    for (int i = 0; i < 4; ++i) {
        const int c = lane * 4 + 256 * i;
        const f32x4 gv = *(const f32x4*)(g + c), sv = *(const f32x4*)(sh + c), cv = *(const f32x4*)(sc + c);
        x[i] = (x[i] * rs) * gv * (cv + 1.f) + sv;
    }
}
__device__ __forceinline__ void store_row_bf16(bf16_t* dst, const f32x4 (&x)[4], int lane) {
#pragma unroll
    for (int i = 0; i < 4; ++i) { u32x2 w; w.x = pack2(x[i][0], x[i][1]); w.y = pack2(x[i][2], x[i][3]); *(u32x2*)(dst + lane * 4 + 256 * i) = w; }
}
__device__ __forceinline__ void store_row_fp8(unsigned char* dst, const f32x4 (&x)[4], int lane, float sc);
__device__ __forceinline__ void st_norm1(KP p, int l) {
    const int wid = ltid() >> 6, lane = ltid() & 63;
    const float* mod = p->MOD + (size_t)l * 9 * 6144; const float* g = p->in[I_N1G] + l * DM;
    for (int R = lbid() * 8 + wid; R < MT; R += lgrid() * 8) {
        const float* src = R < NLAT ? p->in[I_X] + (size_t)R * DM : p->in[I_CTX] + (size_t)(R - NLAT) * DM;
        f32x4 x[4];
#pragma unroll
        for (int i = 0; i < 4; ++i) { x[i] = *(const f32x4*)(src + lane * 4 + 256 * i); *(f32x4*)(p->X + (size_t)R * DM + lane * 4 + 256 * i) = x[i]; }
        const float* m = mod + mod_row(R) * 6144;
        norm_mod_row(x, g, m, m + 1024, lane);
        store_row_bf16(p->U + (size_t)R * DM, x, lane);
        store_row_fp8(p->U8W + (size_t)R * DM, x, lane, S8_U);
    }
}

__device__ __forceinline__ void st_qkrope(KP p, int l, unsigned char* lds) {
    float* tab = (float*)lds;
    const int tid = ltid(), wid = tid >> 6, lane = tid & 63;
    __syncthreads();
    for (int i = tid; i < 1024; i += NTHREADS) { const int pos = i >> 4, f = i & 15; const float inv = powf(10000.f, -(float)f / 16.f); const float a = (float)pos * inv; tab[i] = cosf(a); tab[1024 + i] = sinf(a); }
    __syncthreads();
    const float qg = p->in[I_QNG][l * 64 + lane] * (0.125f * 1.4426950408889634f), kg = p->in[I_KNG][l * 64 + lane];
    const int f = lane & 15;
    const int stride = lgrid() * 8;
    for (int R0 = lbid() * 8 + wid; R0 < MT; R0 += 2 * stride) {
        const int R1 = R0 + stride; const bool has1 = R1 < MT;
        bf16_t* p0 = p->P + (size_t)R0 * PC + C_QC + lane; bf16_t* p1 = p->P + (size_t)(has1 ? R1 : R0) * PC + C_QC + lane;
        float v0[6], v1[6];
#pragma unroll
        for (int j = 0; j < 6; ++j) { v0[j] = bf2f(p0[j * 64]); v1[j] = bf2f(p1[j * 64]); }
#pragma unroll
        for (int rr = 0; rr < 2; ++rr) {
            const int R = rr ? R1 : R0; if (rr && !has1) break;
            bf16_t* pp = rr ? p1 : p0;
#pragma unroll
            for (int j = 0; j < 6; ++j) {
                float v = rr ? v1[j] : v0[j];
                const float ss = wave_sum(v * v);
                v = v * rsqrtf(ss * (1.f / 64.f) + EPS) * (j < 4 ? qg : kg);
                if (R < NLAT) {
                    const int t = R & (TL - 1), pos = (lane < 32) ? (t >> 6) : (t & 63);
                    const float other = __shfl_xor(v, 16);
                    const float c = tab[pos * 16 + f], sn = tab[1024 + pos * 16 + f];
                    v = (lane & 16) ? (v * c + other * sn) : (v * c - other * sn);
                }
                pp[j * 64] = f2bf(v);
            }
        }
    }
}

namespace att {
typedef float f32x16 __attribute__((ext_vector_type(16)));
typedef short s16x4 __attribute__((ext_vector_type(4)));
constexpr int NSLOT = 3, SLOTB = 8192;
constexpr int LDS_K = 0, LDS_V = NSLOT * SLOTB, LDS_WS = 2 * NSLOT * SLOTB, LDS_OST = LDS_WS + 8 * 64 * 4, LDS_BIAS = LDS_OST + 8 * 4096, LDS_TOTAL = LDS_BIAS + 16 * 32 * 4;
constexpr float C2 = 0.125f * 1.4426950408889634f;
constexpr float LOG2E = 1.4426950408889634f;
constexpr float THR = 8.f;
__device__ __forceinline__ int crow(int r, int hi) { return (r & 3) + 8 * (r >> 2) + 4 * hi; }
__device__ __forceinline__ void glds16(const void* gsrc, unsigned lds_dst) { unsigned keep;
    asm volatile("s_mov_b32 %0, m0\n\ts_mov_b32 m0, %2\n\ts_nop 0\n\tglobal_load_lds_dwordx4 %1, off\n\ts_mov_b32 m0, %0" : "=&s"(keep) : "v"(gsrc), "s"(lds_dst) : "memory"); }
__device__ __forceinline__ unsigned cvtpk(float lo, float hi) { unsigned r; asm volatile("v_cvt_pk_bf16_f32 %0, %1, %2" : "=v"(r) : "v"(lo), "v"(hi)); return r; }
#define ATT_WAIT_BAR(N) asm volatile("s_waitcnt vmcnt(" #N ") lgkmcnt(0)\n\ts_barrier" ::: "memory")
__device__ __forceinline__ void qkt(f32x16& p0, f32x16& p1, const LAS unsigned char* Kslot, const bf16x8* qr, const f32x16& negm, int r32, int hi) {
    const unsigned ka = (unsigned)(uintptr_t)(Kslot + hi * 1024 + r32 * 16);
    bf16x8 b[8];
#pragma unroll
    for (int i = 0; i < 8; ++i) asm volatile("ds_read_b128 %0, %1 offset:%c2" : "=&v"(b[i]) : "v"(ka), "i"((i >> 1) * 2048 + (i & 1) * 512) : "memory");
    asm volatile("s_waitcnt lgkmcnt(6)" ::: "memory"); __builtin_amdgcn_sched_barrier(0);
    p0 = __builtin_amdgcn_mfma_f32_32x32x16_bf16(b[0], qr[0], negm, 0, 0, 0); p1 = __builtin_amdgcn_mfma_f32_32x32x16_bf16(b[1], qr[0], negm, 0, 0, 0);
    asm volatile("s_waitcnt lgkmcnt(4)" ::: "memory"); __builtin_amdgcn_sched_barrier(0);
    p0 = __builtin_amdgcn_mfma_f32_32x32x16_bf16(b[2], qr[1], p0, 0, 0, 0); p1 = __builtin_amdgcn_mfma_f32_32x32x16_bf16(b[3], qr[1], p1, 0, 0, 0);
    asm volatile("s_waitcnt lgkmcnt(2)" ::: "memory"); __builtin_amdgcn_sched_barrier(0);
    p0 = __builtin_amdgcn_mfma_f32_32x32x16_bf16(b[4], qr[2], p0, 0, 0, 0); p1 = __builtin_amdgcn_mfma_f32_32x32x16_bf16(b[5], qr[2], p1, 0, 0, 0);
    asm volatile("s_waitcnt lgkmcnt(0)" ::: "memory"); __builtin_amdgcn_sched_barrier(0);
    p0 = __builtin_amdgcn_mfma_f32_32x32x16_bf16(b[6], qr[3], p0, 0, 0, 0); p1 = __builtin_amdgcn_mfma_f32_32x32x16_bf16(b[7], qr[3], p1, 0, 0, 0);
}
__device__ __forceinline__ float rowmax(const f32x16& p0, const f32x16& p1) {
    float a = fmaxf(fmaxf(p0[0], p0[1]), p1[0]), b = fmaxf(fmaxf(p0[2], p0[3]), p1[1]); a = fmaxf(fmaxf(a, p1[2]), p1[3]);
#pragma unroll
    for (int r = 4; r < 16; r += 4) { a = fmaxf(fmaxf(a, p0[r]), p0[r + 1]); b = fmaxf(fmaxf(b, p0[r + 2]), p0[r + 3]); a = fmaxf(fmaxf(a, p1[r]), p1[r + 1]); b = fmaxf(fmaxf(b, p1[r + 2]), p1[r + 3]); }
    const float m = fmaxf(a, b);
    auto rr = __builtin_amdgcn_permlane32_swap(__float_as_uint(m), __float_as_uint(m), false, false);
    return fmaxf(__uint_as_float(rr[0]), __uint_as_float(rr[1]));
}
__device__ __forceinline__ void pv(f32x16* o, int vb, bf16x8 pa0, bf16x8 pa1, bf16x8 pa2, bf16x8 pa3) {
#pragma unroll
    for (int d0 = 0; d0 < 2; ++d0) { s16x4 lo[4], hi[4];
#pragma unroll
        for (int ks = 0; ks < 4; ++ks) {
            asm volatile("ds_read_b64_tr_b16 %0,%1 offset:%c2" : "=&v"(lo[ks]) : "v"(vb), "i"(d0 * 4096 + ks * 1024) : "memory");
            asm volatile("ds_read_b64_tr_b16 %0,%1 offset:%c2" : "=&v"(hi[ks]) : "v"(vb), "i"(d0 * 4096 + ks * 1024 + 512) : "memory"); }
        asm volatile("s_waitcnt lgkmcnt(0)" ::: "memory"); __builtin_amdgcn_sched_barrier(0);
#define ATT_PK(k) (bf16x8){lo[k][0], lo[k][1], lo[k][2], lo[k][3], hi[k][0], hi[k][1], hi[k][2], hi[k][3]}
        o[d0] = __builtin_amdgcn_mfma_f32_32x32x16_bf16(pa0, ATT_PK(0), o[d0], 0, 0, 0);
        o[d0] = __builtin_amdgcn_mfma_f32_32x32x16_bf16(pa1, ATT_PK(1), o[d0], 0, 0, 0);
        o[d0] = __builtin_amdgcn_mfma_f32_32x32x16_bf16(pa2, ATT_PK(2), o[d0], 0, 0, 0);
        o[d0] = __builtin_amdgcn_mfma_f32_32x32x16_bf16(pa3, ATT_PK(3), o[d0], 0, 0, 0);
#undef ATT_PK
    }
}
struct Desc {
    const bf16_t* Q;
    const bf16_t* KV;
    bf16_t* O;
    int kcol, vcol;
    int NT;
    int ctx_row0;
    int lat_row0;
    int rlo;
    int qrow;
};
template <int MODE>
__device__ __forceinline__ void attn_unit(const Desc& D, LAS unsigned char* shm) {
    const int tid = ltid(), lane = tid & 63, r32 = lane & 31, hi = lane >> 5; const int wid = __builtin_amdgcn_readfirstlane(tid >> 6);
    const unsigned lds0 = (unsigned)(uintptr_t)shm;
    LAS float* wsf = (LAS float*)(shm + LDS_WS) + wid * 64;
    const bf16_t* Qw = D.Q + (size_t)(wid * 32) * PC;
    bf16x8 qr[4];
#pragma unroll
    for (int d0 = 0; d0 < 4; ++d0) qr[d0] = *(const bf16x8*)(Qw + (size_t)r32 * PC + d0 * 16 + hi * 8);
    const bf16_t* kbase = D.KV + D.kcol + wid * 8 + (size_t)lane * PC;
    const bf16_t* vbase = D.KV + D.vcol + (wid >> 2) * 32 + (lane & 3) * 8 + (size_t)(16 * (wid & 3) + (lane >> 2)) * PC;
    const unsigned kdst = lds0 + LDS_K + wid * 1024, vdst = lds0 + LDS_V + wid * 1024;
    const int NT = D.NT;
#define ATT_TROW(t) ((t) < 4 ? D.ctx_row0 + 64 * (t) : D.lat_row0 + 64 * ((t) - 4))
#define ATT_DMA(t, slotoff) do { const int t_ = (t) < NT ? (t) : NT - 1; const size_t ro_ = (size_t)ATT_TROW(t_) * PC; \
        glds16(kbase + ro_, (unsigned)__builtin_amdgcn_readfirstlane(kdst + (slotoff))); glds16(vbase + ro_, (unsigned)__builtin_amdgcn_readfirstlane(vdst + (slotoff))); } while (0)
    ATT_DMA(0, 0); ATT_DMA(1, SLOTB);
    const int vb0 = (int)(lds0 + LDS_V) + ((lane >> 4) & 1) * 32 + (lane & 3) * 8 + (4 * hi + ((lane & 15) >> 2)) * 64;
    float mhat = 0.f, l_reg = 0.f; f32x16 o[2]; o[0] = f32x16{}; o[1] = f32x16{}; f32x16 negm = f32x16{};
    const int rq = D.qrow + (wid >> 1), cq = (wid & 1) * 32 + r32;
    const int rs = min(max(rq - 4, 0), 56), cs = min(max(cq - 8, 0), 48);
    const int L0 = 4 * hi - cq + 15, L1 = 4 * hi - cs;
    const LAS float* btab = (const LAS float*)(shm + LDS_BIAS);
    int slot = 0;
    for (int t = 0; t < NT; ++t) {
        ATT_WAIT_BAR(2);
        { const int s2 = slot == 0 ? 2 * SLOTB : slot - SLOTB; ATT_DMA(t + 2, s2); }
        bool active = true; int kr = 0;
        if (MODE == 1 && t >= 4) { kr = D.rlo + (t - 4); active = (kr >= rs) && (kr < rs + 8); }
        if (active) {
            f32x16 p0, p1;
            qkt(p0, p1, shm + LDS_K + slot, qr, negm, r32, hi);
            if (MODE == 1 && t >= 4) {
                const LAS float* brow = btab + (kr - rq + 7) * 32;
#pragma unroll
                for (int r = 0; r < 16; ++r) { const int kc = (r & 3) + 8 * (r >> 2);
                    { const int ix = L0 + kc, iv = L1 + kc; const float bv = brow[min(max(ix, 0), 30)]; p0[r] = ((unsigned)iv < 16u) ? p0[r] + bv : -INFINITY; }
                    { const int ix = L0 + kc + 32, iv = L1 + kc + 32; const float bv = brow[min(max(ix, 0), 30)]; p1[r] = ((unsigned)iv < 16u) ? p1[r] + bv : -INFINITY; } }
            }
            const float rm = rowmax(p0, p1);
            bool resc = false;
            if (t == 0) { mhat = rm;
#pragma unroll
                for (int r = 0; r < 16; ++r) { p0[r] -= rm; p1[r] -= rm; negm[r] = -mhat; }
            } else if (__any(rm > THR)) { const float dl = fmaxf(rm, 0.f); mhat += dl;
#pragma unroll
                for (int r = 0; r < 16; ++r) { p0[r] -= dl; p1[r] -= dl; negm[r] = -mhat; }
                const float f = __builtin_amdgcn_exp2f(-dl); l_reg *= f; if (hi == 0) wsf[r32] = f; resc = true; }
            float sacc = 0.f;
#pragma unroll
            for (int r = 0; r < 16; ++r) { p0[r] = __builtin_amdgcn_exp2f(p0[r]); p1[r] = __builtin_amdgcn_exp2f(p1[r]); sacc += p0[r] + p1[r]; }
            l_reg += sacc;
            u32x4 pw0, pw1, pw2, pw3;
            pw0 = (u32x4){cvtpk(p0[0], p0[1]), cvtpk(p0[2], p0[3]), cvtpk(p0[4], p0[5]), cvtpk(p0[6], p0[7])};
            pw1 = (u32x4){cvtpk(p0[8], p0[9]), cvtpk(p0[10], p0[11]), cvtpk(p0[12], p0[13]), cvtpk(p0[14], p0[15])};
            pw2 = (u32x4){cvtpk(p1[0], p1[1]), cvtpk(p1[2], p1[3]), cvtpk(p1[4], p1[5]), cvtpk(p1[6], p1[7])};
            pw3 = (u32x4){cvtpk(p1[8], p1[9]), cvtpk(p1[10], p1[11]), cvtpk(p1[12], p1[13]), cvtpk(p1[14], p1[15])};
            if (resc) { asm volatile("s_waitcnt lgkmcnt(0)" ::: "memory");
#pragma unroll
                for (int r = 0; r < 16; ++r) { const float f = wsf[crow(r, hi)]; o[0][r] *= f; o[1][r] *= f; } }
            __builtin_amdgcn_sched_barrier(0);
            pv(o, vb0 + slot, __builtin_bit_cast(bf16x8, pw0), __builtin_bit_cast(bf16x8, pw1), __builtin_bit_cast(bf16x8, pw2), __builtin_bit_cast(bf16x8, pw3));
        }
        slot = slot == 2 * SLOTB ? 0 : slot + SLOTB;
    }
    { auto rr = __builtin_amdgcn_permlane32_swap(__float_as_uint(l_reg), __float_as_uint(l_reg), false, false); l_reg = __uint_as_float(rr[0]) + __uint_as_float(rr[1]); }
    if (hi == 0) wsf[32 + r32] = l_reg;
    asm volatile("s_waitcnt lgkmcnt(0)" ::: "memory");
    float rli[16];
#pragma unroll
    for (int r = 0; r < 16; ++r) rli[r] = __builtin_amdgcn_rcpf(wsf[32 + crow(r, hi)]);
    bf16_t* Ow = D.O + (size_t)(wid * 32) * 768;
    { LAS bf16_t* stg = (LAS bf16_t*)(shm + LDS_OST) + wid * 2048;
#pragma unroll
      for (int r = 0; r < 16; ++r) { const int orow = crow(r, hi);
#pragma unroll
          for (int d0 = 0; d0 < 2; ++d0) stg[orow * 64 + d0 * 32 + r32] = f2bf(o[d0][r] * rli[r]); }
      asm volatile("s_waitcnt lgkmcnt(0)" ::: "memory");
#pragma unroll
      for (int i = 0; i < 4; ++i) { const int row = i * 8 + (lane >> 3), ch = lane & 7; const u32x4 v = *(const LAS u32x4*)(stg + row * 64 + ch * 8); *(u32x4*)(Ow + (size_t)row * 768 + ch * 8) = v; } }
    asm volatile("s_waitcnt vmcnt(0) lgkmcnt(0)\n\ts_barrier" ::: "memory");
#undef ATT_TROW
#undef ATT_DMA
}
}
__device__ __forceinline__ void attn_one(KP p, int l, int u, bool na, LAS unsigned char* shm);
__device__ __forceinline__ void st_attn(KP p, int l, bool with_ctx, bool na, LAS unsigned char* shm) {
    const int tid = ltid();
    if (na) {
        asm volatile("s_waitcnt lgkmcnt(0)\n\ts_barrier" ::: "memory");
        LAS float* bt = (LAS float*)(shm + att::LDS_BIAS);
        (void)bt;
    }
    const int nlat = NB * 4 * 16, nun = nlat + (with_ctx ? NB * 4 : 0);
    for (int u = lbid(); u < nun; u += lgrid()) attn_one(p, l, u, na, shm);
}
__device__ __forceinline__ void attn_one(KP p, int l, int u, bool na, LAS unsigned char* shm) {
    const int tid = ltid(); const int nlat = NB * 4 * 16;
    {
        att::Desc D;
        const bool isc = u >= nlat; const int uu = isc ? u - nlat : u;
        const int b = isc ? uu >> 2 : uu >> 6, h = isc ? uu & 3 : (uu >> 4) & 3, qb = isc ? 0 : uu & 15;
        const int qrow0 = isc ? NLAT + b * SC : b * TL + qb * 256;
        D.ctx_row0 = NLAT + b * SC; D.NT = 4; D.lat_row0 = b * TL; D.rlo = 0; D.qrow = qb * 4;
        if (na) {
            D.Q = p->P + (size_t)qrow0 * PC + C_QA + h * 64; D.KV = p->P; D.kcol = C_KA + h * 64; D.vcol = C_VA + h * 64; D.O = p->YCAT + (size_t)qrow0 * 768 + h * 64;
            if (!isc) { const int rlo = min(max(qb * 4 - 4, 0), 56), rhi = min(max(qb * 4 - 1, 0), 56) + 7; D.rlo = rlo; D.lat_row0 = b * TL + rlo * 64; D.NT = 4 + (rhi - rlo + 1);
                LAS float* bt = (LAS float*)(shm + att::LDS_BIAS); const float* rpb = p->in[I_RPB] + ((size_t)l * 4 + h) * 15 * 31;
                if (tid < 15 * 32) { const int dr = tid >> 5, dc = tid & 31; bt[tid] = dc < 31 ? rpb[dr * 31 + dc] * att::LOG2E : 0.f; }
                asm volatile("s_waitcnt lgkmcnt(0)\n\ts_barrier" ::: "memory");
                att::attn_unit<1>(D, shm);
            } else att::attn_unit<0>(D, shm);
        } else {
            const int kvh = h >> 1;
            D.Q = p->P + (size_t)qrow0 * PC + C_QC + h * 64; D.KV = p->P; D.kcol = C_KC + kvh * 64; D.vcol = C_VC + kvh * 64; D.O = p->YCAT + (size_t)qrow0 * 768 + 512 + h * 64;
            if (!isc) D.NT = 68;
            att::attn_unit<0>(D, shm);
        }
    }
}

__device__ __forceinline__ int gla_row(int b, int c, int j) { return c < 4 ? NLAT + b * SC + c * 64 + j : b * TL + (c - 4) * 64 + j; }
namespace gla {
constexpr int G_OFF = 0, KT_OFF = 65536, VTS_OFF = 65536 + 36864, QD_OFF = 65536, KI_OFF = 65536 + 40960, VTO_OFF = 0, X_OFF = 65536, LDS_TOTAL = 65536 + 81920;
typedef short s16x4 __attribute__((ext_vector_type(4)));
__device__ __forceinline__ f32x4 mfma16(bf16x8 a, bf16x8 b, f32x4 c) { return __builtin_amdgcn_mfma_f32_16x16x32_bf16(a, b, c, 0, 0, 0); }
__device__ __forceinline__ void gates_cumsum(KP p, int l, int b, int c, LAS unsigned char* shm, int tid) {
    LAS float* Gs = (LAS float*)(shm + G_OFF);
    { const int j = tid >> 3, part = tid & 7; const bf16_t* src = p->P + (size_t)gla_row(b, c, j) * PC + C_G + part * 32;
      const float* bias = (part < 4 ? p->in[I_BGF] + l * 128 + part * 32 : p->in[I_BGB] + l * 128 + (part - 4) * 32);
#pragma unroll
      for (int q = 0; q < 4; ++q) { const u32x4 w = *(const u32x4*)(src + q * 8); const f32x4 b0 = *(const f32x4*)(bias + q * 8), b1 = *(const f32x4*)(bias + q * 8 + 4);
          LAS float* d = Gs + j * 256 + part * 32 + q * 8;
          *(LAS f32x4*)d = (f32x4){logsig16(bflo(w.x) + b0[0]), logsig16(bfhi(w.x) + b0[1]), logsig16(bflo(w.y) + b0[2]), logsig16(bfhi(w.y) + b0[3])};
          *(LAS f32x4*)(d + 4) = (f32x4){logsig16(bflo(w.z) + b1[0]), logsig16(bfhi(w.z) + b1[1]), logsig16(bflo(w.w) + b1[2]), logsig16(bfhi(w.w) + b1[3])}; } }
    __syncthreads();
    if (tid < 256) {
        float v[64];
#pragma unroll
        for (int j = 0; j < 64; ++j) v[j] = Gs[j * 256 + tid];
        if (tid < 128) {
#pragma unroll
            for (int j = 1; j < 64; ++j) v[j] += v[j - 1];
        } else {
#pragma unroll
            for (int j = 62; j >= 0; --j) v[j] += v[j + 1];
        }
#pragma unroll
        for (int j = 0; j < 64; ++j) Gs[j * 256 + tid] = v[j];
    }
    __syncthreads();
}
__device__ __forceinline__ void build_vt(KP p, int b, int c, LAS unsigned char* vt, int tid) {
    const int j = tid & 63, w = tid >> 6; const bf16_t* src = p->P + (size_t)gla_row(b, c, j) * PC + C_VB + w * 32;
    LAS bf16_t* dst = (LAS bf16_t*)(vt + (w >> 1) * 9216 + ((w & 1) * 32) * 144) + j;
#pragma unroll
    for (int q = 0; q < 4; ++q) { const u32x4 x = *(const u32x4*)(src + q * 8);
        dst[(q * 8 + 0) * 72] = (bf16_t)(x.x & 0xFFFF); dst[(q * 8 + 1) * 72] = (bf16_t)(x.x >> 16); dst[(q * 8 + 2) * 72] = (bf16_t)(x.y & 0xFFFF); dst[(q * 8 + 3) * 72] = (bf16_t)(x.y >> 16);
        dst[(q * 8 + 4) * 72] = (bf16_t)(x.z & 0xFFFF); dst[(q * 8 + 5) * 72] = (bf16_t)(x.z >> 16); dst[(q * 8 + 6) * 72] = (bf16_t)(x.w & 0xFFFF); dst[(q * 8 + 7) * 72] = (bf16_t)(x.w >> 16); }
}
}
__device__ __forceinline__ void gla_states_one(KP p, int l, int u, LAS unsigned char* shm);
__device__ __forceinline__ void st_gla_states2(KP p, int l, LAS unsigned char* shm) {
    const int tid = ltid(), lane = tid & 63, l15 = lane & 15, kg = lane >> 4; const int w = __builtin_amdgcn_readfirstlane(tid >> 6);
    LAS float* Gs = (LAS float*)(shm + gla::G_OFF);
    for (int u = lbid(); u < NB * NCH; u += lgrid()) gla_states_one(p, l, u, shm);
    __syncthreads();
}
__device__ __forceinline__ void gla_states_one(KP p, int l, int u, LAS unsigned char* shm) {
    const int tid = ltid(), lane = tid & 63, l15 = lane & 15, kg = lane >> 4; const int w = __builtin_amdgcn_readfirstlane(tid >> 6);
    LAS float* Gs = (LAS float*)(shm + gla::G_OFF);
    {
        const int b = u / NCH, c = u % NCH;
        __syncthreads();
        gla::gates_cumsum(p, l, b, c, shm, tid);
        {
          const int dir = w >> 2, h = w & 3, j = lane; const bf16_t* src = p->P + (size_t)gla_row(b, c, j) * PC + C_KB + h * 32;
          LAS bf16_t* dst = (LAS bf16_t*)(shm + gla::KT_OFF + w * 4608) + j;
          const LAS float* gb = Gs + j * 256 + dir * 128 + h * 32; const LAS float* gl = Gs + (dir ? 0 : 63) * 256 + dir * 128 + h * 32;
#pragma unroll
          for (int q = 0; q < 4; ++q) { const u32x4 x = *(const u32x4*)(src + q * 8); const unsigned xs[4] = {x.x, x.y, x.z, x.w};
#pragma unroll
              for (int e = 0; e < 8; ++e) { const int kk = q * 8 + e; const float kv = (e & 1) ? bfhi(xs[e >> 1]) : bflo(xs[e >> 1]);
                  dst[kk * 72] = f2bf(kv * __expf(gl[kk] - gb[kk])); } } }
        gla::build_vt(p, b, c, shm + gla::VTS_OFF, tid);
        if (tid < 256) { const int dir = tid >> 7, h = (tid >> 5) & 3, kk = tid & 31; p->DEC[((((size_t)b * 2 + dir) * NCH + c) * 4 + h) * 32 + kk] = __expf(Gs[(dir ? 0 : 63) * 256 + tid]); }
        __syncthreads();
        { const int dir = w >> 2, h = w & 3;
          const LAS unsigned char* vt = shm + gla::VTS_OFF + h * 9216; const LAS unsigned char* kt = shm + gla::KT_OFF + w * 4608;
          float* dst = p->DST + ((((size_t)b * 2 + dir) * NCH + c) * 4 + h) * 2048;
#pragma unroll
          for (int ki = 0; ki < 2; ++ki) { const bf16x8 kb0 = *(const LAS bf16x8*)(kt + (ki * 16 + l15) * 144 + kg * 16), kb1 = *(const LAS bf16x8*)(kt + (ki * 16 + l15) * 144 + 64 + kg * 16);
#pragma unroll
              for (int vi = 0; vi < 4; ++vi) { const bf16x8 va0 = *(const LAS bf16x8*)(vt + (vi * 16 + l15) * 144 + kg * 16), va1 = *(const LAS bf16x8*)(vt + (vi * 16 + l15) * 144 + 64 + kg * 16);
                  f32x4 acc = (f32x4){0.f, 0.f, 0.f, 0.f}; acc = gla::mfma16(va0, kb0, acc); acc = gla::mfma16(va1, kb1, acc);
                  *(f32x4*)(dst + (ki * 16 + l15) * 64 + vi * 16 + 4 * kg) = acc; } } }
    }
    __syncthreads();
}
__device__ __forceinline__ void st_gla_scan2(KP p) {
    for (int i = lbid() * NTHREADS + ltid(); i < NB * 2 * 4 * 2048; i += lgrid() * NTHREADS) {
        const int e = i & 2047, h = (i >> 11) & 3, dir = (i >> 13) & 1, b = i >> 14, kk = e >> 6;
        float s = 0.f;
#pragma unroll 1
        for (int n0 = 0; n0 < NCH; n0 += 17) {
            float d[17], dc[17]; size_t base[17];
#pragma unroll
            for (int q = 0; q < 17; ++q) { const int n = n0 + q; const int c = dir == 0 ? n : (n < 4 ? 3 - n : 71 - n);
                base[q] = (((size_t)b * 2 + dir) * NCH + c) * 4 + h; d[q] = p->DST[base[q] * 2048 + e]; dc[q] = p->DEC[base[q] * 32 + kk]; }
#pragma unroll
            for (int q = 0; q < 17; ++q) { p->ST[base[q] * 2048 + e] = f2bf(s); s = dc[q] * s + d[q]; }
        }
    }
}
__device__ __forceinline__ void st_gla_out2(KP p, int l, bool with_ctx, LAS unsigned char* shm) {
    const int tid = ltid(), lane = tid & 63, l15 = lane & 15, kg = lane >> 4; const int w = __builtin_amdgcn_readfirstlane(tid >> 6);
    LAS float* Gs = (LAS float*)(shm + gla::G_OFF);
    const float qs = 0.17677669529663687f;
    for (int u = lbid(); u < NB * NCH; u += lgrid()) {
        const int b = u / NCH, c = u % NCH;
        if (!with_ctx && c < 4) continue;
        __syncthreads();
        gla::gates_cumsum(p, l, b, c, shm, tid);
        {
          const int j = tid >> 3, part = tid & 7, h = part >> 1, kk0 = (part & 1) * 16; const size_t ro = (size_t)gla_row(b, c, j) * PC;
          const u32x4 q0 = *(const u32x4*)(p->P + ro + C_QB + part * 16), q1 = *(const u32x4*)(p->P + ro + C_QB + part * 16 + 8);
          const u32x4 k0 = *(const u32x4*)(p->P + ro + C_KB + part * 16), k1 = *(const u32x4*)(p->P + ro + C_KB + part * 16 + 8);
          const unsigned qx[8] = {q0.x, q0.y, q0.z, q0.w, q1.x, q1.y, q1.z, q1.w}, kx[8] = {k0.x, k0.y, k0.z, k0.w, k1.x, k1.y, k1.z, k1.w};
#pragma unroll
          for (int dir = 0; dir < 2; ++dir) { const LAS float* gb = Gs + j * 256 + dir * 128 + part * 16; unsigned qo[8], ko[8];
#pragma unroll
              for (int e = 0; e < 8; ++e) { const float g0 = gb[2 * e], g1 = gb[2 * e + 1];
                  qo[e] = pack2(bflo(qx[e]) * qs * __expf(g0), bfhi(qx[e]) * qs * __expf(g1)); ko[e] = pack2(bflo(kx[e]) * __expf(-g0), bfhi(kx[e]) * __expf(-g1)); }
              LAS unsigned char* qd = shm + gla::QD_OFF + (dir * 4 + h) * 5120 + j * 80 + kk0 * 2; LAS unsigned char* ki = shm + gla::KI_OFF + (dir * 4 + h) * 5120 + j * 80 + kk0 * 2;
              *(LAS u32x4*)qd = (u32x4){qo[0], qo[1], qo[2], qo[3]}; *(LAS u32x4*)(qd + 16) = (u32x4){qo[4], qo[5], qo[6], qo[7]};
              *(LAS u32x4*)ki = (u32x4){ko[0], ko[1], ko[2], ko[3]}; *(LAS u32x4*)(ki + 16) = (u32x4){ko[4], ko[5], ko[6], ko[7]}; } }
        __syncthreads();
        gla::build_vt(p, b, c, shm + gla::VTO_OFF, tid);
        __syncthreads();
        const int dir = w >> 2, h = w & 3;
        f32x4 acc[4][4];
#pragma unroll
        for (int ti = 0; ti < 4; ++ti)
#pragma unroll
            for (int vi = 0; vi < 4; ++vi) acc[ti][vi] = (f32x4){0.f, 0.f, 0.f, 0.f};
        { const LAS unsigned char* qd = shm + gla::QD_OFF + w * 5120; const LAS unsigned char* ki = shm + gla::KI_OFF + w * 5120; const LAS unsigned char* vt = shm + gla::VTO_OFF + h * 9216;
          const bf16_t* st = p->ST + ((((size_t)b * 2 + dir) * NCH + c) * 4 + h) * 2048;
          bf16x8 sfr[4];
#pragma unroll
          for (int vi = 0; vi < 4; ++vi) {
#pragma unroll
              for (int j = 0; j < 8; ++j) sfr[vi][j] = (short)st[(kg * 8 + j) * 64 + vi * 16 + l15]; }
#pragma unroll
          for (int ti = 0; ti < 4; ++ti) {
              const bf16x8 qf = *(const LAS bf16x8*)(qd + (ti * 16 + l15) * 80 + kg * 16);
              const int ig = ti * 16 + l15;
              unsigned pk[4][2];
#pragma unroll
              for (int tj = 0; tj < 4; ++tj) {
                  const bf16x8 kf = *(const LAS bf16x8*)(ki + (tj * 16 + l15) * 80 + kg * 16);
                  f32x4 a2 = gla::mfma16(kf, qf, (f32x4){0.f, 0.f, 0.f, 0.f});
#pragma unroll
                  for (int jj = 0; jj < 4; ++jj) { const int jg = tj * 16 + 4 * kg + jj; const bool ok = dir == 0 ? (jg <= ig) : (jg >= ig); a2[jj] = ok ? a2[jj] : 0.f; }
                  pk[tj][0] = pack2(a2[0], a2[1]); pk[tj][1] = pack2(a2[2], a2[3]);
              }
#pragma unroll
              for (int s2 = 0; s2 < 2; ++s2) {
                  const u32x4 bw = (u32x4){pk[2 * s2][0], pk[2 * s2][1], pk[2 * s2 + 1][0], pk[2 * s2 + 1][1]}; const bf16x8 bfr = __builtin_bit_cast(bf16x8, bw);
#pragma unroll
                  for (int vi = 0; vi < 4; ++vi) {
                      const LAS unsigned char* vr = vt + (vi * 16 + l15) * 144 + kg * 8;
                      const u32x2 lo = *(const LAS u32x2*)(vr + (2 * s2) * 32), hi2 = *(const LAS u32x2*)(vr + (2 * s2 + 1) * 32);
                      const u32x4 aw = (u32x4){lo.x, lo.y, hi2.x, hi2.y};
                      acc[ti][vi] = gla::mfma16(__builtin_bit_cast(bf16x8, aw), bfr, acc[ti][vi]);
                  }
              }
#pragma unroll
              for (int vi = 0; vi < 4; ++vi) acc[ti][vi] = gla::mfma16(sfr[vi], qf, acc[ti][vi]);
          } }
        __syncthreads();
        { LAS f32x4* xo = (LAS f32x4*)(shm + gla::X_OFF + w * 8192);
#pragma unroll
          for (int t2 = 0; t2 < 2; ++t2)
#pragma unroll
              for (int vi = 0; vi < 4; ++vi) xo[(t2 * 4 + vi) * 64 + lane] = dir == 0 ? acc[2 + t2][vi] : acc[t2][vi]; }
        __syncthreads();
        { const LAS f32x4* xi = (const LAS f32x4*)(shm + gla::X_OFF + (w ^ 4) * 8192);
          const float* gg = p->in[I_GLAG] + l * 64;
#pragma unroll
          for (int t2 = 0; t2 < 2; ++t2) {
              f32x4 o[4]; float ss = 0.f;
#pragma unroll
              for (int vi = 0; vi < 4; ++vi) { o[vi] = (dir == 0 ? acc[t2][vi] : acc[2 + t2][vi]) + xi[(t2 * 4 + vi) * 64 + lane]; ss += o[vi][0] * o[vi][0] + o[vi][1] * o[vi][1] + o[vi][2] * o[vi][2] + o[vi][3] * o[vi][3]; }
              ss += __shfl_xor(ss, 16); ss += __shfl_xor(ss, 32);
              const float rs = rsqrtf(ss * (1.f / 64.f) + EPS);
              const int R = gla_row(b, c, (dir * 2 + t2) * 16 + l15);
#pragma unroll
              for (int vi = 0; vi < 4; ++vi) { const int col = h * 64 + vi * 16 + 4 * kg; const u32x2 rw = *(const u32x2*)(p->P + (size_t)R * PC + C_RB + col); const f32x4 gv = *(const f32x4*)(gg + vi * 16 + 4 * kg);
                  u32x2 yw; yw.x = pack2(o[vi][0] * rs * gv[0] * siluf(bflo(rw.x)), o[vi][1] * rs * gv[1] * siluf(bfhi(rw.x))); yw.y = pack2(o[vi][2] * rs * gv[2] * siluf(bflo(rw.y)), o[vi][3] * rs * gv[3] * siluf(bfhi(rw.y)));
                  *(u32x2*)(p->YCAT + (size_t)R * 768 + 256 + col) = yw; }
          } }
    }
    __syncthreads();
}

__device__ __forceinline__ void st_norm2_router(KP p, int l, bool with_ctx, unsigned char* lds) {
    float* W2 = (float*)lds;
    const int tid = ltid(), wid = tid >> 6, lane = tid & 63;
    __syncthreads();
    for (int i_ = tid; i_ < DM * NE; i_ += NTHREADS) { const int col = i_ >> 4, e = i_ & 15, ln = (col & 255) >> 2, q = col & 3, i = col >> 8;
        W2[(((i * 4 + q) * 64) + ln) * 20 + e] = p->in[I_WR][(size_t)l * DM * NE + i_]; }
    __syncthreads();
    const float* mod = p->MOD + (size_t)l * 9 * 6144; const float* g = p->in[I_N2G] + l * DM;
    const int nrows = with_ctx ? MT : NLAT, stride = lgrid() * 8;
    const bool b5 = lane & 32, b4 = lane & 16, b3 = lane & 8, b2 = lane & 4;
    const int my_e = (b5 ? 8 : 0) + (b4 ? 4 : 0) + (b3 ? 2 : 0) + (b2 ? 1 : 0);
    for (int R0 = lbid() * 8 + wid; R0 < nrows; R0 += 2 * stride) {
        const int R1 = R0 + stride; const bool has1 = R1 < nrows; const int R1c = has1 ? R1 : R0;
        f32x4 x0[4], x1[4];
#pragma unroll
        for (int i = 0; i < 4; ++i) { x0[i] = *(const f32x4*)(p->X + (size_t)R0 * DM + lane * 4 + 256 * i); x1[i] = *(const f32x4*)(p->X + (size_t)R1c * DM + lane * 4 + 256 * i); }
        const float* m0 = mod + mod_row(R0) * 6144; const float* m1 = mod + mod_row(R1c) * 6144;
        float ss0 = 0.f, ss1 = 0.f;
#pragma unroll
        for (int i = 0; i < 4; ++i) { ss0 += x0[i][0] * x0[i][0] + x0[i][1] * x0[i][1] + x0[i][2] * x0[i][2] + x0[i][3] * x0[i][3]; ss1 += x1[i][0] * x1[i][0] + x1[i][1] * x1[i][1] + x1[i][2] * x1[i][2] + x1[i][3] * x1[i][3]; }
#pragma unroll
        for (int o = 32; o > 0; o >>= 1) { ss0 += __shfl_xor(ss0, o); ss1 += __shfl_xor(ss1, o); }
        const float rs0 = rsqrtf(ss0 * (1.f / DM) + EPS), rs1 = rsqrtf(ss1 * (1.f / DM) + EPS);
#pragma unroll
        for (int i = 0; i < 4; ++i) {
            const int c = lane * 4 + 256 * i; const f32x4 gv = *(const f32x4*)(g + c);
            x0[i] = (x0[i] * rs0) * gv * (*(const f32x4*)(m0 + 4096 + c) + 1.f) + *(const f32x4*)(m0 + 3072 + c);
            x1[i] = (x1[i] * rs1) * gv * (*(const f32x4*)(m1 + 4096 + c) + 1.f) + *(const f32x4*)(m1 + 3072 + c);
        }
        store_row_fp8((unsigned char*)p->U + (size_t)R0 * DM, x0, lane, S8_X);
        if (has1) store_row_fp8((unsigned char*)p->U + (size_t)R1 * DM, x1, lane, S8_X);
        f32x4 a0[4], a1[4];
#pragma unroll
        for (int j = 0; j < 4; ++j) { a0[j] = (f32x4){0.f, 0.f, 0.f, 0.f}; a1[j] = (f32x4){0.f, 0.f, 0.f, 0.f}; }
#pragma unroll
        for (int i = 0; i < 4; ++i)
#pragma unroll
            for (int q = 0; q < 4; ++q) { const f32x4* wv = (const f32x4*)(W2 + (((i * 4 + q) * 64) + lane) * 20); const float xa = x0[i][q], xb = x1[i][q];
#pragma unroll
                for (int j = 0; j < 4; ++j) { const f32x4 w4 = wv[j]; a0[j] += w4 * xa; a1[j] += w4 * xb; }
                if (q & 1) __builtin_amdgcn_sched_barrier(0); }
        float l0, l1;
        { float u0[8], u1[8];
#pragma unroll
          for (int k = 0; k < 8; ++k) { const float k0 = a0[k >> 2][k & 3], h0 = a0[2 + (k >> 2)][k & 3], k1 = a1[k >> 2][k & 3], h1 = a1[2 + (k >> 2)][k & 3];
              u0[k] = (b5 ? h0 : k0) + __shfl_xor(b5 ? k0 : h0, 32); u1[k] = (b5 ? h1 : k1) + __shfl_xor(b5 ? k1 : h1, 32); }
          float v0[4], v1[4];
#pragma unroll
          for (int k = 0; k < 4; ++k) { v0[k] = (b4 ? u0[4 + k] : u0[k]) + __shfl_xor(b4 ? u0[k] : u0[4 + k], 16); v1[k] = (b4 ? u1[4 + k] : u1[k]) + __shfl_xor(b4 ? u1[k] : u1[4 + k], 16); }
          float w0[2], w1[2];
#pragma unroll
          for (int k = 0; k < 2; ++k) { w0[k] = (b3 ? v0[2 + k] : v0[k]) + __shfl_xor(b3 ? v0[k] : v0[2 + k], 8); w1[k] = (b3 ? v1[2 + k] : v1[k]) + __shfl_xor(b3 ? v1[k] : v1[2 + k], 8); }
          l0 = (b2 ? w0[1] : w0[0]) + __shfl_xor(b2 ? w0[0] : w0[1], 4); l1 = (b2 ? w1[1] : w1[0]) + __shfl_xor(b2 ? w1[0] : w1[1], 4);
          l0 += __shfl_xor(l0, 2); l1 += __shfl_xor(l1, 2); l0 += __shfl_xor(l0, 1); l1 += __shfl_xor(l1, 1); }
        float mx0 = l0, mx1 = l1;
#pragma unroll
        for (int o = 32; o >= 4; o >>= 1) { mx0 = fmaxf(mx0, __shfl_xor(mx0, o)); mx1 = fmaxf(mx1, __shfl_xor(mx1, o)); }
        const float ex0 = expf(l0 - mx0), ex1 = expf(l1 - mx1); float s0 = ex0, s1 = ex1;
#pragma unroll
        for (int o = 32; o >= 4; o >>= 1) { s0 += __shfl_xor(s0, o); s1 += __shfl_xor(s1, o); }
        if ((lane & 3) == 0) { p->AFF[(size_t)R0 * 16 + my_e] = ex0 / s0; if (has1) p->AFF[(size_t)R1 * 16 + my_e] = ex1 / s1; }
    }
}

__device__ __forceinline__ int block_sum_i(int v, int* red, int tid) {
    const int lane = tid & 63, wid = tid >> 6;
#pragma unroll
    for (int o = 32; o > 0; o >>= 1) v += __shfl_xor(v, o);
    __syncthreads();
    if (lane == 0) red[wid] = v;
    __syncthreads();
    int s = 0;
#pragma unroll
    for (int w = 0; w < 8; ++w) s += red[w];
    return s;
}
__device__ __forceinline__ int block_excl_scan_i(int v, int* red, int tid) {
    const int lane = tid & 63, wid = tid >> 6;
    int inc = v;
#pragma unroll
    for (int o = 1; o < 64; o <<= 1) { const int t = __shfl_up(inc, o); if (lane >= o) inc += t; }
    __syncthreads();
    if (lane == 63) red[wid] = inc;
    __syncthreads();
    int base = 0;
#pragma unroll
    for (int w = 0; w < 8; ++w) base += (w < wid) ? red[w] : 0;
    return base + inc - v;
}
__device__ __forceinline__ void st_topk(KP p, bool with_ctx, unsigned char* lds) {
    int* red = (int*)lds;
    const int tid = ltid();
    const int nun = NB * NE * (with_ctx ? 2 : 1);
    for (int u = lbid(); u < nun; u += lgrid()) {
        const int grp = u / (NB * NE), b = (u / NE) % NB, e = u % NE;
        const int n = grp ? SC : TL, cap = grp ? CAPC : CAPL, per = grp ? 1 : 8;
        const int rowbase = grp ? NLAT + b * SC : b * TL;
        unsigned key[8];
#pragma unroll
        for (int i = 0; i < 8; ++i) { const int t = tid * per + i; key[i] = (i < per && t < n) ? __float_as_uint(p->AFF[(size_t)(rowbase + t) * 16 + e]) : 0u; }
        unsigned prefix = 0u;
        { const int lane_ = tid & 63, wid_ = tid >> 6; int* rq = red + 16;
          __syncthreads();
          for (int step = 0; step < 16; ++step) {
              const int bit = step == 0 ? 30 : 30 - 2 * step;
              const unsigned c1 = prefix | (1u << bit), c2 = step == 0 ? 0xFFFFFFFFu : prefix | (2u << bit), c3 = step == 0 ? 0xFFFFFFFFu : prefix | (3u << bit);
              int a = 0, b3 = 0;
#pragma unroll
              for (int i = 0; i < 8; ++i) { a += (key[i] >= c1 ? 1 : 0) + (key[i] >= c2 ? 65536 : 0); b3 += key[i] >= c3 ? 1 : 0; }
#pragma unroll
              for (int o = 32; o > 0; o >>= 1) { a += __shfl_xor(a, o); b3 += __shfl_xor(b3, o); }
              int* slot = rq + (step & 1) * 16;
              if (lane_ == 0) { slot[wid_ * 2] = a; slot[wid_ * 2 + 1] = b3; }
              __syncthreads();
              int sa = 0, sb = 0;
#pragma unroll
              for (int w8 = 0; w8 < 8; ++w8) { sa += slot[w8 * 2]; sb += slot[w8 * 2 + 1]; }
              const int n1 = sa & 0xFFFF, n2 = sa >> 16, n3 = sb;
              prefix = (n3 >= cap) ? c3 : (n2 >= cap) ? c2 : (n1 >= cap) ? c1 : prefix;
          } }
        int ngt = 0, neq = 0;
#pragma unroll
        for (int i = 0; i < 8; ++i) { ngt += key[i] > prefix ? 1 : 0; neq += (key[i] == prefix && key[i] != 0u) ? 1 : 0; }
        const int need = cap - block_sum_i(ngt, red, tid);
        int eqbase = block_excl_scan_i(neq, red, tid);
        int sel[8]; int nsel = 0;
#pragma unroll
        for (int i = 0; i < 8; ++i) { const bool eq = key[i] == prefix && key[i] != 0u; sel[i] = (key[i] > prefix || (eq && eqbase < need)) ? 1 : 0; eqbase += eq ? 1 : 0; nsel += sel[i]; }
        int slot = block_excl_scan_i(nsel, red, tid);
        const int ebase = e * EROWS + (grp ? NB * CAPL + b * CAPC : b * CAPL);
#pragma unroll
        for (int i = 0; i < 8; ++i) { const int t = tid * per + i;
            if (i < per && t < n) { const int R = rowbase + t;
                if (sel[i]) { const int er = ebase + slot; p->SRCROW[er] = R; p->VAL[er] = __uint_as_float(key[i]); p->SLOTOF[(size_t)R * 16 + e] = er; ++slot; }
                else p->SLOTOF[(size_t)R * 16 + e] = -1; } }
        __syncthreads();
    }
}
__device__ __forceinline__ void st_combine(KP p, int l, bool with_ctx) {
    const int wid = ltid() >> 6, lane = ltid() & 63;
    const float* mod = p->MOD + (size_t)l * 9 * 6144;
    const int nrows = with_ctx ? MT : NLAT, stride = lgrid() * 8;
    int R = lbid() * 8 + wid;
    int so_n = -1; float sv_n = 0.f; f32x4 x_n[4];
    if (R < nrows) {
        so_n = p->SLOTOF[(size_t)R * 16 + (lane & 15)]; sv_n = so_n >= 0 ? p->VAL[so_n] : 0.f;
#pragma unroll
        for (int i = 0; i < 4; ++i) x_n[i] = *(const f32x4*)(p->X + (size_t)R * DM + lane * 4 + 256 * i);
    }
    for (; R < nrows; R += stride) {
        const int so = so_n; const float sv = sv_n; f32x4 x[4];
#pragma unroll
        for (int i = 0; i < 4; ++i) x[i] = x_n[i];
        const int Rn = R + stride;
        if (Rn < nrows) {
            so_n = p->SLOTOF[(size_t)Rn * 16 + (lane & 15)]; sv_n = so_n >= 0 ? p->VAL[so_n] : 0.f;
#pragma unroll
            for (int i = 0; i < 4; ++i) x_n[i] = *(const f32x4*)(p->X + (size_t)Rn * DM + lane * 4 + 256 * i);
        }
        unsigned mask = (unsigned)(__ballot(so >= 0) & 0xFFFFull);
        f32x4 a[4];
#pragma unroll
        for (int i = 0; i < 4; ++i) a[i] = (f32x4){0.f, 0.f, 0.f, 0.f};
        while (mask) {
            const int e0 = __builtin_ctz(mask); mask &= mask - 1;
            const bool two = mask != 0; const int e1 = two ? __builtin_ctz(mask) : e0; if (two) mask &= mask - 1;
            const int er0 = __shfl(so, e0), er1 = __shfl(so, e1); const float v0 = __shfl(sv, e0), v1 = two ? __shfl(sv, e1) : 0.f;
            const bf16_t* y0 = p->Y + (size_t)er0 * DM + lane * 4; const bf16_t* y1 = p->Y + (size_t)er1 * DM + lane * 4;
            u32x2 w0[4], w1[4];
#pragma unroll
            for (int i = 0; i < 4; ++i) { w0[i] = *(const u32x2*)(y0 + 256 * i); w1[i] = *(const u32x2*)(y1 + 256 * i); }
#pragma unroll
            for (int i = 0; i < 4; ++i) { a[i][0] += v0 * bflo(w0[i].x) + v1 * bflo(w1[i].x); a[i][1] += v0 * bfhi(w0[i].x) + v1 * bfhi(w1[i].x); a[i][2] += v0 * bflo(w0[i].y) + v1 * bflo(w1[i].y); a[i][3] += v0 * bfhi(w0[i].y) + v1 * bfhi(w1[i].y); }
        }
        const float* m = mod + mod_row(R) * 6144;
#pragma unroll
        for (int i = 0; i < 4; ++i) { const int c = lane * 4 + 256 * i; x[i] += *(const f32x4*)(m + 5120 + c) * a[i]; }
        if (l + 1 < NL) {
#pragma unroll
            for (int i = 0; i < 4; ++i) *(f32x4*)(p->X + (size_t)R * DM + lane * 4 + 256 * i) = x[i];
            const float* m2 = p->MOD + (size_t)(l + 1) * 9 * 6144 + mod_row(R) * 6144;
            norm_mod_row(x, p->in[I_N1G] + (l + 1) * DM, m2, m2 + 1024, lane);
            store_row_bf16(p->U + (size_t)R * DM, x, lane);
            store_row_fp8(p->U8W + (size_t)R * DM, x, lane, S8_U);
        } else {
            float ss = 0.f;
#pragma unroll
            for (int i = 0; i < 4; ++i) ss += x[i][0] * x[i][0] + x[i][1] * x[i][1] + x[i][2] * x[i][2] + x[i][3] * x[i][3];
            ss = wave_sum(ss); const float rs = rsqrtf(ss * (1.f / DM) + EPS);
#pragma unroll
            for (int i = 0; i < 4; ++i) { const int c = lane * 4 + 256 * i; *(f32x4*)(p->out + (size_t)R * DM + c) = x[i] * rs * *(const f32x4*)(p->in[I_FNG] + c); }
        }
    }
}

constexpr int LDS_BYTES = 160 * 1024;
#define PHASE_BEGIN { KP p = kparams(); LAS unsigned char* lds3 = llds3(lds0); unsigned char* lds = (unsigned char*)lds3; const int G = lgrid(), c0_ = lbid(), c = (G % 8 == 0) ? (c0_ % 8) * (G / 8) + c0_ / 8 : c0_;     (void)p; (void)lds; (void)lds3; (void)G; (void)c;
#define PHASE_END   xcd_barrier(bar); }
#ifndef DUPMASK
#define DUPMASK 0
#endif
#define RUN(bit, ...) do { __VA_ARGS__; if ((DUPMASK >> (bit)) & 1) { xcd_barrier(bar); __VA_ARGS__; } } while (0)
__global__ void __launch_bounds__(NTHREADS, 2) fwd(Params p_unused) {
    extern __shared__ __attribute__((aligned(16))) unsigned char lds_raw[];
    LAS unsigned char* lds0 = (LAS unsigned char*)lds_raw + 16;
    volatile LAS unsigned* xbw = (volatile LAS unsigned*)lds_raw;
    if (threadIdx.x == 0) { xbw[0] = 0u; xbw[1] = 0u; xbw[2] = 0u; xbw[3] = 0u; }
    __syncthreads();
    XcdBarrier bar = xcd_barrier_post(kparams()->bar, xbw);
    PHASE_BEGIN RUN(12, st_adaln(p, lds)); RUN(0, st_convert(p, lds, 0, NL)); RUN(13, st_fold(p)); PHASE_END
    PHASE_BEGIN RUN(14, st_norm1(p, 0)); PHASE_END
    for (int l = 0; l < NL; ++l) {
        const bool wc = l + 1 < NL;
        PHASE_BEGIN pg8::PlainOrder S{(const char*)p->U, (const char*)(p->WIN + (size_t)l * PC * DM), (size_t)256 * DM * 2, (size_t)256 * DM * 2, MT / 256, C_MG / 256, G, c};
                    pg8::EpiIn E{p->P, p->PG};
                    const int c8 = (c + 56) % G;
                    pg8::PlainOrder S8{(const char*)p->U8W, (const char*)(p->WING8 + (size_t)l * 3072 * DM), (size_t)256 * DM, (size_t)256 * DM, (wc ? MT : NLAT) / 256, 3072 / 256, G, c8};
                    pg8::EpiGate8 E8{p->PG, 1.f / (S8_U * S8_W)};
                    RUN(1, pg8::gemm_phase<pg8::EpiIn, pg8::PlainOrder, true, true>(lds3, DM * 2, DM * 2, DM / 64, S, E); pg8::gemm_phase<pg8::EpiGate8, pg8::PlainOrder, true, true, true>(lds3, DM, DM, DM / 128, S8, E8)); PHASE_END
        PHASE_BEGIN st_qkrope(p, l, lds);
                    { unsigned* head = p->bar + XCD_BAR_WORDS + l * 64; volatile LAS unsigned* qw = (volatile LAS unsigned*)lds_raw + 2;
                      const int nNA = NB * 4 * 16, nGS = NB * NCH, nTot = nNA + nGS + (wc ? NB * 4 : 0);
                      for (;;) {
                          __syncthreads();
                          if (ltid() == 0) *qw = __hip_atomic_fetch_add(head, 1u, __ATOMIC_RELAXED, __HIP_MEMORY_SCOPE_AGENT);
                          __syncthreads();
                          const int u = (int)*qw;
                          if (u >= nTot) break;
                          if (u < nNA) attn_one(p, l, u, true, lds3);
                          else if (u < nNA + nGS) gla_states_one(p, l, u - nNA, lds3);
                          else attn_one(p, l, nNA + (u - nNA - nGS), true, lds3);
                      } }
                    PHASE_END
        PHASE_BEGIN st_gla_scan2(p);
                    { unsigned* head = p->bar + XCD_BAR_WORDS + (4 + l) * 64; volatile LAS unsigned* qw = (volatile LAS unsigned*)lds_raw + 2;
                      const int nTot = NB * 4 * 16 + (wc ? NB * 4 : 0);
                      for (;;) {
                          __syncthreads();
                          if (ltid() == 0) *qw = __hip_atomic_fetch_add(head, 1u, __ATOMIC_RELAXED, __HIP_MEMORY_SCOPE_AGENT);
                          __syncthreads();
                          const int u = (int)*qw;
                          if (u >= nTot) break;
                          attn_one(p, l, u, false, lds3);
                      } }
                    PHASE_END
        PHASE_BEGIN RUN(5, st_gla_out2(p, l, wc, lds3)); PHASE_END
        PHASE_BEGIN pg8::MergeOrder S{(const char*)p->YCAT, (const char*)(p->WB + (size_t)l * DM * 768), (size_t)256 * 768 * 2, (size_t)256 * 768 * 2, (wc ? MT : NLAT) / 256, DM / 256, G, c};
                    pg8::EpiMerge E{p->PG, p->MPRE};
                    RUN(6, pg8::gemm_phase<pg8::EpiMerge, pg8::MergeOrder, true, true>(lds3, 768 * 2, 768 * 2, 256 / 64, S, E)); PHASE_END
        PHASE_BEGIN pg8::PlainOrder S{(const char*)p->MPRE, (const char*)(p->WOUT + (size_t)l * DM * DM), (size_t)256 * DM * 2, (size_t)256 * DM * 2, (wc ? MT : NLAT) / 256, DM / 256, G, c};
                    pg8::EpiOut E{p->X, p->MOD + (size_t)l * 9 * 6144};
                    pg8::gemm_phase<pg8::EpiOut, pg8::PlainOrder, true, true>(lds3, DM * 2, DM * 2, DM / 64, S, E); PHASE_END
        PHASE_BEGIN RUN(7, st_norm2_router(p, l, wc, lds)); PHASE_END
        PHASE_BEGIN RUN(8, st_topk(p, wc, lds)); PHASE_END
        PHASE_BEGIN pg8::ExpertOrder S{(const char*)p->U, (const char*)(p->WGU + (size_t)l * NE * 2 * FF * DM), 0, (size_t)256 * DM, 0, (size_t)2 * FF * DM, wc ? 17 : 16, 16, G, c, p->SRCROW};
                    pg8::EpiGU8 E{p->H, 1.f / (S8_W * S8_X), S8_H};
                    RUN(10, pg8::gemm_phase<pg8::EpiGU8, pg8::ExpertOrder, true, true, true, true>(lds3, DM, DM, DM / 128, S, E)); PHASE_END
        PHASE_BEGIN pg8::ExpertOrder S{(const char*)p->H, (const char*)(p->WD + (size_t)l * NE * DM * FF), (size_t)256 * FF, (size_t)256 * FF, (size_t)EROWS * FF, (size_t)DM * FF, wc ? 17 : 16, 4, G, c, nullptr};
                    pg8::EpiDown E{p->Y, 1.f / (S8_W * S8_H)};
                    RUN(11, pg8::gemm_phase<pg8::EpiDown, pg8::ExpertOrder, true, true, true>(lds3, FF, FF, FF / 128, S, E)); PHASE_END
        PHASE_BEGIN st_combine(p, l, wc); PHASE_END
    }
}

extern "C" void kernel_launch(void* const* d_in, const int* in_sizes, int n_in, void* d_out, int out_size, void* d_ws, size_t ws_size, hipStream_t stream) {
    Params p{};
    for (int i = 0; i < 26; ++i) p.in[i] = (const float*)d_in[i];
    p.out = (float*)d_out;
    unsigned char* w = (unsigned char*)d_ws; size_t off = 0;
    auto take = [&](size_t bytes) { unsigned char* r = w + off; off += (bytes + 255) & ~(size_t)255; return r; };
    p.bar = (unsigned*)take((XCD_BAR_WORDS + QUEUE_WORDS) * 4);
    p.X = (float*)take((size_t)MT * DM * 4);
    p.U = (bf16_t*)take((size_t)MT * DM * 2);
    p.MOD = (float*)take((size_t)NL * 9 * 6144 * 4);
    p.MPRE = (bf16_t*)take((size_t)MT * DM * 2);
    p.AFF = (float*)take((size_t)MT * 16 * 4);
    p.SRCROW = (int*)take((size_t)NE * EROWS * 4);
    p.VAL = (float*)take((size_t)NE * EROWS * 4);
    p.SLOTOF = (int*)take((size_t)MT * 16 * 4);
    p.WIN = (bf16_t*)take((size_t)NL * PC * DM * 2);
    p.WB = (bf16_t*)take((size_t)NL * DM * 768 * 2);
    p.WOUT = (bf16_t*)take((size_t)NL * DM * DM * 2);
    p.WGU = (unsigned char*)take((size_t)NL * NE * 2 * FF * DM);
    p.WD = (unsigned char*)take((size_t)NL * NE * DM * FF);
    p.U8W = (unsigned char*)take((size_t)MT * DM);
    p.WING8 = (unsigned char*)take((size_t)NL * 3072 * DM);
    const size_t r1 = off;
    p.P = (bf16_t*)take((size_t)MT * PC * 2);
    p.YCAT = (bf16_t*)take((size_t)MT * 768 * 2);
    p.DST = (float*)take((size_t)NB * 2 * NCH * 4 * 2048 * 4);
    p.DEC = (float*)take((size_t)NB * 2 * NCH * 4 * 32 * 4);
    p.ST = (bf16_t*)take((size_t)NB * 2 * NCH * 4 * 2048 * 2);
    p.PG = (unsigned char*)take((size_t)MT * 3072);
    const size_t r1_end = off;
    off = r1;
    p.XS = (unsigned char*)take((size_t)NE * EROWS * DM);
    p.H = (unsigned char*)take((size_t)NE * EROWS * FF);
    p.Y = (bf16_t*)take((size_t)NE * EROWS * DM * 2);
    if (off < r1_end) off = r1_end;
    if (off > ws_size) { fprintf(stderr, "workspace too small: need %zu have %zu\n", off, ws_size); return; }
    static int grid = 0;
    if (!grid) {
        (void)hipFuncSetAttribute((const void*)fwd, hipFuncAttributeMaxDynamicSharedMemorySize, LDS_BYTES);
        int dev = 0, cus = 0, per_cu = 0;
        (void)hipGetDevice(&dev);
        (void)hipDeviceGetAttribute(&cus, hipDeviceAttributeMultiprocessorCount, dev);
        (void)hipOccupancyMaxActiveBlocksPerMultiprocessor(&per_cu, fwd, NTHREADS, LDS_BYTES);
        if (per_cu < 1) fprintf(stderr, "occupancy query says %d blocks per CU\n", per_cu);
        grid = cus;
    }
    (void)hipMemsetAsync(p.bar, 0, (XCD_BAR_WORDS + QUEUE_WORDS) * 4, stream);
    hipLaunchKernelGGL(fwd, dim3(grid), dim3(NTHREADS), LDS_BYTES, stream, p);
}
```

```cpp
#include <hip/hip_runtime.h>
#include <stdint.h>
#include <stdio.h>


typedef unsigned short bf16_t;
typedef short bf16x8 __attribute__((ext_vector_type(8)));
typedef float f32x4 __attribute__((ext_vector_type(4)));
typedef unsigned u32x4 __attribute__((ext_vector_type(4)));
typedef unsigned u32x2 __attribute__((ext_vector_type(2)));
#define LAS __attribute__((address_space(3)))

constexpr int DM = 1024, NB = 8, TL = 4096, SC = 256, NL = 4;
constexpr int NLAT = NB * TL, NCTX = NB * SC, MT = NLAT + NCTX;
constexpr int INC = 5152, PC = 5376;
constexpr int C_QA = 0, C_KA = 256, C_VA = 512, C_QB = 768, C_KB = 896, C_VB = 1024, C_RB = 1280, C_G = 1536,
              C_QC = 1792, C_KC = 2048, C_VC = 2176, C_MG = 2304;
constexpr int NE = 16, FF = 2048, CAPL = 512, CAPC = 32, EROWS = NB * CAPL + NB * CAPC;
constexpr int NCH = 68;
constexpr int NTHREADS = 512;
constexpr float EPS = 1e-6f;
constexpr float S8_W = 256.f, S8_X = 8.f, S8_H = 4.f, S8_U = 8.f;

__device__ __forceinline__ unsigned cvt_pk_bf16_hw(float lo, float hi) { unsigned r; asm("v_cvt_pk_bf16_f32 %0, %1, %2" : "=v"(r) : "v"(lo), "v"(hi)); return r; }
__device__ __forceinline__ bf16_t f2bf(float f) { return (bf16_t)(cvt_pk_bf16_hw(f, f) & 0xFFFFu); }
__device__ __forceinline__ float bf2f(bf16_t b) { return __uint_as_float(((unsigned)b) << 16); }
__device__ __forceinline__ unsigned pack2(float lo, float hi) { return cvt_pk_bf16_hw(lo, hi); }
__device__ __forceinline__ float bflo(unsigned w) { return __uint_as_float(w << 16); }
__device__ __forceinline__ float bfhi(unsigned w) { return __uint_as_float(w & 0xFFFF0000u); }
__device__ __forceinline__ float siluf(float x) { return x * __builtin_amdgcn_rcpf(1.f + __expf(-x)); }
__device__ __forceinline__ float logsig16(float z) { return (fminf(z, 0.f) - __logf(1.f + __expf(-fabsf(z)))) * (1.f / 16.f); }
__device__ __forceinline__ float wave_sum(float v) {
#pragma unroll
    for (int o = 32; o > 0; o >>= 1) v += __shfl_xor(v, o);
    return v;
}
__device__ __forceinline__ int ltid() { int t = threadIdx.x; asm volatile("" : "+v"(t)); return t; }
__device__ __forceinline__ int lbid() { int t = blockIdx.x; asm volatile("" : "+s"(t)); return t; }
__device__ __forceinline__ int lgrid() { int t = gridDim.x; asm volatile("" : "+s"(t)); return t; }
__device__ __forceinline__ LAS unsigned char* llds3(LAS unsigned char* p) { asm volatile("" : "+s"(p)); return p; }
__device__ __forceinline__ int mod_row(int R) { return R < NLAT ? (R >> 12) : NB; }

struct Params {
    const float* in[26];
    float* out;
    float* X; bf16_t* U; float* MOD; bf16_t* P; bf16_t* YCAT; bf16_t* MPRE;
    float* AFF; int* SRCROW; float* VAL; int* SLOTOF;
    unsigned char* XS; unsigned char* H; bf16_t* Y;
    float* DST; float* DEC; bf16_t* ST; unsigned char* PG; unsigned char* U8W; unsigned char* WING8;
    bf16_t* WIN; bf16_t* WB; bf16_t* WOUT; unsigned char* WGU; unsigned char* WD;
    unsigned* bar;
};
enum { I_X = 0, I_C, I_CTX, I_CCTX, I_WADA, I_BADA, I_N1G, I_N2G, I_WIN, I_RPB, I_WGF, I_BGF, I_WGB, I_BGB, I_GLAG, I_QNG, I_KNG,
       I_WBA, I_WBB, I_WBC, I_WOUT, I_WR, I_WEG, I_WEU, I_WED, I_FNG };

typedef const __attribute__((address_space(4))) Params* KP;
__device__ __forceinline__ KP kparams() {
    KP kp = (KP)__builtin_amdgcn_kernarg_segment_ptr();
    asm volatile("" : "+s"(kp) :: "memory");
    return kp;
}
#define XB_TMO      128
#define XB_XCNT(j)  (256  + 64 * (j))
#define XB_XSUB(j)  (1280 + 64 * (j))
#define XB_XGEN(j)  (2304 + 64 * (j))
#define XB_TOP      3328
#define XB_TOPGEN   3392
#define XCD_BAR_WORDS 3456
#define XB_SPIN_CAP (1u << 22)
#define QUEUE_WORDS (48 * 64)
__device__ __forceinline__ unsigned xb_ld(unsigned* p)              { return __hip_atomic_load(p, __ATOMIC_RELAXED, __HIP_MEMORY_SCOPE_AGENT); }
__device__ __forceinline__ unsigned xb_add(unsigned* p, unsigned v) { return __hip_atomic_fetch_add(p, v, __ATOMIC_RELAXED, __HIP_MEMORY_SCOPE_AGENT); }
__device__ __forceinline__ unsigned xb_xcc_id() { return (unsigned)__builtin_amdgcn_s_getreg((3 << 11) | 20) & 0xFu; }
#define XB_SPIN(cond, bar) do { unsigned _sp = 0; while (cond) { __builtin_amdgcn_s_sleep(1); \
    if ((++_sp & 255u) == 0u) { if (xb_ld(&(bar)[XB_TMO])) break; if (_sp > XB_SPIN_CAP) { atomicAdd(&(bar)[XB_TMO], 1u); break; } } } } while (0)
struct XcdBarrier { unsigned* bar; unsigned x; volatile LAS unsigned* st; };
__device__ __forceinline__ XcdBarrier xcd_barrier_post(unsigned* bar, volatile LAS unsigned* st) {
    XcdBarrier b; b.bar = bar; b.x = xb_xcc_id(); b.st = st;
    if (threadIdx.x == 0) (void)xb_add(&bar[XB_XCNT(b.x)], 1u);
    return b;
}
__device__ __forceinline__ void xcd_barrier_complete(unsigned* bar, unsigned x, unsigned& nloc, unsigned& nx) {
    const unsigned G = gridDim.x * gridDim.y * gridDim.z;
    unsigned sum, cnt, mine, sp = 0u;
    for (;;) {
        sum = 0u; cnt = 0u; mine = 0u;
#pragma unroll
        for (unsigned j = 0; j < 16; ++j) { const unsigned c = xb_ld(&bar[XB_XCNT(j)]); sum += c; cnt += (c > 0u) ? 1u : 0u; mine = (j == x) ? c : mine; }
        if (sum == G) break;
        __builtin_amdgcn_s_sleep(1);
        if ((++sp & 255u) == 0u) { if (xb_ld(&bar[XB_TMO])) break; if (sp > XB_SPIN_CAP) { atomicAdd(&bar[XB_TMO], 1u); break; } }
    }
    nloc = mine > 0u ? mine : 1u; nx = cnt > 0u ? cnt : 1u;
}
__device__ __forceinline__ void xcd_barrier(const XcdBarrier& b) {
    asm volatile("s_waitcnt vmcnt(0)" ::: "memory");
    __syncthreads();
    if (threadIdx.x == 0) {
        unsigned* bar = b.bar;
        __builtin_amdgcn_s_waitcnt(0);
        unsigned nloc = b.st[0], nx = b.st[1];
        if (nloc == 0u) { xcd_barrier_complete(bar, b.x, nloc, nx); b.st[0] = nloc; b.st[1] = nx; }
        const unsigned old = xb_add(&bar[XB_XSUB(b.x)], 1u);
        const unsigned gen = old / nloc;
        if (old + 1u == (gen + 1u) * nloc) {
            __builtin_amdgcn_fence(__ATOMIC_RELEASE, "agent");
            asm volatile("s_waitcnt vmcnt(0)" ::: "memory");
            const unsigned og = xb_add(&bar[XB_TOP], 1u);
            const unsigned tg = og / nx;
            if (og + 1u == (tg + 1u) * nx) xb_add(&bar[XB_TOPGEN], 1u);
            else XB_SPIN(xb_ld(&bar[XB_TOPGEN]) == tg, bar);
            __builtin_amdgcn_fence(__ATOMIC_ACQUIRE, "agent");
            xb_add(&bar[XB_XGEN(b.x)], 1u);
            asm volatile("s_waitcnt vmcnt(0)" ::: "memory");
        } else {
            XB_SPIN(xb_ld(&bar[XB_XGEN(b.x)]) == gen, bar);
            __builtin_amdgcn_fence(__ATOMIC_ACQUIRE, "agent");
            asm volatile("s_waitcnt vmcnt(0)" ::: "memory");
        }
    }
    __syncthreads();
}

#ifndef PG8_TID
#define PG8_TID ltid()
#endif
namespace pg8 {
constexpr int BM = 256, BK = 64, HALF = 128, HTB = HALF * BK * 2, STAGE_BYTES = 8 * HTB;
__host__ __device__ __forceinline__ int lds_byte(int r, int c) { const int st = (r >> 4) * 2 + (c >> 5), rr = r & 15, cc = c & 31, ob = rr * 64 + cc * 2; return st * 1024 + (ob ^ (((ob >> 9) & 1) << 5)); }
__host__ __device__ __forceinline__ void stage_rc(int b, int& R, int& C) { const int st = b / 1024, sb = b % 1024, swz = sb ^ (((sb >> 9) & 1) << 5); R = (st >> 1) * 16 + swz / 64; C = (st & 1) * 32 + (swz % 64) / 2; }
__host__ __device__ __forceinline__ int perm32(int rho) { const int n = rho >> 4, i = rho & 15; return 8 * (i >> 2) + 4 * n + (i & 3); }
struct Unit { const char* A; const char* B; int row0, col0, aux, keep; const int* G; };
__device__ __forceinline__ unsigned cvt_pk_bf16(float lo, float hi) { unsigned r; asm volatile("v_cvt_pk_bf16_f32 %0, %1, %2" : "=v"(r) : "v"(lo), "v"(hi)); return r; }

typedef int v8i __attribute__((ext_vector_type(8)));
typedef int v4i __attribute__((ext_vector_type(4)));
__device__ __forceinline__ void glds16s(unsigned voff, const void* sbase, unsigned lds_dst) { unsigned keep;
    asm volatile("s_mov_b32 %0, m0\n\ts_mov_b32 m0, %3\n\ts_nop 0\n\tglobal_load_lds_dwordx4 %1, %2\n\ts_mov_b32 m0, %0" : "=&s"(keep) : "v"(voff), "s"(sbase), "s"(lds_dst) : "memory"); }
__device__ __forceinline__ void glds4s(unsigned voff, const void* sbase, unsigned lds_dst) { unsigned keep;
    asm volatile("s_mov_b32 %0, m0\n\ts_mov_b32 m0, %3\n\ts_nop 0\n\tglobal_load_lds_dword %1, %2\n\ts_mov_b32 m0, %0" : "=&s"(keep) : "v"(voff), "s"(sbase), "s"(lds_dst) : "memory"); }
template <class Epi, class Sched, bool ALIGN_EPI, bool SP2, bool FP8 = false, bool GATHER = false>
__device__ __forceinline__ void gemm_phase(LAS unsigned char* lds, const int ldaB, const int ldbB, const int nt_in, const Sched& S, const Epi& E) {
    int nt = nt_in; asm volatile("" : "+s"(nt));
    const int tid = PG8_TID, wid = __builtin_amdgcn_readfirstlane(tid >> 6), lane = tid & 63, wr = wid >> 2, wc = wid & 3, fr = lane & 15, fq = lane >> 4;
    unsigned voffA[2], voffB[2];
#pragma unroll
    for (int i = 0; i < 2; ++i) { int R, C; stage_rc(tid * 16 + i * 8192, R, C); const int Rb = Epi::PERM ? ((R & ~31) + perm32(R & 31)) : R;
        voffA[i] = (unsigned)(R * ldaB + C * 2); voffB[i] = (unsigned)(Rb * ldbB + C * 2); }
    const size_t kstep = (size_t)(BK * 2);
    const size_t hstepA = (size_t)HALF * ldaB, hstepB = (size_t)HALF * ldbB;
    const unsigned ldsw = (unsigned)wid * 1024u, ldsbase = (unsigned)__builtin_amdgcn_readfirstlane((int)(unsigned)(uintptr_t)lds);
    const int aoff = lds_byte(wr * 64 + fr, fq * 8), boff = lds_byte(wc * 32 + fr, fq * 8);
#define PG8_SA(b, h) (((b) * 2 + (h)) * HTB)
#define PG8_SB(b, h) ((4 + (b) * 2 + (h)) * HTB)
#define PG8_STAGE(bufoff, gbase, voff) do { _Pragma("unroll") for (int _i = 0; _i < 2; ++_i) \
        glds16s((voff)[_i], (const void*)(gbase), ldsbase + (unsigned)(bufoff) + ldsw + _i * 8192); } while (0)
    unsigned vc[2][2], vn[2][2]; int gR[2], gC[2];
#pragma unroll
    for (int i = 0; i < 2; ++i) { int R, C; stage_rc(tid * 16 + i * 8192, R, C); gR[i] = R; gC[i] = C * 2; vc[0][i] = vc[1][i] = vn[0][i] = vn[1][i] = 0u; }
    LAS int* gidx = (LAS int*)(lds + STAGE_BYTES);
#define PG8_GIDX(dst, buf) do { _Pragma("unroll") for (int h_ = 0; h_ < 2; ++h_) _Pragma("unroll") for (int i_ = 0; i_ < 2; ++i_) dst[h_][i_] = (unsigned)(gidx[(buf) * 256 + h_ * HALF + gR[i_]] * ldaB + gC[i_]); } while (0)
#define PG8_STAGE_A(b, h, base, nx) do { if constexpr (GATHER) { if (nx) PG8_STAGE(PG8_SA(b, h), base, vn[h]); else PG8_STAGE(PG8_SA(b, h), base, vc[h]); } \
        else PG8_STAGE(PG8_SA(b, h), (base) + (h) * hstepA, voffA); } while (0)
#define PG8_LDA(dst, b, h) do { _Pragma("unroll") for (int m = 0; m < 4; ++m) { dst[m].lo = *(const LAS v4i*)(lds + PG8_SA(b, h) + aoff + m * 2048); dst[m].hi = *(const LAS v4i*)(lds + PG8_SA(b, h) + aoff + m * 2048 + 1024); } } while (0)
#define PG8_LDB(dst, b, h) do { _Pragma("unroll") for (int n = 0; n < 2; ++n) { dst[n].lo = *(const LAS v4i*)(lds + PG8_SB(b, h) + boff + n * 2048); dst[n].hi = *(const LAS v4i*)(lds + PG8_SB(b, h) + boff + n * 2048 + 1024); } } while (0)
#define PG8_MMA(ai, bj, At, Bt) do { __builtin_amdgcn_s_setprio(1); _Pragma("unroll") for (int m = 0; m < 4; ++m) _Pragma("unroll") for (int n = 0; n < 2; ++n) { \
        if constexpr (FP8) asm volatile("v_mfma_scale_f32_16x16x128_f8f6f4 %0, %1, %2, %0, %3, %3 op_sel_hi:[0,0,0]" : "+v"(acc[ai][bj][m][n]) : "v"(Bt[n]), "v"(At[m]), "v"(sc8)); \
        else { const v4i bl_ = Bt[n].lo, bh_ = Bt[n].hi, al_ = At[m].lo, ah_ = At[m].hi;     \
               acc[ai][bj][m][n] = __builtin_amdgcn_mfma_f32_16x16x32_bf16(__builtin_bit_cast(bf16x8, bl_), __builtin_bit_cast(bf16x8, al_), acc[ai][bj][m][n], 0, 0, 0); \
               acc[ai][bj][m][n] = __builtin_amdgcn_mfma_f32_16x16x32_bf16(__builtin_bit_cast(bf16x8, bh_), __builtin_bit_cast(bf16x8, ah_), acc[ai][bj][m][n], 0, 0, 0); } } __builtin_amdgcn_s_setprio(0); } while (0)
#define PG8_WAIT_V(n) asm volatile("s_waitcnt vmcnt(" #n ")" ::: "memory")
#define PG8_WAIT_L(n) asm volatile("s_waitcnt lgkmcnt(" #n ")" ::: "memory")
#define PG8_BAR __builtin_amdgcn_s_barrier()
#define PG8_SCHED __builtin_amdgcn_sched_barrier(0)
    Unit cur, nxt; int ui = 0;
    if (!S.next(0, cur)) return;
    f32x4 acc[2][2][4][2];
#pragma unroll
    for (int a = 0; a < 2; ++a)
#pragma unroll
        for (int b = 0; b < 2; ++b)
#pragma unroll
            for (int m = 0; m < 4; ++m)
#pragma unroll
                for (int n = 0; n < 2; ++n) acc[a][b][m][n] = (f32x4){0.f, 0.f, 0.f, 0.f};
    v8i At[4], B0[2], B1[2];
    int sc8 = 0x7F7F7F7F; asm volatile("" : "+v"(sc8));
    const char* cA = cur.A; const char* cB = cur.B;
    if constexpr (GATHER) {
        if (tid < 256) gidx[tid] = cur.G[tid];
        asm volatile("s_waitcnt vmcnt(0) lgkmcnt(0)" ::: "memory"); PG8_BAR; asm volatile("" ::: "memory");
        PG8_GIDX(vc, 0);
    }
    if constexpr (SP2) {
        PG8_STAGE(PG8_SB(0, 0), cB, voffB); PG8_STAGE(PG8_SB(0, 1), cB + hstepB, voffB); PG8_STAGE_A(0, 0, cA, false); PG8_STAGE_A(0, 1, cA, false);
        if (wr == 1) PG8_BAR;
        PG8_WAIT_V(2); PG8_BAR;
        PG8_STAGE(PG8_SB(1, 0), cB + kstep, voffB); PG8_STAGE_A(1, 0, cA + kstep, false); PG8_STAGE(PG8_SB(1, 1), cB + hstepB + kstep, voffB);
        PG8_WAIT_V(6); PG8_BAR;
    } else {
        PG8_STAGE(PG8_SB(0, 0), cB, voffB); PG8_STAGE(PG8_SA(0, 0), cA, voffA); PG8_STAGE(PG8_SB(0, 1), cB + hstepB, voffB); PG8_STAGE(PG8_SA(0, 1), cA + hstepA, voffA);
        if (wr == 1) PG8_BAR;
        PG8_WAIT_V(4); PG8_BAR;
        PG8_STAGE(PG8_SB(1, 0), cB + kstep, voffB); PG8_STAGE(PG8_SA(1, 0), cA + kstep, voffA); PG8_STAGE(PG8_SB(1, 1), cB + hstepB + kstep, voffB);
        PG8_WAIT_V(6); PG8_BAR;
    }
    for (;;) {
        const bool has_next = S.next(ui + 1, nxt);
        const char* nA = has_next ? nxt.A : cA; const char* nB = has_next ? nxt.B : cB;
        if constexpr (GATHER) { if (has_next && wid < 4) glds4s((unsigned)lane * 4u, (const void*)(nxt.G + wid * 64), ldsbase + (unsigned)STAGE_BYTES + (unsigned)(((ui + 1) & 1) * 1024 + wid * 256)); }
#pragma unroll 1
        for (int t = 0; t < nt; t += 2) {
            const bool last = (t == nt - 2);
            const char* a1 = cA + (size_t)(t + 1) * kstep;
            const char* a2 = last ? nA : cA + (size_t)(t + 2) * kstep; const char* b2 = last ? nB : cB + (size_t)(t + 2) * kstep;
            const char* a3 = a2 + kstep; const char* b3 = b2 + kstep;
            if constexpr (SP2) {
            if constexpr (GATHER) { if (last) { if (has_next) PG8_GIDX(vn, (ui + 1) & 1); else { vn[0][0] = vc[0][0]; vn[0][1] = vc[0][1]; vn[1][0] = vc[1][0]; vn[1][1] = vc[1][1]; } } }
            PG8_LDB(B0, 0, 0); PG8_LDB(B1, 0, 1); PG8_SCHED; PG8_LDA(At, 0, 0); PG8_STAGE_A(1, 1, a1, false);
            PG8_WAIT_V(8); PG8_WAIT_L(0); PG8_BAR; PG8_MMA(0, 0, At, B0); PG8_MMA(0, 1, At, B1); PG8_BAR; PG8_SCHED;
            PG8_LDA(At, 0, 1); PG8_STAGE(PG8_SB(0, 0), b2, voffB); PG8_STAGE(PG8_SB(0, 1), b2 + hstepB, voffB); PG8_STAGE_A(0, 0, a2, last);
            PG8_WAIT_V(8); PG8_WAIT_L(0); PG8_BAR; PG8_MMA(1, 0, At, B0); PG8_MMA(1, 1, At, B1); PG8_BAR; PG8_SCHED;
            PG8_LDB(B0, 1, 0); PG8_LDB(B1, 1, 1); PG8_SCHED; PG8_LDA(At, 1, 0); PG8_STAGE_A(0, 1, a2, last);
            PG8_WAIT_V(8); PG8_WAIT_L(0); PG8_BAR; PG8_MMA(0, 0, At, B0); PG8_MMA(0, 1, At, B1); PG8_BAR; PG8_SCHED;
            PG8_LDA(At, 1, 1); PG8_STAGE(PG8_SB(1, 0), b3, voffB); PG8_STAGE(PG8_SB(1, 1), b3 + hstepB, voffB); PG8_STAGE_A(1, 0, a3, last);
            PG8_WAIT_V(8); PG8_WAIT_L(0); PG8_BAR; PG8_MMA(1, 0, At, B0); PG8_MMA(1, 1, At, B1); PG8_BAR; PG8_SCHED;
            } else {
            PG8_LDB(B0, 0, 0); PG8_SCHED; PG8_LDA(At, 0, 0); PG8_STAGE(PG8_SA(1, 1), a1 + hstepA, voffA);
            PG8_WAIT_L(8); PG8_BAR; PG8_WAIT_L(0); PG8_MMA(0, 0, At, B0); PG8_BAR; PG8_SCHED;
            PG8_LDB(B1, 0, 1); PG8_STAGE(PG8_SB(0, 0), b2, voffB);
            PG8_BAR; PG8_WAIT_L(0); PG8_MMA(0, 1, At, B1); PG8_BAR;
            PG8_LDA(At, 0, 1); PG8_STAGE(PG8_SA(0, 0), a2, voffA);
            PG8_BAR; PG8_WAIT_L(0); PG8_MMA(1, 0, At, B0); PG8_BAR; PG8_SCHED;
            PG8_STAGE(PG8_SB(0, 1), b2 + hstepB, voffB);
            PG8_WAIT_V(6); PG8_BAR; PG8_MMA(1, 1, At, B1); PG8_BAR;
            PG8_LDB(B0, 1, 0); PG8_SCHED; PG8_LDA(At, 1, 0); PG8_STAGE(PG8_SA(0, 1), a2 + hstepA, voffA);
            PG8_WAIT_L(8); PG8_BAR; PG8_WAIT_L(0); PG8_MMA(0, 0, At, B0); PG8_BAR; PG8_SCHED;
            PG8_LDB(B1, 1, 1); PG8_STAGE(PG8_SB(1, 0), b3, voffB);
            PG8_BAR; PG8_WAIT_L(0); PG8_MMA(0, 1, At, B1); PG8_BAR;
            PG8_LDA(At, 1, 1); PG8_STAGE(PG8_SA(1, 0), a3, voffA);
            PG8_BAR; PG8_WAIT_L(0); PG8_MMA(1, 0, At, B0); PG8_BAR; PG8_SCHED;
            PG8_STAGE(PG8_SB(1, 1), b3 + hstepB, voffB);
            PG8_WAIT_V(6); PG8_BAR; PG8_MMA(1, 1, At, B1); PG8_BAR;
            }
        }
        if constexpr (FP8) asm volatile("s_nop 15\n\ts_nop 15" ::: "memory");
        if constexpr (ALIGN_EPI) { if (wr == 0) PG8_BAR; }
        E(acc, cur, wr, wc, fr, fq);
        if (!has_next) break;
        if (!(Epi::KEEP && cur.keep)) {
#pragma unroll
        for (int a = 0; a < 2; ++a)
#pragma unroll
            for (int b = 0; b < 2; ++b)
#pragma unroll
                for (int m = 0; m < 4; ++m)
#pragma unroll
                    for (int n = 0; n < 2; ++n) acc[a][b][m][n] = (f32x4){0.f, 0.f, 0.f, 0.f};
        }
        cur = nxt; cA = nA; cB = nB; ++ui;
        if constexpr (GATHER) { vc[0][0] = vn[0][0]; vc[0][1] = vn[0][1]; vc[1][0] = vn[1][0]; vc[1][1] = vn[1][1]; }
        if constexpr (ALIGN_EPI) { if (wr == 1) PG8_BAR; }
    }
    PG8_WAIT_V(0);
    if constexpr (!ALIGN_EPI) { if (wr == 0) PG8_BAR; }
    PG8_BAR;
#undef PG8_SA
#undef PG8_SB
#undef PG8_STAGE
#undef PG8_STAGE_A
#undef PG8_GIDX
#undef PG8_LDA
#undef PG8_LDB
#undef PG8_MMA
#undef PG8_WAIT_V
#undef PG8_WAIT_L
#undef PG8_BAR
#undef PG8_SCHED
}

struct PlainOrder {
    const char* A; const char* B; size_t astep, bstep; int nM, nN, G, c;
    __device__ __forceinline__ bool next(int i, Unit& u) const {
        const int L = i * G + c; if (L >= nM * nN) return false;
        const int nig = 8 * nN, gid = L / nig, fm = gid * 8, gsz = (nM - fm) < 8 ? (nM - fm) : 8;
        const int pm = fm + ((L % nig) % gsz), pn = (L % nig) / gsz;
        u.A = A + (size_t)pm * astep; u.B = B + (size_t)pn * bstep; u.row0 = pm * 256; u.col0 = pn * 256; u.aux = 0; u.keep = 0; u.G = nullptr; return true;
    }
};
struct MergeOrder {
    const char* A; const char* B; size_t astep, bstep; int nM, nN, G, c;
    __device__ __forceinline__ bool next(int i, Unit& u) const {
        const int t = i / 3, seg = i - 3 * t;
        const int L = t * G + c; if (L >= nM * nN) return false;
        const int nig = 8 * nN, gid = L / nig, fm = gid * 8, gsz = (nM - fm) < 8 ? (nM - fm) : 8;
        const int pm = fm + ((L % nig) % gsz), pn = (L % nig) / gsz;
        u.A = A + (size_t)pm * astep + seg * 512; u.B = B + (size_t)pn * bstep + seg * 512; u.row0 = pm * 256; u.col0 = pn * 256; u.aux = seg; u.keep = seg < 2; u.G = nullptr; return true;
    }
};
struct ExpertOrder {
    const char* A; const char* B; size_t astep, bstep, aexp, bexp; int nM, nN, G, c; const int* rows;
    __device__ __forceinline__ bool next(int i, Unit& u) const {
        const int L = i * G + c, per = nM * nN; if (L >= NE * per) return false;
        const int e = L / per, r = L - e * per;
        const int nig = 8 * nN, gid = r / nig, fm = gid * 8, gsz = (nM - fm) < 8 ? (nM - fm) : 8;
        const int pm = fm + ((r % nig) % gsz), pn = (r % nig) / gsz;
        u.A = A + (size_t)e * aexp + (size_t)pm * astep; u.B = B + (size_t)e * bexp + (size_t)pn * bstep; u.row0 = e * EROWS + pm * 256; u.col0 = pn * 256; u.aux = e; u.keep = 0; u.G = rows ? rows + u.row0 : nullptr; return true;
    }
};
__device__ __forceinline__ unsigned q8(float g) {
    const float sg = __builtin_amdgcn_rcpf(1.f + __builtin_amdgcn_exp2f(g * -1.4426950408889634f));
    return (unsigned)__builtin_amdgcn_fmed3f(sg * 255.f + 0.5f, 1.f, 255.f);
}
struct EpiIn {
    static constexpr bool PERM = true, KEEP = false;
    bf16_t* P; unsigned char* PG;
    __device__ __forceinline__ void operator()(f32x4 (&acc)[2][2][4][2], const Unit& u, int wr, int wc, int fr, int fq) const {
        const int row0 = u.row0 + wr * 64 + fr, cl = u.col0 + wc * 32 + 8 * fq; const bool mg = u.col0 >= C_MG;
        if (mg) {
#pragma unroll
            for (int ai = 0; ai < 2; ++ai)
#pragma unroll
                for (int m = 0; m < 4; ++m) { unsigned char* rowp = PG + (size_t)(row0 + ai * HALF + m * 16) * 3072 + (cl - C_MG);
#pragma unroll
                    for (int bj = 0; bj < 2; ++bj) { const f32x4 v0 = acc[ai][bj][m][0], v1 = acc[ai][bj][m][1]; u32x2 w;
                        w.x = q8(v0[0]) | (q8(v0[1]) << 8) | (q8(v0[2]) << 16) | (q8(v0[3]) << 24); w.y = q8(v1[0]) | (q8(v1[1]) << 8) | (q8(v1[2]) << 16) | (q8(v1[3]) << 24);
                        *(u32x2*)(rowp + bj * HALF) = w; } }
        } else {
#pragma unroll
            for (int ai = 0; ai < 2; ++ai)
#pragma unroll
                for (int m = 0; m < 4; ++m) { bf16_t* rowp = P + (size_t)(row0 + ai * HALF + m * 16) * PC + cl;
#pragma unroll
                    for (int bj = 0; bj < 2; ++bj) { const f32x4 v0 = acc[ai][bj][m][0], v1 = acc[ai][bj][m][1]; u32x4 w; w.x = cvt_pk_bf16(v0[0], v0[1]); w.y = cvt_pk_bf16(v0[2], v0[3]); w.z = cvt_pk_bf16(v1[0], v1[1]); w.w = cvt_pk_bf16(v1[2], v1[3]);
                        *(u32x4*)(rowp + bj * HALF) = w; } }
        }
    }
};
__device__ __forceinline__ float ub(unsigned w, int i) { return (float)((w >> (8 * i)) & 0xFFu); }
struct EpiMerge {
    static constexpr bool PERM = true, KEEP = true;
    const unsigned char* PG; bf16_t* MPRE;
    __device__ __forceinline__ void operator()(f32x4 (&acc)[2][2][4][2], const Unit& u, int wr, int wc, int fr, int fq) const {
        const int row0 = u.row0 + wr * 64 + fr, cl = u.col0 + wc * 32 + 8 * fq, seg = u.aux;
#pragma unroll
        for (int ai = 0; ai < 2; ++ai) {
            u32x2 g0[4][2], g1[4][2];
#pragma unroll
            for (int m = 0; m < 4; ++m) { const unsigned char* gp = PG + (size_t)(row0 + ai * HALF + m * 16) * 3072 + seg * 1024 + cl;
#pragma unroll
                for (int bj = 0; bj < 2; ++bj) { g0[m][bj] = *(const u32x2*)(gp + bj * HALF); g1[m][bj] = (seg < 2) ? *(const u32x2*)(gp + 1024 + bj * HALF) : (u32x2){0u, 0u}; } }
            __builtin_amdgcn_sched_barrier(0);
#pragma unroll
            for (int m = 0; m < 4; ++m) { const int row = row0 + ai * HALF + m * 16;
#pragma unroll
                for (int bj = 0; bj < 2; ++bj) {
                    float f[8];
#pragma unroll
                    for (int e = 0; e < 4; ++e) { f[e] = ub(g0[m][bj].x, e); f[4 + e] = ub(g0[m][bj].y, e); }
                    if (seg < 2) {
#pragma unroll
                        for (int e = 0; e < 4; ++e) { f[e] *= __builtin_amdgcn_rcpf(ub(g1[m][bj].x, e)); f[4 + e] *= __builtin_amdgcn_rcpf(ub(g1[m][bj].y, e)); }
                        acc[ai][bj][m][0] *= (f32x4){f[0], f[1], f[2], f[3]}; acc[ai][bj][m][1] *= (f32x4){f[4], f[5], f[6], f[7]};
                    } else {
                        const f32x4 v0 = acc[ai][bj][m][0] * (1.f / 255.f), v1 = acc[ai][bj][m][1] * (1.f / 255.f); u32x4 w;
                        w.x = cvt_pk_bf16(v0[0] * f[0], v0[1] * f[1]); w.y = cvt_pk_bf16(v0[2] * f[2], v0[3] * f[3]); w.z = cvt_pk_bf16(v1[0] * f[4], v1[1] * f[5]); w.w = cvt_pk_bf16(v1[2] * f[6], v1[3] * f[7]);
                        *(u32x4*)(MPRE + (size_t)row * DM + cl + bj * HALF) = w; }
                } }
        }
    }
};
struct EpiOut {
    static constexpr bool PERM = false, KEEP = false;
    float* X; const float* mod;
    __device__ __forceinline__ void operator()(f32x4 (&acc)[2][2][4][2], const Unit& u, int wr, int wc, int fr, int fq) const {
        const int row0 = u.row0 + wr * 64 + fr, col0 = u.col0 + wc * 32 + 4 * fq;
        const float* g1 = mod + mod_row(u.row0) * 6144 + 2048 + col0;
        f32x4 gv[2][2];
#pragma unroll
        for (int bj = 0; bj < 2; ++bj)
#pragma unroll
            for (int n = 0; n < 2; ++n) gv[bj][n] = *(const f32x4*)(g1 + bj * HALF + n * 16);
#pragma unroll
        for (int ai = 0; ai < 2; ++ai)
#pragma unroll
            for (int m = 0; m < 4; ++m) { float* rowp = X + (size_t)(row0 + ai * HALF + m * 16) * DM + col0;
#pragma unroll
                for (int bj = 0; bj < 2; ++bj)
#pragma unroll
                    for (int n = 0; n < 2; ++n) { float* xp = rowp + bj * HALF + n * 16; *(f32x4*)xp = *(const f32x4*)xp + gv[bj][n] * acc[ai][bj][m][n]; } }
    }
};
__device__ __forceinline__ float clamp8(float v) { return __builtin_amdgcn_fmed3f(v, -448.f, 448.f); }
__device__ __forceinline__ unsigned pk4_fp8(float a, float b, float c, float d) { int w = 0; a = clamp8(a); b = clamp8(b); c = clamp8(c); d = clamp8(d); w = __builtin_amdgcn_cvt_pk_fp8_f32(a, b, w, false); w = __builtin_amdgcn_cvt_pk_fp8_f32(c, d, w, true); return (unsigned)w; }
struct EpiGate8 {
    static constexpr bool PERM = true, KEEP = false;
    unsigned char* PG; float s;
    __device__ __forceinline__ void operator()(f32x4 (&acc)[2][2][4][2], const Unit& u, int wr, int wc, int fr, int fq) const {
        const int row0 = u.row0 + wr * 64 + fr, cl = u.col0 + wc * 32 + 8 * fq;
#pragma unroll
        for (int ai = 0; ai < 2; ++ai)
#pragma unroll
            for (int m = 0; m < 4; ++m) { unsigned char* rowp = PG + (size_t)(row0 + ai * HALF + m * 16) * 3072 + cl;
#pragma unroll
                for (int bj = 0; bj < 2; ++bj) { const f32x4 v0 = acc[ai][bj][m][0] * s, v1 = acc[ai][bj][m][1] * s; u32x2 w;
                    w.x = q8(v0[0]) | (q8(v0[1]) << 8) | (q8(v0[2]) << 16) | (q8(v0[3]) << 24); w.y = q8(v1[0]) | (q8(v1[1]) << 8) | (q8(v1[2]) << 16) | (q8(v1[3]) << 24);
                    *(u32x2*)(rowp + bj * HALF) = w; } }
    }
};
struct EpiGU8 {
    static constexpr bool PERM = true, KEEP = false;
    unsigned char* H; float s, hs;
    typedef float f32x2 __attribute__((ext_vector_type(2)));
    static __device__ __forceinline__ f32x2 gu2(f32x2 g, f32x2 u, f32x2 ne, f32x2 nlc, f32x2 ic) {
        const f32x2 t = __builtin_elementwise_fma(g, ne, nlc);
        f32x2 e; e.x = __builtin_amdgcn_exp2f(t.x); e.y = __builtin_amdgcn_exp2f(t.y);
        const f32x2 d = e + ic;
        f32x2 r; r.x = __builtin_amdgcn_rcpf(d.x); r.y = __builtin_amdgcn_rcpf(d.y);
        return (g * u) * r;
    }
    __device__ __forceinline__ void operator()(f32x4 (&acc)[2][2][4][2], const Unit& u, int wr, int wc, int fr, int fq) const {
        const int row0 = u.row0 + wr * 64 + fr, hc = (u.col0 >> 1) + wc * 32 + 8 * fq;
        const float c = s * s * hs, nef = -s * 1.4426950408889634f, nlcf = -__builtin_log2f(c), icf = 1.f / c;
        const f32x2 ne = {nef, nef}, nlc = {nlcf, nlcf}, ic = {icf, icf};
#pragma unroll
        for (int ai = 0; ai < 2; ++ai)
#pragma unroll
            for (int m = 0; m < 4; ++m) { const f32x4 g0 = acc[ai][0][m][0], g1 = acc[ai][0][m][1], u0 = acc[ai][1][m][0], u1 = acc[ai][1][m][1]; u32x2 w;
                const f32x2 a0 = gu2((f32x2){g0[0], g0[1]}, (f32x2){u0[0], u0[1]}, ne, nlc, ic), a1 = gu2((f32x2){g0[2], g0[3]}, (f32x2){u0[2], u0[3]}, ne, nlc, ic);
                const f32x2 b0 = gu2((f32x2){g1[0], g1[1]}, (f32x2){u1[0], u1[1]}, ne, nlc, ic), b1 = gu2((f32x2){g1[2], g1[3]}, (f32x2){u1[2], u1[3]}, ne, nlc, ic);
                w.x = pk4_fp8(a0.x, a0.y, a1.x, a1.y); w.y = pk4_fp8(b0.x, b0.y, b1.x, b1.y);
                *(u32x2*)(H + (size_t)(row0 + ai * HALF + m * 16) * FF + hc) = w; }
    }
};
struct EpiDown {
    static constexpr bool PERM = true, KEEP = false;
    bf16_t* Y; float s;
    __device__ __forceinline__ void operator()(f32x4 (&acc)[2][2][4][2], const Unit& u, int wr, int wc, int fr, int fq) const {
        const int row0 = u.row0 + wr * 64 + fr, cl = u.col0 + wc * 32 + 8 * fq;
#pragma unroll
        for (int ai = 0; ai < 2; ++ai)
#pragma unroll
            for (int m = 0; m < 4; ++m) { bf16_t* rowp = Y + (size_t)(row0 + ai * HALF + m * 16) * DM + cl;
#pragma unroll
                for (int bj = 0; bj < 2; ++bj) { const f32x4 v0 = acc[ai][bj][m][0] * s, v1 = acc[ai][bj][m][1] * s; u32x4 w; w.x = cvt_pk_bf16(v0[0], v0[1]); w.y = cvt_pk_bf16(v0[2], v0[3]); w.z = cvt_pk_bf16(v1[0], v1[1]); w.w = cvt_pk_bf16(v1[2], v1[3]);
                    *(u32x4*)(rowp + bj * HALF) = w; } }
    }
};
}

__device__ __forceinline__ void st_adaln(KP p, unsigned char* lds) {
    float* sc = (float*)lds;
    float* red = sc + 9 * 1024;
    const int tid = ltid(), wid = tid >> 6, lane = tid & 63;
    __syncthreads();
    for (int i = tid; i < 9 * 1024; i += NTHREADS) { const int r = i >> 10, k = i & 1023; const float v = r < 8 ? p->in[I_C][r * 1024 + k] : p->in[I_CCTX][k]; sc[i] = siluf(v); }
    __syncthreads();
    for (int u = lbid(); u < NL * 96; u += lgrid()) {
        const int l = u / 96, n = (u % 96) * 64 + lane;
        const float* w = p->in[I_WADA] + (size_t)l * 1024 * 6144 + n;
        float a[9];
#pragma unroll
        for (int r = 0; r < 9; ++r) a[r] = 0.f;
#pragma unroll 16
        for (int k = wid * 128; k < wid * 128 + 128; ++k) {
            const float wv = w[(size_t)k * 6144];
#pragma unroll
            for (int r = 0; r < 9; ++r) a[r] += sc[r * 1024 + k] * wv;
        }
#pragma unroll
        for (int r = 0; r < 9; ++r) red[(wid * 9 + r) * 64 + lane] = a[r];
        __syncthreads();
        for (int i = tid; i < 9 * 64; i += NTHREADS) {
            const int r = i >> 6, c = i & 63; float s = 0.f;
#pragma unroll
            for (int w8 = 0; w8 < 8; ++w8) s += red[(w8 * 9 + r) * 64 + c];
            const int nn = (u % 96) * 64 + c;
            p->MOD[((size_t)l * 9 + r) * 6144 + nn] = s + p->in[I_BADA][l * 6144 + nn];
        }
        __syncthreads();
    }
}
template <class RowMap>
__device__ __forceinline__ void cvt_tile(float* tile, const float* src, int N, int k0, int n0, bf16_t* dst, int ldd, int koff, const RowMap& rm, float scale = 1.f) {
    const int tid = ltid();
    __syncthreads();
#pragma unroll
    for (int i = 0; i < 8; ++i) { const int idx = i * NTHREADS + tid, kk = idx >> 6, nn = idx & 63; tile[kk * 65 + nn] = (n0 + nn < N) ? src[(size_t)(k0 + kk) * N + n0 + nn] * scale : 0.f; }
    __syncthreads();
    const int nn = tid >> 3, kc = tid & 7; const int dr = rm(n0 + nn);
    if (n0 + nn < N && dr >= 0) {
        u32x4 w; const float* t = tile + (kc * 8) * 65 + nn;
        w.x = pack2(t[0], t[65]); w.y = pack2(t[130], t[195]); w.z = pack2(t[260], t[325]); w.w = pack2(t[390], t[455]);
        *(u32x4*)(dst + (size_t)dr * ldd + koff + k0 + kc * 8) = w;
    }
}
template <int KT, class RowMap>
__device__ __forceinline__ void cvt_tile8(float* tile, const float* src, int N, int k0, int n0, unsigned char* dst, int ldd, const RowMap& rm, float scale) {
    const int tid = ltid();
    __syncthreads();
#pragma unroll
    for (int i = 0; i < KT / 32; ++i) { const int idx = i * NTHREADS + tid, kk = idx >> 4, n4 = (idx & 15) * 4;
        const f32x4 v = (n0 + n4 < N) ? *(const f32x4*)(src + (size_t)(k0 + kk) * N + n0 + n4) : (f32x4){0.f, 0.f, 0.f, 0.f};
        float* t = tile + kk * 65 + n4; t[0] = v[0] * scale; t[1] = v[1] * scale; t[2] = v[2] * scale; t[3] = v[3] * scale; }
    __syncthreads();
    const int nn = tid >> 3, kc = tid & 7; const int dr = (n0 + nn < N) ? rm(n0 + nn) : -1;
    if (dr >= 0) {
#pragma unroll
        for (int h = 0; h < KT / 64; ++h) { u32x2 w; const float* t = tile + (h * 64 + kc * 8) * 65 + nn;
            w.x = pg8::pk4_fp8(t[0], t[65], t[130], t[195]); w.y = pg8::pk4_fp8(t[260], t[325], t[390], t[455]);
            *(u32x2*)(dst + (size_t)dr * ldd + k0 + h * 64 + kc * 8) = w; } }
}
__device__ __forceinline__ void store_row_fp8(unsigned char* dst, const f32x4 (&x)[4], int lane, float sc) {
#pragma unroll
    for (int i = 0; i < 4; ++i) *(unsigned*)(dst + lane * 4 + 256 * i) = pg8::pk4_fp8(x[i][0] * sc, x[i][1] * sc, x[i][2] * sc, x[i][3] * sc);
}
struct MapIn  { __device__ __forceinline__ int operator()(int n) const { return n < 1536 ? n : ((n < 1568 || n >= 2080) ? -1 : n + 224); } };
struct MapInG { __device__ __forceinline__ int operator()(int n) const { return n >= 2080 ? n - 2080 : -1; } };
struct MapId  { __device__ __forceinline__ int operator()(int n) const { return n; } };
struct MapGU  { int up; __device__ __forceinline__ int operator()(int n) const { return (n >> 7) * 256 + up * 128 + (n & 127); } };
constexpr int CV_IN = 16 * 81, CV_WB = 3 * 64, CV_OUT = 256, CV_G = 16 * 128, CV_D = 16 * 128, CV_LAYER = CV_IN + CV_WB + CV_OUT + 2 * CV_G + CV_D;
__device__ __forceinline__ void st_convert(KP p, unsigned char* lds, int l_lo, int l_hi) {
    float* tile = (float*)lds;
    for (int u = l_lo * CV_LAYER + lbid(); u < l_hi * CV_LAYER; u += lgrid()) {
        const int l = u / CV_LAYER; int r = u % CV_LAYER;
        if (r < CV_IN) { const int nt_ = r % 81;
            if (nt_ <= 32) cvt_tile(tile, p->in[I_WIN] + (size_t)l * DM * INC, INC, (r / 81) * 64, nt_ * 64, p->WIN + (size_t)l * PC * DM, DM, 0, MapIn(), nt_ < 4 ? 0.125f * 1.4426950408889634f : 1.f);
            if (nt_ >= 32) cvt_tile8<64>(tile, p->in[I_WIN] + (size_t)l * DM * INC, INC, (r / 81) * 64, nt_ * 64, p->WING8 + (size_t)l * 3072 * DM, DM, MapInG(), S8_W);
            continue; }
        r -= CV_IN;
        if (r < CV_WB) { const int br = r / 64, t = r % 64; cvt_tile(tile, p->in[I_WBA + br] + (size_t)l * 256 * DM, DM, (t / 16) * 64, (t % 16) * 64, p->WB + (size_t)l * DM * 768, 768, br * 256, MapId()); continue; }
        r -= CV_WB;
        if (r < CV_OUT) { cvt_tile(tile, p->in[I_WOUT] + (size_t)l * DM * DM, DM, (r / 16) * 64, (r % 16) * 64, p->WOUT + (size_t)l * DM * DM, DM, 0, MapId()); continue; }
        r -= CV_OUT;
        if (r < 2 * CV_G) { const int up = r / CV_G, rr = r % CV_G, e = rr / 128, t = rr % 128;
            cvt_tile8<256>(tile, p->in[up ? I_WEU : I_WEG] + ((size_t)l * NE + e) * DM * FF, FF, (t / 32) * 256, (t % 32) * 64, p->WGU + ((size_t)l * NE + e) * 2 * FF * DM, DM, MapGU{up}, S8_W); continue; }
        r -= 2 * CV_G;
        { const int e = r / 128, t = r % 128; cvt_tile8<256>(tile, p->in[I_WED] + ((size_t)l * NE + e) * FF * DM, DM, (t / 16) * 256, (t % 16) * 64, p->WD + ((size_t)l * NE + e) * DM * FF, FF, MapId(), S8_W); }
    }
}
__device__ __forceinline__ void st_fold(KP p) {
    for (int i = lbid() * NTHREADS + ltid(); i < NL * 256 * DM; i += lgrid() * NTHREADS) {
        const int l = i / (256 * DM), r = i % (256 * DM), nn = r / DM, k = r % DM, dir = nn >> 7, n = nn & 127;
        const float* wi = p->in[I_WIN] + ((size_t)l * DM + k) * INC + 1536 + dir * 16;
        const float* wg = p->in[dir ? I_WGB : I_WGF] + (size_t)l * 16 * 128 + n;
        float s = 0.f;
#pragma unroll
        for (int j = 0; j < 16; ++j) s += wi[j] * wg[j * 128];
        p->WIN[((size_t)l * PC + C_G + nn) * DM + k] = f2bf(s);
    }
}
__device__ __forceinline__ void norm_mod_row(f32x4 (&x)[4], const float* g, const float* sh, const float* sc, int lane) {
    float ss = 0.f;
#pragma unroll
    for (int i = 0; i < 4; ++i) ss += x[i][0] * x[i][0] + x[i][1] * x[i][1] + x[i][2] * x[i][2] + x[i][3] * x[i][3];
    ss = wave_sum(ss);
    const float rs = rsqrtf(ss * (1.f / DM) + EPS);
#pragma unroll
    for (int i = 0; i < 4; ++i) {
        const int c = lane * 4 + 256 * i;
        const f32x4 gv = *(const f32x4*)(g + c), sv = *(const f32x4*)(sh + c), cv = *(const f32x4*)(sc + c);
        x[i] = (x[i] * rs) * gv * (cv + 1.f) + sv;
    }
}
__device__ __forceinline__ void store_row_bf16(bf16_t* dst, const f32x4 (&x)[4], int lane) {
#pragma unroll
    for (int i = 0; i < 4; ++i) { u32x2 w; w.x = pack2(x[i][0], x[i][1]); w.y = pack2(x[i][2], x[i][3]); *(u32x2*)(dst + lane * 4 + 256 * i) = w; }
}
__device__ __forceinline__ void store_row_fp8(unsigned char* dst, const f32x4 (&x)[4], int lane, float sc);
__device__ __forceinline__ void st_norm1(KP p, int l) {
    const int wid = ltid() >> 6, lane = ltid() & 63;
    const float* mod = p->MOD + (size_t)l * 9 * 6144; const float* g = p->in[I_N1G] + l * DM;
    for (int R = lbid() * 8 + wid; R < MT; R += lgrid() * 8) {
        const float* src = R < NLAT ? p->in[I_X] + (size_t)R * DM : p->in[I_CTX] + (size_t)(R - NLAT) * DM;
        f32x4 x[4];
#pragma unroll
        for (int i = 0; i < 4; ++i) { x[i] = *(const f32x4*)(src + lane * 4 + 256 * i); *(f32x4*)(p->X + (size_t)R * DM + lane * 4 + 256 * i) = x[i]; }
        const float* m = mod + mod_row(R) * 6144;
        norm_mod_row(x, g, m, m + 1024, lane);
        store_row_bf16(p->U + (size_t)R * DM, x, lane);
        store_row_fp8(p->U8W + (size_t)R * DM, x, lane, S8_U);
    }
}

__device__ __forceinline__ void st_qkrope(KP p, int l, unsigned char* lds) {
    float* tab = (float*)lds;
    const int tid = ltid(), wid = tid >> 6, lane = tid & 63;
    __syncthreads();
    for (int i = tid; i < 1024; i += NTHREADS) { const int pos = i >> 4, f = i & 15; const float inv = powf(10000.f, -(float)f / 16.f); const float a = (float)pos * inv; tab[i] = cosf(a); tab[1024 + i] = sinf(a); }
    __syncthreads();
    const float qg = p->in[I_QNG][l * 64 + lane] * (0.125f * 1.4426950408889634f), kg = p->in[I_KNG][l * 64 + lane];
    const int f = lane & 15;
    const int stride = lgrid() * 8;
    for (int R0 = lbid() * 8 + wid; R0 < MT; R0 += 2 * stride) {
        const int R1 = R0 + stride; const bool has1 = R1 < MT;
        bf16_t* p0 = p->P + (size_t)R0 * PC + C_QC + lane; bf16_t* p1 = p->P + (size_t)(has1 ? R1 : R0) * PC + C_QC + lane;
        float v0[6], v1[6];
#pragma unroll
        for (int j = 0; j < 6; ++j) { v0[j] = bf2f(p0[j * 64]); v1[j] = bf2f(p1[j * 64]); }
#pragma unroll
        for (int rr = 0; rr < 2; ++rr) {
            const int R = rr ? R1 : R0; if (rr && !has1) break;
            bf16_t* pp = rr ? p1 : p0;
#pragma unroll
            for (int j = 0; j < 6; ++j) {
                float v = rr ? v1[j] : v0[j];
                const float ss = wave_sum(v * v);
                v = v * rsqrtf(ss * (1.f / 64.f) + EPS) * (j < 4 ? qg : kg);
                if (R < NLAT) {
                    const int t = R & (TL - 1), pos = (lane < 32) ? (t >> 6) : (t & 63);
                    const float other = __shfl_xor(v, 16);
                    const float c = tab[pos * 16 + f], sn = tab[1024 + pos * 16 + f];
                    v = (lane & 16) ? (v * c + other * sn) : (v * c - other * sn);
                }
                pp[j * 64] = f2bf(v);
            }
        }
    }
}

namespace att {
typedef float f32x16 __attribute__((ext_vector_type(16)));
typedef short s16x4 __attribute__((ext_vector_type(4)));
constexpr int NSLOT = 3, SLOTB = 8192;
constexpr int LDS_K = 0, LDS_V = NSLOT * SLOTB, LDS_WS = 2 * NSLOT * SLOTB, LDS_OST = LDS_WS + 8 * 64 * 4, LDS_BIAS = LDS_OST + 8 * 4096, LDS_TOTAL = LDS_BIAS + 16 * 32 * 4;
constexpr float C2 = 0.125f * 1.4426950408889634f;
constexpr float LOG2E = 1.4426950408889634f;
constexpr float THR = 8.f;
__device__ __forceinline__ int crow(int r, int hi) { return (r & 3) + 8 * (r >> 2) + 4 * hi; }
__device__ __forceinline__ void glds16(const void* gsrc, unsigned lds_dst) { unsigned keep;
    asm volatile("s_mov_b32 %0, m0\n\ts_mov_b32 m0, %2\n\ts_nop 0\n\tglobal_load_lds_dwordx4 %1, off\n\ts_mov_b32 m0, %0" : "=&s"(keep) : "v"(gsrc), "s"(lds_dst) : "memory"); }
__device__ __forceinline__ unsigned cvtpk(float lo, float hi) { unsigned r; asm volatile("v_cvt_pk_bf16_f32 %0, %1, %2" : "=v"(r) : "v"(lo), "v"(hi)); return r; }
#define ATT_WAIT_BAR(N) asm volatile("s_waitcnt vmcnt(" #N ") lgkmcnt(0)\n\ts_barrier" ::: "memory")
__device__ __forceinline__ void qkt(f32x16& p0, f32x16& p1, const LAS unsigned char* Kslot, const bf16x8* qr, const f32x16& negm, int r32, int hi) {
    const unsigned ka = (unsigned)(uintptr_t)(Kslot + hi * 1024 + r32 * 16);
    bf16x8 b[8];
#pragma unroll
    for (int i = 0; i < 8; ++i) asm volatile("ds_read_b128 %0, %1 offset:%c2" : "=&v"(b[i]) : "v"(ka), "i"((i >> 1) * 2048 + (i & 1) * 512) : "memory");
    asm volatile("s_waitcnt lgkmcnt(6)" ::: "memory"); __builtin_amdgcn_sched_barrier(0);
    p0 = __builtin_amdgcn_mfma_f32_32x32x16_bf16(b[0], qr[0], negm, 0, 0, 0); p1 = __builtin_amdgcn_mfma_f32_32x32x16_bf16(b[1], qr[0], negm, 0, 0, 0);
    asm volatile("s_waitcnt lgkmcnt(4)" ::: "memory"); __builtin_amdgcn_sched_barrier(0);
    p0 = __builtin_amdgcn_mfma_f32_32x32x16_bf16(b[2], qr[1], p0, 0, 0, 0); p1 = __builtin_amdgcn_mfma_f32_32x32x16_bf16(b[3], qr[1], p1, 0, 0, 0);
    asm volatile("s_waitcnt lgkmcnt(2)" ::: "memory"); __builtin_amdgcn_sched_barrier(0);
    p0 = __builtin_amdgcn_mfma_f32_32x32x16_bf16(b[4], qr[2], p0, 0, 0, 0); p1 = __builtin_amdgcn_mfma_f32_32x32x16_bf16(b[5], qr[2], p1, 0, 0, 0);
    asm volatile("s_waitcnt lgkmcnt(0)" ::: "memory"); __builtin_amdgcn_sched_barrier(0);
    p0 = __builtin_amdgcn_mfma_f32_32x32x16_bf16(b[6], qr[3], p0, 0, 0, 0); p1 = __builtin_amdgcn_mfma_f32_32x32x16_bf16(b[7], qr[3], p1, 0, 0, 0);
}
__device__ __forceinline__ float rowmax(const f32x16& p0, const f32x16& p1) {
    float a = fmaxf(fmaxf(p0[0], p0[1]), p1[0]), b = fmaxf(fmaxf(p0[2], p0[3]), p1[1]); a = fmaxf(fmaxf(a, p1[2]), p1[3]);
#pragma unroll
    for (int r = 4; r < 16; r += 4) { a = fmaxf(fmaxf(a, p0[r]), p0[r + 1]); b = fmaxf(fmaxf(b, p0[r + 2]), p0[r + 3]); a = fmaxf(fmaxf(a, p1[r]), p1[r + 1]); b = fmaxf(fmaxf(b, p1[r + 2]), p1[r + 3]); }
    const float m = fmaxf(a, b);
    auto rr = __builtin_amdgcn_permlane32_swap(__float_as_uint(m), __float_as_uint(m), false, false);
    return fmaxf(__uint_as_float(rr[0]), __uint_as_float(rr[1]));
}
__device__ __forceinline__ void pv(f32x16* o, int vb, bf16x8 pa0, bf16x8 pa1, bf16x8 pa2, bf16x8 pa3) {
#pragma unroll
    for (int d0 = 0; d0 < 2; ++d0) { s16x4 lo[4], hi[4];
#pragma unroll
        for (int ks = 0; ks < 4; ++ks) {
            asm volatile("ds_read_b64_tr_b16 %0,%1 offset:%c2" : "=&v"(lo[ks]) : "v"(vb), "i"(d0 * 4096 + ks * 1024) : "memory");
            asm volatile("ds_read_b64_tr_b16 %0,%1 offset:%c2" : "=&v"(hi[ks]) : "v"(vb), "i"(d0 * 4096 + ks * 1024 + 512) : "memory"); }
        asm volatile("s_waitcnt lgkmcnt(0)" ::: "memory"); __builtin_amdgcn_sched_barrier(0);
#define ATT_PK(k) (bf16x8){lo[k][0], lo[k][1], lo[k][2], lo[k][3], hi[k][0], hi[k][1], hi[k][2], hi[k][3]}
        o[d0] = __builtin_amdgcn_mfma_f32_32x32x16_bf16(pa0, ATT_PK(0), o[d0], 0, 0, 0);
        o[d0] = __builtin_amdgcn_mfma_f32_32x32x16_bf16(pa1, ATT_PK(1), o[d0], 0, 0, 0);
        o[d0] = __builtin_amdgcn_mfma_f32_32x32x16_bf16(pa2, ATT_PK(2), o[d0], 0, 0, 0);
        o[d0] = __builtin_amdgcn_mfma_f32_32x32x16_bf16(pa3, ATT_PK(3), o[d0], 0, 0, 0);
#undef ATT_PK
    }
}
struct Desc {
    const bf16_t* Q;
    const bf16_t* KV;
    bf16_t* O;
    int kcol, vcol;
    int NT;
    int ctx_row0;
    int lat_row0;
    int rlo;
    int qrow;
};
template <int MODE>
__device__ __forceinline__ void attn_unit(const Desc& D, LAS unsigned char* shm) {
    const int tid = ltid(), lane = tid & 63, r32 = lane & 31, hi = lane >> 5; const int wid = __builtin_amdgcn_readfirstlane(tid >> 6);
    const unsigned lds0 = (unsigned)(uintptr_t)shm;
    LAS float* wsf = (LAS float*)(shm + LDS_WS) + wid * 64;
    const bf16_t* Qw = D.Q + (size_t)(wid * 32) * PC;
    bf16x8 qr[4];
#pragma unroll
    for (int d0 = 0; d0 < 4; ++d0) qr[d0] = *(const bf16x8*)(Qw + (size_t)r32 * PC + d0 * 16 + hi * 8);
    const bf16_t* kbase = D.KV + D.kcol + wid * 8 + (size_t)lane * PC;
    const bf16_t* vbase = D.KV + D.vcol + (wid >> 2) * 32 + (lane & 3) * 8 + (size_t)(16 * (wid & 3) + (lane >> 2)) * PC;
    const unsigned kdst = lds0 + LDS_K + wid * 1024, vdst = lds0 + LDS_V + wid * 1024;
    const int NT = D.NT;
#define ATT_TROW(t) ((t) < 4 ? D.ctx_row0 + 64 * (t) : D.lat_row0 + 64 * ((t) - 4))
#define ATT_DMA(t, slotoff) do { const int t_ = (t) < NT ? (t) : NT - 1; const size_t ro_ = (size_t)ATT_TROW(t_) * PC; \
        glds16(kbase + ro_, (unsigned)__builtin_amdgcn_readfirstlane(kdst + (slotoff))); glds16(vbase + ro_, (unsigned)__builtin_amdgcn_readfirstlane(vdst + (slotoff))); } while (0)
    ATT_DMA(0, 0); ATT_DMA(1, SLOTB);
    const int vb0 = (int)(lds0 + LDS_V) + ((lane >> 4) & 1) * 32 + (lane & 3) * 8 + (4 * hi + ((lane & 15) >> 2)) * 64;
    float mhat = 0.f, l_reg = 0.f; f32x16 o[2]; o[0] = f32x16{}; o[1] = f32x16{}; f32x16 negm = f32x16{};
    const int rq = D.qrow + (wid >> 1), cq = (wid & 1) * 32 + r32;
    const int rs = min(max(rq - 4, 0), 56), cs = min(max(cq - 8, 0), 48);
    const int L0 = 4 * hi - cq + 15, L1 = 4 * hi - cs;
    const LAS float* btab = (const LAS float*)(shm + LDS_BIAS);
    int slot = 0;
    for (int t = 0; t < NT; ++t) {
        ATT_WAIT_BAR(2);
        { const int s2 = slot == 0 ? 2 * SLOTB : slot - SLOTB; ATT_DMA(t + 2, s2); }
        bool active = true; int kr = 0;
        if (MODE == 1 && t >= 4) { kr = D.rlo + (t - 4); active = (kr >= rs) && (kr < rs + 8); }
        if (active) {
            f32x16 p0, p1;
            qkt(p0, p1, shm + LDS_K + slot, qr, negm, r32, hi);
            if (MODE == 1 && t >= 4) {
                const LAS float* brow = btab + (kr - rq + 7) * 32;
#pragma unroll
                for (int r = 0; r < 16; ++r) { const int kc = (r & 3) + 8 * (r >> 2);
                    { const int ix = L0 + kc, iv = L1 + kc; const float bv = brow[min(max(ix, 0), 30)]; p0[r] = ((unsigned)iv < 16u) ? p0[r] + bv : -INFINITY; }
                    { const int ix = L0 + kc + 32, iv = L1 + kc + 32; const float bv = brow[min(max(ix, 0), 30)]; p1[r] = ((unsigned)iv < 16u) ? p1[r] + bv : -INFINITY; } }
            }
            const float rm = rowmax(p0, p1);
            bool resc = false;
            if (t == 0) { mhat = rm;
#pragma unroll
                for (int r = 0; r < 16; ++r) { p0[r] -= rm; p1[r] -= rm; negm[r] = -mhat; }
            } else if (__any(rm > THR)) { const float dl = fmaxf(rm, 0.f); mhat += dl;
#pragma unroll
                for (int r = 0; r < 16; ++r) { p0[r] -= dl; p1[r] -= dl; negm[r] = -mhat; }
                const float f = __builtin_amdgcn_exp2f(-dl); l_reg *= f; if (hi == 0) wsf[r32] = f; resc = true; }
            float sacc = 0.f;
#pragma unroll
            for (int r = 0; r < 16; ++r) { p0[r] = __builtin_amdgcn_exp2f(p0[r]); p1[r] = __builtin_amdgcn_exp2f(p1[r]); sacc += p0[r] + p1[r]; }
            l_reg += sacc;
            u32x4 pw0, pw1, pw2, pw3;
            pw0 = (u32x4){cvtpk(p0[0], p0[1]), cvtpk(p0[2], p0[3]), cvtpk(p0[4], p0[5]), cvtpk(p0[6], p0[7])};
            pw1 = (u32x4){cvtpk(p0[8], p0[9]), cvtpk(p0[10], p0[11]), cvtpk(p0[12], p0[13]), cvtpk(p0[14], p0[15])};
            pw2 = (u32x4){cvtpk(p1[0], p1[1]), cvtpk(p1[2], p1[3]), cvtpk(p1[4], p1[5]), cvtpk(p1[6], p1[7])};
            pw3 = (u32x4){cvtpk(p1[8], p1[9]), cvtpk(p1[10], p1[11]), cvtpk(p1[12], p1[13]), cvtpk(p1[14], p1[15])};
            if (resc) { asm volatile("s_waitcnt lgkmcnt(0)" ::: "memory");
#pragma unroll
                for (int r = 0; r < 16; ++r) { const float f = wsf[crow(r, hi)]; o[0][r] *= f; o[1][r] *= f; } }
            __builtin_amdgcn_sched_barrier(0);
            pv(o, vb0 + slot, __builtin_bit_cast(bf16x8, pw0), __builtin_bit_cast(bf16x8, pw1), __builtin_bit_cast(bf16x8, pw2), __builtin_bit_cast(bf16x8, pw3));
        }
        slot = slot == 2 * SLOTB ? 0 : slot + SLOTB;
    }
    { auto rr = __builtin_amdgcn_permlane32_swap(__float_as_uint(l_reg), __float_as_uint(l_reg), false, false); l_reg = __uint_as_float(rr[0]) + __uint_as_float(rr[1]); }
    if (hi == 0) wsf[32 + r32] = l_reg;
    asm volatile("s_waitcnt lgkmcnt(0)" ::: "memory");
    float rli[16];
#pragma unroll
    for (int r = 0; r < 16; ++r) rli[r] = __builtin_amdgcn_rcpf(wsf[32 + crow(r, hi)]);
    bf16_t* Ow = D.O + (size_t)(wid * 32) * 768;
    { LAS bf16_t* stg = (LAS bf16_t*)(shm + LDS_OST) + wid * 2048;
#pragma unroll
      for (int r = 0; r < 16; ++r) { const int orow = crow(r, hi);
#pragma unroll
          for (int d0 = 0; d0 < 2; ++d0) stg[orow * 64 + d0 * 32 + r32] = f2bf(o[d0][r] * rli[r]); }
      asm volatile("s_waitcnt lgkmcnt(0)" ::: "memory");
#pragma unroll
      for (int i = 0; i < 4; ++i) { const int row = i * 8 + (lane >> 3), ch = lane & 7; const u32x4 v = *(const LAS u32x4*)(stg + row * 64 + ch * 8); *(u32x4*)(Ow + (size_t)row * 768 + ch * 8) = v; } }
    asm volatile("s_waitcnt vmcnt(0) lgkmcnt(0)\n\ts_barrier" ::: "memory");
#undef ATT_TROW
#undef ATT_DMA
}

typedef const LAS char* lds_cptr;
typedef short v4i16_t __attribute__((ext_vector_type(4)));
__device__ __forceinline__ void kload2(bf16x8* kf, lds_cptr kp, int d0) { kf[2 * d0] = *(const LAS bf16x8*)(kp + d0 * 2048); kf[2 * d0 + 1] = *(const LAS bf16x8*)(kp + d0 * 2048 + 512); }
__device__ __forceinline__ s16x4 vtr(lds_cptr p) { return __builtin_bit_cast(s16x4, __builtin_amdgcn_ds_read_tr16_b64_v4i16((LAS v4i16_t*)p)); }
#define SBAR() __builtin_amdgcn_sched_barrier(0)
#define PIN(x) asm volatile("" : "+v"(x))
#define MFMA(a, b, c) __builtin_amdgcn_mfma_f32_32x32x16_bf16(a, b, c, 0, 0, 0)
__device__ __forceinline__ void attn_unit_pipe(const Desc& D, LAS unsigned char* shm) {
    const int tid = ltid(), lane = tid & 63, r32 = lane & 31, hi = lane >> 5; const int wid = __builtin_amdgcn_readfirstlane(tid >> 6);
    const unsigned lds0 = (unsigned)(uintptr_t)shm;
    LAS float* wsf = (LAS float*)(shm + LDS_WS) + wid * 64;
    const bf16_t* Qw = D.Q + (size_t)(wid * 32) * PC;
    const int NT = D.NT;
    const bf16_t* ksrc = D.KV + D.kcol + wid * 8 + (size_t)lane * PC;
    const bf16_t* vsrc = D.KV + D.vcol + (wid >> 2) * 32 + (lane & 3) * 8 + (size_t)(16 * (wid & 3) + (lane >> 2)) * PC;
    const unsigned kdst = lds0 + LDS_K + wid * 1024, vdst = lds0 + LDS_V + wid * 1024;
#define TROW(t) ((t) < 4 ? D.ctx_row0 + 64 * (t) : D.lat_row0 + 64 * ((t) - 4))
#define DMA_K(t, slot) glds16(ksrc + (size_t)TROW(t) * PC, (unsigned)__builtin_amdgcn_readfirstlane(kdst + (slot)))
#define DMA_V(t, slot) glds16(vsrc + (size_t)TROW(t) * PC, (unsigned)__builtin_amdgcn_readfirstlane(vdst + (slot)))
    const lds_cptr vp0 = (lds_cptr)shm + LDS_V + ((lane >> 4) & 1) * 32 + (lane & 3) * 8 + (4 * hi + ((lane & 15) >> 2)) * 64;
    const lds_cptr kp0 = (lds_cptr)shm + LDS_K + hi * 1024 + r32 * 16;
    DMA_K(0, 0); DMA_V(0, 0); DMA_K(1, SLOTB);
    bf16x8 qr[4];
#pragma unroll
    for (int d0 = 0; d0 < 4; ++d0) qr[d0] = *(const bf16x8*)(Qw + (size_t)r32 * PC + d0 * 16 + hi * 8);
    float mhat = 0.f, l_reg = 0.f; f32x16 o[2]; o[0] = f32x16{}; o[1] = f32x16{};
    f32x16 negm = f32x16{}; PIN(negm);
    bool resc = false;
    f32x16 pA0, pA1, pB0, pB1; bf16x8 kf[8]; s16x4 vlo[8], vhi[8]; u32x4 pw0, pw1, pw2, pw3;
    int sl_prev = 0, sl_cur = 0, sl_next = SLOTB;
#define ROT() do { sl_prev = sl_cur; sl_cur = sl_next; sl_next = (sl_next == 2 * SLOTB) ? 0 : sl_next + SLOTB; } while (0)
#define EX(v) __builtin_amdgcn_exp2f(v)
#define RESC() do { if (resc) { _Pragma("unroll") for (int d_ = 0; d_ < 2; ++d_) _Pragma("unroll") for (int r = 0; r < 16; ++r) o[d_][r] *= wsf[crow(r, hi)]; } } while (0)
    DMA_K(2, 2 * SLOTB);
    ATT_WAIT_BAR(3);
    _Pragma("unroll") for (int d0 = 0; d0 < 4; ++d0) kload2(kf, kp0, d0);
    pA0 = MFMA(kf[0], qr[0], negm); pA1 = MFMA(kf[1], qr[0], negm); pA0 = MFMA(kf[2], qr[1], pA0); pA1 = MFMA(kf[3], qr[1], pA1);
    pA0 = MFMA(kf[4], qr[2], pA0); pA1 = MFMA(kf[5], qr[2], pA1); pA0 = MFMA(kf[6], qr[3], pA0); pA1 = MFMA(kf[7], qr[3], pA1);
    { const float rm = rowmax(pA0, pA1); mhat = rm;
#pragma unroll
      for (int r = 0; r < 16; ++r) { pA0[r] = EX(pA0[r] - rm); pA1[r] = EX(pA1[r] - rm); negm[r] = -mhat; } }
    ATT_WAIT_BAR(0);
    DMA_K(3, 0); DMA_V(1, SLOTB); ROT();
    _Pragma("unroll") for (int d0 = 0; d0 < 4; ++d0) kload2(kf, kp0 + sl_cur, d0);
    ATT_WAIT_BAR(2);
#define PKW(P, i) cvtpk(P[i], P[i + 1])
#define PAF(k) __builtin_bit_cast(bf16x8, pw##k)
#define VFR(i) (bf16x8){vlo[i][0], vlo[i][1], vlo[i][2], vlo[i][3], vhi[i][0], vhi[i][1], vhi[i][2], vhi[i][3]}
#define VRD(i) do { vlo[i] = vtr(vp_ + (((i) >> 2) * 4096 + ((i) & 3) * 1024)); vhi[i] = vtr(vp_ + (((i) >> 2) * 4096 + ((i) & 3) * 1024 + 512)); } while (0)
#define KRD(G, d0) do { if (G) { kload2(kf, kp0 + sl_next, d0); SBAR(); } } while (0)
#define GAPA(MF, a0, a1, a2, a3, W0, W1, PW) do { MF; sacc += a0; sacc += a1; sacc += a2; sacc += a3; W0; W1; PIN(PW); PIN(sacc); SBAR(); } while (0)
#define GAPB(MF, X, i) do { MF; X[i] = EX(X[i]); X[i + 1] = EX(X[i + 1]); X[i + 2] = EX(X[i + 2]); X[i + 3] = EX(X[i + 3]); PIN(X); SBAR(); } while (0)
#define STEP(C0, C1, P0, P1, t, GK, GV, GL) do { SBAR(); \
    const lds_cptr vp_ = vp0 + sl_prev; \
    VRD(0); SBAR(); float sacc = P0[0] + P0[1]; \
                    GAPA(C0 = MFMA(kf[0], qr[0], negm), P0[2], P0[3], P0[4], P0[5],     pw0[0] = PKW(P0, 0),  pw0[1] = PKW(P0, 2),  pw0); \
    VRD(4); SBAR(); GAPA(C1 = MFMA(kf[1], qr[0], negm), P0[6], P0[7], P0[8], P0[9],     pw0[2] = PKW(P0, 4),  pw0[3] = PKW(P0, 6),  pw0); \
    VRD(1); SBAR(); GAPA(C0 = MFMA(kf[2], qr[1], C0),    P0[10], P0[11], P0[12], P0[13], pw1[0] = PKW(P0, 8),  pw1[1] = PKW(P0, 10), pw1); \
    VRD(5); SBAR(); GAPA(C1 = MFMA(kf[3], qr[1], C1),    P0[14], P0[15], P1[0], P1[1],   pw1[2] = PKW(P0, 12), pw1[3] = PKW(P0, 14), pw1); \
    VRD(2); SBAR(); GAPA(C0 = MFMA(kf[4], qr[2], C0),    P1[2], P1[3], P1[4], P1[5],     pw2[0] = PKW(P1, 0),  pw2[1] = PKW(P1, 2),  pw2); \
    VRD(6); SBAR(); GAPA(C1 = MFMA(kf[5], qr[2], C1),    P1[6], P1[7], P1[8], P1[9],     pw2[2] = PKW(P1, 4),  pw2[3] = PKW(P1, 6),  pw2); \
    VRD(3); SBAR(); GAPA(C0 = MFMA(kf[6], qr[3], C0),    P1[10], P1[11], P1[12], P1[13], pw3[0] = PKW(P1, 8),  pw3[1] = PKW(P1, 10), pw3); \
    VRD(7); SBAR(); GAPA(C1 = MFMA(kf[7], qr[3], C1),    P1[14], P1[15], 0.f, 0.f,       pw3[2] = PKW(P1, 12), pw3[3] = PKW(P1, 14), pw3); \
    l_reg += sacc; \
    if (GK) DMA_K((t) + 3, sl_cur); if (GV) DMA_V((t) + 1, sl_next); \
    { const float rm = rowmax(C0, C1); resc = false;                        \
      if (__builtin_expect(__any(rm > THR), 0)) { const float dl = fmaxf(rm, 0.f); mhat += dl; \
          _Pragma("unroll") for (int r = 0; r < 16; ++r) { C0[r] -= dl; C1[r] -= dl; negm[r] = -mhat; } \
          const float f = __builtin_amdgcn_exp2f(-dl); l_reg *= f; if (hi == 0) wsf[r32] = f; resc = true; } } \
    SBAR(); \
    GAPB(o[0] = MFMA(PAF(0), VFR(0), o[0]), C0, 0);              GAPB(o[1] = MFMA(PAF(0), VFR(4), o[1]), C0, 4); \
    KRD(GL, 0); GAPB(o[0] = MFMA(PAF(1), VFR(1), o[0]), C0, 8);  KRD(GL, 1); GAPB(o[1] = MFMA(PAF(1), VFR(5), o[1]), C0, 12); \
    KRD(GL, 2); GAPB(o[0] = MFMA(PAF(2), VFR(2), o[0]), C1, 0);  KRD(GL, 3); GAPB(o[1] = MFMA(PAF(2), VFR(6), o[1]), C1, 4); \
    GAPB(o[0] = MFMA(PAF(3), VFR(3), o[0]), C1, 8);              GAPB(o[1] = MFMA(PAF(3), VFR(7), o[1]), C1, 12); \
    } while (0)
    int t = 1;
    for (; t + 5 < NT; t += 2) {
        STEP(pB0, pB1, pA0, pA1, t, true, true, true);     ATT_WAIT_BAR(2); RESC(); ROT();
        STEP(pA0, pA1, pB0, pB1, t + 1, true, true, true); ATT_WAIT_BAR(2); RESC(); ROT();
    }
#define ENDW(tt) do { if ((tt) + 3 < NT) { ATT_WAIT_BAR(2); } else if ((tt) + 2 < NT) { ATT_WAIT_BAR(1); } else { ATT_WAIT_BAR(0); } } while (0)
    for (; t + 1 < NT; t += 2) {
        STEP(pB0, pB1, pA0, pA1, t, (t + 3 < NT), (t + 1 < NT), (t + 1 < NT));         ENDW(t);     RESC(); ROT();
        STEP(pA0, pA1, pB0, pB1, t + 1, (t + 4 < NT), (t + 2 < NT), (t + 2 < NT));     ENDW(t + 1); RESC(); ROT();
    }
    STEP(pB0, pB1, pA0, pA1, NT - 1, false, false, false); RESC();
    { float sacc = pB0[0] + pB0[1];
#pragma unroll
      for (int r = 2; r < 16; ++r) sacc += pB0[r];
#pragma unroll
      for (int r = 0; r < 16; ++r) sacc += pB1[r];
      l_reg += sacc;
      pw0 = (u32x4){PKW(pB0, 0), PKW(pB0, 2), PKW(pB0, 4), PKW(pB0, 6)}; pw1 = (u32x4){PKW(pB0, 8), PKW(pB0, 10), PKW(pB0, 12), PKW(pB0, 14)};
      pw2 = (u32x4){PKW(pB1, 0), PKW(pB1, 2), PKW(pB1, 4), PKW(pB1, 6)}; pw3 = (u32x4){PKW(pB1, 8), PKW(pB1, 10), PKW(pB1, 12), PKW(pB1, 14)};
      const lds_cptr vp_ = vp0 + sl_cur; _Pragma("unroll") for (int i = 0; i < 8; ++i) VRD(i);
      o[0] = MFMA(PAF(0), VFR(0), o[0]); o[1] = MFMA(PAF(0), VFR(4), o[1]); o[0] = MFMA(PAF(1), VFR(1), o[0]); o[1] = MFMA(PAF(1), VFR(5), o[1]);
      o[0] = MFMA(PAF(2), VFR(2), o[0]); o[1] = MFMA(PAF(2), VFR(6), o[1]); o[0] = MFMA(PAF(3), VFR(3), o[0]); o[1] = MFMA(PAF(3), VFR(7), o[1]); }
    { auto rr = __builtin_amdgcn_permlane32_swap(__float_as_uint(l_reg), __float_as_uint(l_reg), false, false); l_reg = __uint_as_float(rr[0]) + __uint_as_float(rr[1]); }
    if (hi == 0) wsf[32 + r32] = l_reg;
    asm volatile("s_waitcnt lgkmcnt(0)" ::: "memory");
    float rli[16];
#pragma unroll
    for (int r = 0; r < 16; ++r) rli[r] = __builtin_amdgcn_rcpf(wsf[32 + crow(r, hi)]);
    bf16_t* Ow = D.O + (size_t)(wid * 32) * 768;
    { LAS bf16_t* stg = (LAS bf16_t*)(shm + LDS_OST) + wid * 2048;
#pragma unroll
      for (int r = 0; r < 16; ++r) { const int orow = crow(r, hi);
#pragma unroll
          for (int d0 = 0; d0 < 2; ++d0) stg[orow * 64 + d0 * 32 + r32] = f2bf(o[d0][r] * rli[r]); }
      asm volatile("s_waitcnt lgkmcnt(0)" ::: "memory");
#pragma unroll
      for (int i = 0; i < 4; ++i) { const int row = i * 8 + (lane >> 3), ch = lane & 7; const u32x4 v = *(const LAS u32x4*)(stg + row * 64 + ch * 8); *(u32x4*)(Ow + (size_t)row * 768 + ch * 8) = v; } }
    asm volatile("s_waitcnt vmcnt(0) lgkmcnt(0)\n\ts_barrier" ::: "memory");
#undef TROW
#undef DMA_K
#undef DMA_V
#undef ROT
#undef EX
#undef RESC
#undef PKW
#undef PAF
#undef VFR
#undef VRD
#undef KRD
#undef ENDW
#undef GAPA
#undef GAPB
#undef STEP
}
#undef SBAR
#undef PIN
#undef MFMA
}
__device__ __forceinline__ void attn_one(KP p, int l, int u, bool na, LAS unsigned char* shm);
__device__ __forceinline__ void st_attn(KP p, int l, bool with_ctx, bool na, LAS unsigned char* shm) {
    const int tid = ltid();
    if (na) {
        asm volatile("s_waitcnt lgkmcnt(0)\n\ts_barrier" ::: "memory");
        LAS float* bt = (LAS float*)(shm + att::LDS_BIAS);
        (void)bt;
    }
    const int nlat = NB * 4 * 16, nun = nlat + (with_ctx ? NB * 4 : 0);
    for (int u = lbid(); u < nun; u += lgrid()) attn_one(p, l, u, na, shm);
}
__device__ __forceinline__ void attn_one(KP p, int l, int u, bool na, LAS unsigned char* shm) {
    const int tid = ltid(); const int nlat = NB * 4 * 16;
    {
        att::Desc D;
        const bool isc = u >= nlat; const int uu = isc ? u - nlat : u;
        const int b = isc ? uu >> 2 : uu >> 6, h = isc ? uu & 3 : (uu >> 4) & 3, qb = isc ? 0 : uu & 15;
        const int qrow0 = isc ? NLAT + b * SC : b * TL + qb * 256;
        D.ctx_row0 = NLAT + b * SC; D.NT = 4; D.lat_row0 = b * TL; D.rlo = 0; D.qrow = qb * 4;
        if (na) {
            D.Q = p->P + (size_t)qrow0 * PC + C_QA + h * 64; D.KV = p->P; D.kcol = C_KA + h * 64; D.vcol = C_VA + h * 64; D.O = p->YCAT + (size_t)qrow0 * 768 + h * 64;
            if (!isc) { const int rlo = min(max(qb * 4 - 4, 0), 56), rhi = min(max(qb * 4 - 1, 0), 56) + 7; D.rlo = rlo; D.lat_row0 = b * TL + rlo * 64; D.NT = 4 + (rhi - rlo + 1);
                LAS float* bt = (LAS float*)(shm + att::LDS_BIAS); const float* rpb = p->in[I_RPB] + ((size_t)l * 4 + h) * 15 * 31;
                if (tid < 15 * 32) { const int dr = tid >> 5, dc = tid & 31; bt[tid] = dc < 31 ? rpb[dr * 31 + dc] * att::LOG2E : 0.f; }
                asm volatile("s_waitcnt lgkmcnt(0)\n\ts_barrier" ::: "memory");
                att::attn_unit<1>(D, shm);
            } else att::attn_unit<0>(D, shm);
        } else {
            const int kvh = h >> 1;
            D.Q = p->P + (size_t)qrow0 * PC + C_QC + h * 64; D.KV = p->P; D.kcol = C_KC + kvh * 64; D.vcol = C_VC + kvh * 64; D.O = p->YCAT + (size_t)qrow0 * 768 + 512 + h * 64;
            if (!isc) { D.NT = 68; att::attn_unit_pipe(D, shm); }
            else att::attn_unit<0>(D, shm);
        }
    }
}

__device__ __forceinline__ int gla_row(int b, int c, int j) { return c < 4 ? NLAT + b * SC + c * 64 + j : b * TL + (c - 4) * 64 + j; }
namespace gla {
constexpr int G_OFF = 0, KT_OFF = 65536, VTS_OFF = 65536 + 36864, QD_OFF = 65536, KI_OFF = 65536 + 40960, VTO_OFF = 0, X_OFF = 65536, LDS_TOTAL = 65536 + 81920;
typedef short s16x4 __attribute__((ext_vector_type(4)));
__device__ __forceinline__ f32x4 mfma16(bf16x8 a, bf16x8 b, f32x4 c) { return __builtin_amdgcn_mfma_f32_16x16x32_bf16(a, b, c, 0, 0, 0); }
__device__ __forceinline__ void gates_cumsum(KP p, int l, int b, int c, LAS unsigned char* shm, int tid) {
    LAS float* Gs = (LAS float*)(shm + G_OFF);
    { const int j = tid >> 3, part = tid & 7; const bf16_t* src = p->P + (size_t)gla_row(b, c, j) * PC + C_G + part * 32;
      const float* bias = (part < 4 ? p->in[I_BGF] + l * 128 + part * 32 : p->in[I_BGB] + l * 128 + (part - 4) * 32);
#pragma unroll
      for (int q = 0; q < 4; ++q) { const u32x4 w = *(const u32x4*)(src + q * 8); const f32x4 b0 = *(const f32x4*)(bias + q * 8), b1 = *(const f32x4*)(bias + q * 8 + 4);
          LAS float* d = Gs + j * 256 + part * 32 + q * 8;
          *(LAS f32x4*)d = (f32x4){logsig16(bflo(w.x) + b0[0]), logsig16(bfhi(w.x) + b0[1]), logsig16(bflo(w.y) + b0[2]), logsig16(bfhi(w.y) + b0[3])};
          *(LAS f32x4*)(d + 4) = (f32x4){logsig16(bflo(w.z) + b1[0]), logsig16(bfhi(w.z) + b1[1]), logsig16(bflo(w.w) + b1[2]), logsig16(bfhi(w.w) + b1[3])}; } }
    __syncthreads();
    if (tid < 256) {
        float v[64];
#pragma unroll
        for (int j = 0; j < 64; ++j) v[j] = Gs[j * 256 + tid];
        if (tid < 128) {
#pragma unroll
            for (int j = 1; j < 64; ++j) v[j] += v[j - 1];
        } else {
#pragma unroll
            for (int j = 62; j >= 0; --j) v[j] += v[j + 1];
        }
#pragma unroll
        for (int j = 0; j < 64; ++j) Gs[j * 256 + tid] = v[j];
    }
    __syncthreads();
}
__device__ __forceinline__ void build_vt(KP p, int b, int c, LAS unsigned char* vt, int tid) {
    const int j = tid & 63, w = tid >> 6; const bf16_t* src = p->P + (size_t)gla_row(b, c, j) * PC + C_VB + w * 32;
    LAS bf16_t* dst = (LAS bf16_t*)(vt + (w >> 1) * 9216 + ((w & 1) * 32) * 144) + j;
#pragma unroll
    for (int q = 0; q < 4; ++q) { const u32x4 x = *(const u32x4*)(src + q * 8);
        dst[(q * 8 + 0) * 72] = (bf16_t)(x.x & 0xFFFF); dst[(q * 8 + 1) * 72] = (bf16_t)(x.x >> 16); dst[(q * 8 + 2) * 72] = (bf16_t)(x.y & 0xFFFF); dst[(q * 8 + 3) * 72] = (bf16_t)(x.y >> 16);
        dst[(q * 8 + 4) * 72] = (bf16_t)(x.z & 0xFFFF); dst[(q * 8 + 5) * 72] = (bf16_t)(x.z >> 16); dst[(q * 8 + 6) * 72] = (bf16_t)(x.w & 0xFFFF); dst[(q * 8 + 7) * 72] = (bf16_t)(x.w >> 16); }
}
}
__device__ __forceinline__ void gla_states_one(KP p, int l, int u, LAS unsigned char* shm);
__device__ __forceinline__ void st_gla_states2(KP p, int l, LAS unsigned char* shm) {
    const int tid = ltid(), lane = tid & 63, l15 = lane & 15, kg = lane >> 4; const int w = __builtin_amdgcn_readfirstlane(tid >> 6);
    LAS float* Gs = (LAS float*)(shm + gla::G_OFF);
    for (int u = lbid(); u < NB * NCH; u += lgrid()) gla_states_one(p, l, u, shm);
    __syncthreads();
}
__device__ __forceinline__ void gla_states_one(KP p, int l, int u, LAS unsigned char* shm) {
    const int tid = ltid(), lane = tid & 63, l15 = lane & 15, kg = lane >> 4; const int w = __builtin_amdgcn_readfirstlane(tid >> 6);
    LAS float* Gs = (LAS float*)(shm + gla::G_OFF);
    {
        const int b = u / NCH, c = u % NCH;
        __syncthreads();
        gla::gates_cumsum(p, l, b, c, shm, tid);
        {
          const int dir = w >> 2, h = w & 3, j = lane; const bf16_t* src = p->P + (size_t)gla_row(b, c, j) * PC + C_KB + h * 32;
          LAS bf16_t* dst = (LAS bf16_t*)(shm + gla::KT_OFF + w * 4608) + j;
          const LAS float* gb = Gs + j * 256 + dir * 128 + h * 32; const LAS float* gl = Gs + (dir ? 0 : 63) * 256 + dir * 128 + h * 32;
#pragma unroll
          for (int q = 0; q < 4; ++q) { const u32x4 x = *(const u32x4*)(src + q * 8); const unsigned xs[4] = {x.x, x.y, x.z, x.w};
#pragma unroll
              for (int e = 0; e < 8; ++e) { const int kk = q * 8 + e; const float kv = (e & 1) ? bfhi(xs[e >> 1]) : bflo(xs[e >> 1]);
                  dst[kk * 72] = f2bf(kv * __expf(gl[kk] - gb[kk])); } } }
        gla::build_vt(p, b, c, shm + gla::VTS_OFF, tid);
        if (tid < 256) { const int dir = tid >> 7, h = (tid >> 5) & 3, kk = tid & 31; p->DEC[((((size_t)b * 2 + dir) * NCH + c) * 4 + h) * 32 + kk] = __expf(Gs[(dir ? 0 : 63) * 256 + tid]); }
        __syncthreads();
        { const int dir = w >> 2, h = w & 3;
          const LAS unsigned char* vt = shm + gla::VTS_OFF + h * 9216; const LAS unsigned char* kt = shm + gla::KT_OFF + w * 4608;
          float* dst = p->DST + ((((size_t)b * 2 + dir) * NCH + c) * 4 + h) * 2048;
#pragma unroll
          for (int ki = 0; ki < 2; ++ki) { const bf16x8 kb0 = *(const LAS bf16x8*)(kt + (ki * 16 + l15) * 144 + kg * 16), kb1 = *(const LAS bf16x8*)(kt + (ki * 16 + l15) * 144 + 64 + kg * 16);
#pragma unroll
              for (int vi = 0; vi < 4; ++vi) { const bf16x8 va0 = *(const LAS bf16x8*)(vt + (vi * 16 + l15) * 144 + kg * 16), va1 = *(const LAS bf16x8*)(vt + (vi * 16 + l15) * 144 + 64 + kg * 16);
                  f32x4 acc = (f32x4){0.f, 0.f, 0.f, 0.f}; acc = gla::mfma16(va0, kb0, acc); acc = gla::mfma16(va1, kb1, acc);
                  *(f32x4*)(dst + (ki * 16 + l15) * 64 + vi * 16 + 4 * kg) = acc; } } }
    }
    __syncthreads();
}
__device__ __forceinline__ void st_gla_scan2(KP p) {
    for (int i = lbid() * NTHREADS + ltid(); i < NB * 2 * 4 * 2048; i += lgrid() * NTHREADS) {
        const int e = i & 2047, h = (i >> 11) & 3, dir = (i >> 13) & 1, b = i >> 14, kk = e >> 6;
        float s = 0.f;
#pragma unroll 1
        for (int n0 = 0; n0 < NCH; n0 += 17) {
            float d[17], dc[17]; size_t base[17];
#pragma unroll
            for (int q = 0; q < 17; ++q) { const int n = n0 + q; const int c = dir == 0 ? n : (n < 4 ? 3 - n : 71 - n);
                base[q] = (((size_t)b * 2 + dir) * NCH + c) * 4 + h; d[q] = p->DST[base[q] * 2048 + e]; dc[q] = p->DEC[base[q] * 32 + kk]; }
#pragma unroll
            for (int q = 0; q < 17; ++q) { p->ST[base[q] * 2048 + e] = f2bf(s); s = dc[q] * s + d[q]; }
        }
    }
}
__device__ __forceinline__ void st_gla_out2(KP p, int l, bool with_ctx, LAS unsigned char* shm) {
    const int tid = ltid(), lane = tid & 63, l15 = lane & 15, kg = lane >> 4; const int w = __builtin_amdgcn_readfirstlane(tid >> 6);
    LAS float* Gs = (LAS float*)(shm + gla::G_OFF);
    const float qs = 0.17677669529663687f;
    for (int u = lbid(); u < NB * NCH; u += lgrid()) {
        const int b = u / NCH, c = u % NCH;
        if (!with_ctx && c < 4) continue;
        __syncthreads();
        gla::gates_cumsum(p, l, b, c, shm, tid);
        {
          const int j = tid >> 3, part = tid & 7, h = part >> 1, kk0 = (part & 1) * 16; const size_t ro = (size_t)gla_row(b, c, j) * PC;
          const u32x4 q0 = *(const u32x4*)(p->P + ro + C_QB + part * 16), q1 = *(const u32x4*)(p->P + ro + C_QB + part * 16 + 8);
          const u32x4 k0 = *(const u32x4*)(p->P + ro + C_KB + part * 16), k1 = *(const u32x4*)(p->P + ro + C_KB + part * 16 + 8);
          const unsigned qx[8] = {q0.x, q0.y, q0.z, q0.w, q1.x, q1.y, q1.z, q1.w}, kx[8] = {k0.x, k0.y, k0.z, k0.w, k1.x, k1.y, k1.z, k1.w};
#pragma unroll
          for (int dir = 0; dir < 2; ++dir) { const LAS float* gb = Gs + j * 256 + dir * 128 + part * 16; unsigned qo[8], ko[8];
#pragma unroll
              for (int e = 0; e < 8; ++e) { const float g0 = gb[2 * e], g1 = gb[2 * e + 1];
                  qo[e] = pack2(bflo(qx[e]) * qs * __expf(g0), bfhi(qx[e]) * qs * __expf(g1)); ko[e] = pack2(bflo(kx[e]) * __expf(-g0), bfhi(kx[e]) * __expf(-g1)); }
              LAS unsigned char* qd = shm + gla::QD_OFF + (dir * 4 + h) * 5120 + j * 80 + kk0 * 2; LAS unsigned char* ki = shm + gla::KI_OFF + (dir * 4 + h) * 5120 + j * 80 + kk0 * 2;
              *(LAS u32x4*)qd = (u32x4){qo[0], qo[1], qo[2], qo[3]}; *(LAS u32x4*)(qd + 16) = (u32x4){qo[4], qo[5], qo[6], qo[7]};
              *(LAS u32x4*)ki = (u32x4){ko[0], ko[1], ko[2], ko[3]}; *(LAS u32x4*)(ki + 16) = (u32x4){ko[4], ko[5], ko[6], ko[7]}; } }
        __syncthreads();
        gla::build_vt(p, b, c, shm + gla::VTO_OFF, tid);
        __syncthreads();
        const int dir = w >> 2, h = w & 3;
        f32x4 acc[4][4];
#pragma unroll
        for (int ti = 0; ti < 4; ++ti)
#pragma unroll
            for (int vi = 0; vi < 4; ++vi) acc[ti][vi] = (f32x4){0.f, 0.f, 0.f, 0.f};
        { const LAS unsigned char* qd = shm + gla::QD_OFF + w * 5120; const LAS unsigned char* ki = shm + gla::KI_OFF + w * 5120; const LAS unsigned char* vt = shm + gla::VTO_OFF + h * 9216;
          const bf16_t* st = p->ST + ((((size_t)b * 2 + dir) * NCH + c) * 4 + h) * 2048;
          bf16x8 sfr[4];
#pragma unroll
          for (int vi = 0; vi < 4; ++vi) {
#pragma unroll
              for (int j = 0; j < 8; ++j) sfr[vi][j] = (short)st[(kg * 8 + j) * 64 + vi * 16 + l15]; }
#pragma unroll
          for (int ti = 0; ti < 4; ++ti) {
              const bf16x8 qf = *(const LAS bf16x8*)(qd + (ti * 16 + l15) * 80 + kg * 16);
              const int ig = ti * 16 + l15;
              unsigned pk[4][2];
#pragma unroll
              for (int tj = 0; tj < 4; ++tj) {
                  const bf16x8 kf = *(const LAS bf16x8*)(ki + (tj * 16 + l15) * 80 + kg * 16);
                  f32x4 a2 = gla::mfma16(kf, qf, (f32x4){0.f, 0.f, 0.f, 0.f});
#pragma unroll
                  for (int jj = 0; jj < 4; ++jj) { const int jg = tj * 16 + 4 * kg + jj; const bool ok = dir == 0 ? (jg <= ig) : (jg >= ig); a2[jj] = ok ? a2[jj] : 0.f; }
                  pk[tj][0] = pack2(a2[0], a2[1]); pk[tj][1] = pack2(a2[2], a2[3]);
              }
#pragma unroll
              for (int s2 = 0; s2 < 2; ++s2) {
                  const u32x4 bw = (u32x4){pk[2 * s2][0], pk[2 * s2][1], pk[2 * s2 + 1][0], pk[2 * s2 + 1][1]}; const bf16x8 bfr = __builtin_bit_cast(bf16x8, bw);
#pragma unroll
                  for (int vi = 0; vi < 4; ++vi) {
                      const LAS unsigned char* vr = vt + (vi * 16 + l15) * 144 + kg * 8;
                      const u32x2 lo = *(const LAS u32x2*)(vr + (2 * s2) * 32), hi2 = *(const LAS u32x2*)(vr + (2 * s2 + 1) * 32);
                      const u32x4 aw = (u32x4){lo.x, lo.y, hi2.x, hi2.y};
                      acc[ti][vi] = gla::mfma16(__builtin_bit_cast(bf16x8, aw), bfr, acc[ti][vi]);
                  }
              }
#pragma unroll
              for (int vi = 0; vi < 4; ++vi) acc[ti][vi] = gla::mfma16(sfr[vi], qf, acc[ti][vi]);
          } }
        __syncthreads();
        { LAS f32x4* xo = (LAS f32x4*)(shm + gla::X_OFF + w * 8192);
#pragma unroll
          for (int t2 = 0; t2 < 2; ++t2)
#pragma unroll
              for (int vi = 0; vi < 4; ++vi) xo[(t2 * 4 + vi) * 64 + lane] = dir == 0 ? acc[2 + t2][vi] : acc[t2][vi]; }
        __syncthreads();
        { const LAS f32x4* xi = (const LAS f32x4*)(shm + gla::X_OFF + (w ^ 4) * 8192);
          const float* gg = p->in[I_GLAG] + l * 64;
#pragma unroll
          for (int t2 = 0; t2 < 2; ++t2) {
              f32x4 o[4]; float ss = 0.f;
#pragma unroll
              for (int vi = 0; vi < 4; ++vi) { o[vi] = (dir == 0 ? acc[t2][vi] : acc[2 + t2][vi]) + xi[(t2 * 4 + vi) * 64 + lane]; ss += o[vi][0] * o[vi][0] + o[vi][1] * o[vi][1] + o[vi][2] * o[vi][2] + o[vi][3] * o[vi][3]; }
              ss += __shfl_xor(ss, 16); ss += __shfl_xor(ss, 32);
              const float rs = rsqrtf(ss * (1.f / 64.f) + EPS);
              const int R = gla_row(b, c, (dir * 2 + t2) * 16 + l15);
#pragma unroll
              for (int vi = 0; vi < 4; ++vi) { const int col = h * 64 + vi * 16 + 4 * kg; const u32x2 rw = *(const u32x2*)(p->P + (size_t)R * PC + C_RB + col); const f32x4 gv = *(const f32x4*)(gg + vi * 16 + 4 * kg);
                  u32x2 yw; yw.x = pack2(o[vi][0] * rs * gv[0] * siluf(bflo(rw.x)), o[vi][1] * rs * gv[1] * siluf(bfhi(rw.x))); yw.y = pack2(o[vi][2] * rs * gv[2] * siluf(bflo(rw.y)), o[vi][3] * rs * gv[3] * siluf(bfhi(rw.y)));
                  *(u32x2*)(p->YCAT + (size_t)R * 768 + 256 + col) = yw; }
          } }
    }
    __syncthreads();
}

__device__ __forceinline__ void st_norm2_router(KP p, int l, bool with_ctx, unsigned char* lds) {
    float* W2 = (float*)lds;
    const int tid = ltid(), wid = tid >> 6, lane = tid & 63;
    __syncthreads();
    for (int i_ = tid; i_ < DM * NE; i_ += NTHREADS) { const int col = i_ >> 4, e = i_ & 15, ln = (col & 255) >> 2, q = col & 3, i = col >> 8;
        W2[(((i * 4 + q) * 64) + ln) * 20 + e] = p->in[I_WR][(size_t)l * DM * NE + i_]; }
    __syncthreads();
    const float* mod = p->MOD + (size_t)l * 9 * 6144; const float* g = p->in[I_N2G] + l * DM;
    const int nrows = with_ctx ? MT : NLAT, stride = lgrid() * 8;
    const bool b5 = lane & 32, b4 = lane & 16, b3 = lane & 8, b2 = lane & 4;
    const int my_e = (b5 ? 8 : 0) + (b4 ? 4 : 0) + (b3 ? 2 : 0) + (b2 ? 1 : 0);
    for (int R0 = lbid() * 8 + wid; R0 < nrows; R0 += 2 * stride) {
        const int R1 = R0 + stride; const bool has1 = R1 < nrows; const int R1c = has1 ? R1 : R0;
        f32x4 x0[4], x1[4];
#pragma unroll
        for (int i = 0; i < 4; ++i) { x0[i] = *(const f32x4*)(p->X + (size_t)R0 * DM + lane * 4 + 256 * i); x1[i] = *(const f32x4*)(p->X + (size_t)R1c * DM + lane * 4 + 256 * i); }
        const float* m0 = mod + mod_row(R0) * 6144; const float* m1 = mod + mod_row(R1c) * 6144;
        float ss0 = 0.f, ss1 = 0.f;
#pragma unroll
        for (int i = 0; i < 4; ++i) { ss0 += x0[i][0] * x0[i][0] + x0[i][1] * x0[i][1] + x0[i][2] * x0[i][2] + x0[i][3] * x0[i][3]; ss1 += x1[i][0] * x1[i][0] + x1[i][1] * x1[i][1] + x1[i][2] * x1[i][2] + x1[i][3] * x1[i][3]; }
#pragma unroll
        for (int o = 32; o > 0; o >>= 1) { ss0 += __shfl_xor(ss0, o); ss1 += __shfl_xor(ss1, o); }
        const float rs0 = rsqrtf(ss0 * (1.f / DM) + EPS), rs1 = rsqrtf(ss1 * (1.f / DM) + EPS);
#pragma unroll
        for (int i = 0; i < 4; ++i) {
            const int c = lane * 4 + 256 * i; const f32x4 gv = *(const f32x4*)(g + c);
            x0[i] = (x0[i] * rs0) * gv * (*(const f32x4*)(m0 + 4096 + c) + 1.f) + *(const f32x4*)(m0 + 3072 + c);
            x1[i] = (x1[i] * rs1) * gv * (*(const f32x4*)(m1 + 4096 + c) + 1.f) + *(const f32x4*)(m1 + 3072 + c);
        }
        store_row_fp8((unsigned char*)p->U + (size_t)R0 * DM, x0, lane, S8_X);
        if (has1) store_row_fp8((unsigned char*)p->U + (size_t)R1 * DM, x1, lane, S8_X);
        f32x4 a0[4], a1[4];
#pragma unroll
        for (int j = 0; j < 4; ++j) { a0[j] = (f32x4){0.f, 0.f, 0.f, 0.f}; a1[j] = (f32x4){0.f, 0.f, 0.f, 0.f}; }
#pragma unroll
        for (int i = 0; i < 4; ++i)
#pragma unroll
            for (int q = 0; q < 4; ++q) { const f32x4* wv = (const f32x4*)(W2 + (((i * 4 + q) * 64) + lane) * 20); const float xa = x0[i][q], xb = x1[i][q];
#pragma unroll
                for (int j = 0; j < 4; ++j) { const f32x4 w4 = wv[j]; a0[j] += w4 * xa; a1[j] += w4 * xb; }
                if (q & 1) __builtin_amdgcn_sched_barrier(0); }
        float l0, l1;
        { float u0[8], u1[8];
#pragma unroll
          for (int k = 0; k < 8; ++k) { const float k0 = a0[k >> 2][k & 3], h0 = a0[2 + (k >> 2)][k & 3], k1 = a1[k >> 2][k & 3], h1 = a1[2 + (k >> 2)][k & 3];
              u0[k] = (b5 ? h0 : k0) + __shfl_xor(b5 ? k0 : h0, 32); u1[k] = (b5 ? h1 : k1) + __shfl_xor(b5 ? k1 : h1, 32); }
          float v0[4], v1[4];
#pragma unroll
          for (int k = 0; k < 4; ++k) { v0[k] = (b4 ? u0[4 + k] : u0[k]) + __shfl_xor(b4 ? u0[k] : u0[4 + k], 16); v1[k] = (b4 ? u1[4 + k] : u1[k]) + __shfl_xor(b4 ? u1[k] : u1[4 + k], 16); }
          float w0[2], w1[2];
#pragma unroll
          for (int k = 0; k < 2; ++k) { w0[k] = (b3 ? v0[2 + k] : v0[k]) + __shfl_xor(b3 ? v0[k] : v0[2 + k], 8); w1[k] = (b3 ? v1[2 + k] : v1[k]) + __shfl_xor(b3 ? v1[k] : v1[2 + k], 8); }
          l0 = (b2 ? w0[1] : w0[0]) + __shfl_xor(b2 ? w0[0] : w0[1], 4); l1 = (b2 ? w1[1] : w1[0]) + __shfl_xor(b2 ? w1[0] : w1[1], 4);
          l0 += __shfl_xor(l0, 2); l1 += __shfl_xor(l1, 2); l0 += __shfl_xor(l0, 1); l1 += __shfl_xor(l1, 1); }
        float mx0 = l0, mx1 = l1;
#pragma unroll
        for (int o = 32; o >= 4; o >>= 1) { mx0 = fmaxf(mx0, __shfl_xor(mx0, o)); mx1 = fmaxf(mx1, __shfl_xor(mx1, o)); }
        const float ex0 = expf(l0 - mx0), ex1 = expf(l1 - mx1); float s0 = ex0, s1 = ex1;
#pragma unroll
        for (int o = 32; o >= 4; o >>= 1) { s0 += __shfl_xor(s0, o); s1 += __shfl_xor(s1, o); }
        if ((lane & 3) == 0) { p->AFF[(size_t)R0 * 16 + my_e] = ex0 / s0; if (has1) p->AFF[(size_t)R1 * 16 + my_e] = ex1 / s1; }
    }
}

__device__ __forceinline__ int block_sum_i(int v, int* red, int tid) {
    const int lane = tid & 63, wid = tid >> 6;
#pragma unroll
    for (int o = 32; o > 0; o >>= 1) v += __shfl_xor(v, o);
    __syncthreads();
    if (lane == 0) red[wid] = v;
    __syncthreads();
    int s = 0;
#pragma unroll
    for (int w = 0; w < 8; ++w) s += red[w];
    return s;
}
__device__ __forceinline__ int block_excl_scan_i(int v, int* red, int tid) {
    const int lane = tid & 63, wid = tid >> 6;
    int inc = v;
#pragma unroll
    for (int o = 1; o < 64; o <<= 1) { const int t = __shfl_up(inc, o); if (lane >= o) inc += t; }
    __syncthreads();
    if (lane == 63) red[wid] = inc;
    __syncthreads();
    int base = 0;
#pragma unroll
    for (int w = 0; w < 8; ++w) base += (w < wid) ? red[w] : 0;
    return base + inc - v;
}
__device__ __forceinline__ void st_topk(KP p, bool with_ctx, unsigned char* lds) {
    int* red = (int*)lds;
    const int tid = ltid();
    const int nun = NB * NE * (with_ctx ? 2 : 1);
    for (int u = lbid(); u < nun; u += lgrid()) {
        const int grp = u / (NB * NE), b = (u / NE) % NB, e = u % NE;
        const int n = grp ? SC : TL, cap = grp ? CAPC : CAPL, per = grp ? 1 : 8;
        const int rowbase = grp ? NLAT + b * SC : b * TL;
        unsigned key[8];
#pragma unroll
        for (int i = 0; i < 8; ++i) { const int t = tid * per + i; key[i] = (i < per && t < n) ? __float_as_uint(p->AFF[(size_t)(rowbase + t) * 16 + e]) : 0u; }
        unsigned prefix = 0u;
        { const int lane_ = tid & 63, wid_ = tid >> 6; int* rq = red + 16;
          __syncthreads();
          for (int step = 0; step < 16; ++step) {
              const int bit = step == 0 ? 30 : 30 - 2 * step;
              const unsigned c1 = prefix | (1u << bit), c2 = step == 0 ? 0xFFFFFFFFu : prefix | (2u << bit), c3 = step == 0 ? 0xFFFFFFFFu : prefix | (3u << bit);
              int a = 0, b3 = 0;
#pragma unroll
              for (int i = 0; i < 8; ++i) { a += (key[i] >= c1 ? 1 : 0) + (key[i] >= c2 ? 65536 : 0); b3 += key[i] >= c3 ? 1 : 0; }
#pragma unroll
              for (int o = 32; o > 0; o >>= 1) { a += __shfl_xor(a, o); b3 += __shfl_xor(b3, o); }
              int* slot = rq + (step & 1) * 16;
              if (lane_ == 0) { slot[wid_ * 2] = a; slot[wid_ * 2 + 1] = b3; }
              __syncthreads();
              int sa = 0, sb = 0;
#pragma unroll
              for (int w8 = 0; w8 < 8; ++w8) { sa += slot[w8 * 2]; sb += slot[w8 * 2 + 1]; }
              const int n1 = sa & 0xFFFF, n2 = sa >> 16, n3 = sb;
              prefix = (n3 >= cap) ? c3 : (n2 >= cap) ? c2 : (n1 >= cap) ? c1 : prefix;
          } }
        int ngt = 0, neq = 0;
#pragma unroll
        for (int i = 0; i < 8; ++i) { ngt += key[i] > prefix ? 1 : 0; neq += (key[i] == prefix && key[i] != 0u) ? 1 : 0; }
        const int need = cap - block_sum_i(ngt, red, tid);
        int eqbase = block_excl_scan_i(neq, red, tid);
        int sel[8]; int nsel = 0;
#pragma unroll
        for (int i = 0; i < 8; ++i) { const bool eq = key[i] == prefix && key[i] != 0u; sel[i] = (key[i] > prefix || (eq && eqbase < need)) ? 1 : 0; eqbase += eq ? 1 : 0; nsel += sel[i]; }
        int slot = block_excl_scan_i(nsel, red, tid);
        const int ebase = e * EROWS + (grp ? NB * CAPL + b * CAPC : b * CAPL);
#pragma unroll
        for (int i = 0; i < 8; ++i) { const int t = tid * per + i;
            if (i < per && t < n) { const int R = rowbase + t;
                if (sel[i]) { const int er = ebase + slot; p->SRCROW[er] = R; p->VAL[er] = __uint_as_float(key[i]); p->SLOTOF[(size_t)R * 16 + e] = er; ++slot; }
                else p->SLOTOF[(size_t)R * 16 + e] = -1; } }
        __syncthreads();
    }
}
__device__ __forceinline__ void st_combine(KP p, int l, bool with_ctx) {
    const int wid = ltid() >> 6, lane = ltid() & 63;
    const float* mod = p->MOD + (size_t)l * 9 * 6144;
    const int nrows = with_ctx ? MT : NLAT, stride = lgrid() * 8;
    int R = lbid() * 8 + wid;
    int so_n = -1; float sv_n = 0.f; f32x4 x_n[4];
    if (R < nrows) {
        so_n = p->SLOTOF[(size_t)R * 16 + (lane & 15)]; sv_n = so_n >= 0 ? p->VAL[so_n] : 0.f;
#pragma unroll
        for (int i = 0; i < 4; ++i) x_n[i] = *(const f32x4*)(p->X + (size_t)R * DM + lane * 4 + 256 * i);
    }
    for (; R < nrows; R += stride) {
        const int so = so_n; const float sv = sv_n; f32x4 x[4];
#pragma unroll
        for (int i = 0; i < 4; ++i) x[i] = x_n[i];
        const int Rn = R + stride;
        if (Rn < nrows) {
            so_n = p->SLOTOF[(size_t)Rn * 16 + (lane & 15)]; sv_n = so_n >= 0 ? p->VAL[so_n] : 0.f;
#pragma unroll
            for (int i = 0; i < 4; ++i) x_n[i] = *(const f32x4*)(p->X + (size_t)Rn * DM + lane * 4 + 256 * i);
        }
        unsigned mask = (unsigned)(__ballot(so >= 0) & 0xFFFFull);
        f32x4 a[4];
#pragma unroll
        for (int i = 0; i < 4; ++i) a[i] = (f32x4){0.f, 0.f, 0.f, 0.f};
        while (mask) {
            const int e0 = __builtin_ctz(mask); mask &= mask - 1;
            const bool two = mask != 0; const int e1 = two ? __builtin_ctz(mask) : e0; if (two) mask &= mask - 1;
            const int er0 = __shfl(so, e0), er1 = __shfl(so, e1); const float v0 = __shfl(sv, e0), v1 = two ? __shfl(sv, e1) : 0.f;
            const bf16_t* y0 = p->Y + (size_t)er0 * DM + lane * 4; const bf16_t* y1 = p->Y + (size_t)er1 * DM + lane * 4;
            u32x2 w0[4], w1[4];
#pragma unroll
            for (int i = 0; i < 4; ++i) { w0[i] = *(const u32x2*)(y0 + 256 * i); w1[i] = *(const u32x2*)(y1 + 256 * i); }
#pragma unroll
            for (int i = 0; i < 4; ++i) { a[i][0] += v0 * bflo(w0[i].x) + v1 * bflo(w1[i].x); a[i][1] += v0 * bfhi(w0[i].x) + v1 * bfhi(w1[i].x); a[i][2] += v0 * bflo(w0[i].y) + v1 * bflo(w1[i].y); a[i][3] += v0 * bfhi(w0[i].y) + v1 * bfhi(w1[i].y); }
        }
        const float* m = mod + mod_row(R) * 6144;
#pragma unroll
        for (int i = 0; i < 4; ++i) { const int c = lane * 4 + 256 * i; x[i] += *(const f32x4*)(m + 5120 + c) * a[i]; }
        if (l + 1 < NL) {
#pragma unroll
            for (int i = 0; i < 4; ++i) *(f32x4*)(p->X + (size_t)R * DM + lane * 4 + 256 * i) = x[i];
            const float* m2 = p->MOD + (size_t)(l + 1) * 9 * 6144 + mod_row(R) * 6144;
            norm_mod_row(x, p->in[I_N1G] + (l + 1) * DM, m2, m2 + 1024, lane);
            store_row_bf16(p->U + (size_t)R * DM, x, lane);
            store_row_fp8(p->U8W + (size_t)R * DM, x, lane, S8_U);
        } else {
            float ss = 0.f;
#pragma unroll
            for (int i = 0; i < 4; ++i) ss += x[i][0] * x[i][0] + x[i][1] * x[i][1] + x[i][2] * x[i][2] + x[i][3] * x[i][3];
            ss = wave_sum(ss); const float rs = rsqrtf(ss * (1.f / DM) + EPS);
#pragma unroll
            for (int i = 0; i < 4; ++i) { const int c = lane * 4 + 256 * i; *(f32x4*)(p->out + (size_t)R * DM + c) = x[i] * rs * *(const f32x4*)(p->in[I_FNG] + c); }
        }
    }
}

constexpr int LDS_BYTES = 160 * 1024;
#define PHASE_BEGIN { KP p = kparams(); LAS unsigned char* lds3 = llds3(lds0); unsigned char* lds = (unsigned char*)lds3; const int G = lgrid(), c0_ = lbid(), c = (G % 8 == 0) ? (c0_ % 8) * (G / 8) + c0_ / 8 : c0_;     (void)p; (void)lds; (void)lds3; (void)G; (void)c;
#define PHASE_END   xcd_barrier(bar); }
#ifndef DUPMASK
#define DUPMASK 0
#endif
#define RUN(bit, ...) do { __VA_ARGS__; if ((DUPMASK >> (bit)) & 1) { xcd_barrier(bar); __VA_ARGS__; } } while (0)
__global__ void __launch_bounds__(NTHREADS, 2) fwd(Params p_unused) {
    extern __shared__ __attribute__((aligned(16))) unsigned char lds_raw[];
    LAS unsigned char* lds0 = (LAS unsigned char*)lds_raw + 16;
    volatile LAS unsigned* xbw = (volatile LAS unsigned*)lds_raw;
    if (threadIdx.x == 0) { xbw[0] = 0u; xbw[1] = 0u; xbw[2] = 0u; xbw[3] = 0u; }
    __syncthreads();
    XcdBarrier bar = xcd_barrier_post(kparams()->bar, xbw);
    PHASE_BEGIN RUN(12, st_adaln(p, lds)); RUN(0, st_convert(p, lds, 0, NL)); RUN(13, st_fold(p)); PHASE_END
    PHASE_BEGIN RUN(14, st_norm1(p, 0)); PHASE_END
    for (int l = 0; l < NL; ++l) {
        const bool wc = l + 1 < NL;
        PHASE_BEGIN pg8::PlainOrder S{(const char*)p->U, (const char*)(p->WIN + (size_t)l * PC * DM), (size_t)256 * DM * 2, (size_t)256 * DM * 2, MT / 256, C_MG / 256, G, c};
                    pg8::EpiIn E{p->P, p->PG};
                    const int c8 = (c + 56) % G;
                    pg8::PlainOrder S8{(const char*)p->U8W, (const char*)(p->WING8 + (size_t)l * 3072 * DM), (size_t)256 * DM, (size_t)256 * DM, (wc ? MT : NLAT) / 256, 3072 / 256, G, c8};
                    pg8::EpiGate8 E8{p->PG, 1.f / (S8_U * S8_W)};
                    RUN(1, pg8::gemm_phase<pg8::EpiIn, pg8::PlainOrder, true, true>(lds3, DM * 2, DM * 2, DM / 64, S, E); pg8::gemm_phase<pg8::EpiGate8, pg8::PlainOrder, true, true, true>(lds3, DM, DM, DM / 128, S8, E8)); PHASE_END
        PHASE_BEGIN st_qkrope(p, l, lds);
                    { unsigned* head = p->bar + XCD_BAR_WORDS + l * 64; volatile LAS unsigned* qw = (volatile LAS unsigned*)lds_raw + 2;
                      const int nNA = NB * 4 * 16, nGS = NB * NCH, nTot = nNA + nGS + (wc ? NB * 4 : 0);
                      for (;;) {
                          __syncthreads();
                          if (ltid() == 0) *qw = __hip_atomic_fetch_add(head, 1u, __ATOMIC_RELAXED, __HIP_MEMORY_SCOPE_AGENT);
                          __syncthreads();
                          const int u = (int)*qw;
                          if (u >= nTot) break;
                          if (u < nNA) attn_one(p, l, u, true, lds3);
                          else if (u < nNA + nGS) gla_states_one(p, l, u - nNA, lds3);
                          else attn_one(p, l, nNA + (u - nNA - nGS), true, lds3);
                      } }
                    PHASE_END
        PHASE_BEGIN st_gla_scan2(p);
                    { const int nq = (G % 8 == 0) ? 8 : 1, x = c0_ % nq;
                      unsigned* head = p->bar + XCD_BAR_WORDS + (16 + l * 8 + x) * 64; volatile LAS unsigned* qw = (volatile LAS unsigned*)lds_raw + 2;
                      const int nLat = NB * 4 * 16 / nq, nCtxQ = NB * 4 / nq, nTot = nLat + (wc ? nCtxQ : 0);
                      for (;;) {
                          __syncthreads();
                          if (ltid() == 0) *qw = __hip_atomic_fetch_add(head, 1u, __ATOMIC_RELAXED, __HIP_MEMORY_SCOPE_AGENT);
                          __syncthreads();
                          const int j = (int)*qw;
                          if (j >= nTot) break;
                          int u = j;
                          if (nq == 8) {
                              if (j < nLat) { const int pair = x + 8 * (j >> 5), jj = j & 31; u = ((pair >> 1) << 6) | ((((pair & 1) << 1) | (jj >> 4)) << 4) | (jj & 15); }
                              else u = NB * 4 * 16 + x * nCtxQ + (j - nLat);
                          }
                          attn_one(p, l, u, false, lds3);
                      } }
                    PHASE_END
        PHASE_BEGIN RUN(5, st_gla_out2(p, l, wc, lds3)); PHASE_END
        PHASE_BEGIN pg8::MergeOrder S{(const char*)p->YCAT, (const char*)(p->WB + (size_t)l * DM * 768), (size_t)256 * 768 * 2, (size_t)256 * 768 * 2, (wc ? MT : NLAT) / 256, DM / 256, G, c};
                    pg8::EpiMerge E{p->PG, p->MPRE};
                    RUN(6, pg8::gemm_phase<pg8::EpiMerge, pg8::MergeOrder, true, true>(lds3, 768 * 2, 768 * 2, 256 / 64, S, E)); PHASE_END
        PHASE_BEGIN pg8::PlainOrder S{(const char*)p->MPRE, (const char*)(p->WOUT + (size_t)l * DM * DM), (size_t)256 * DM * 2, (size_t)256 * DM * 2, (wc ? MT : NLAT) / 256, DM / 256, G, c};
                    pg8::EpiOut E{p->X, p->MOD + (size_t)l * 9 * 6144};
                    pg8::gemm_phase<pg8::EpiOut, pg8::PlainOrder, true, true>(lds3, DM * 2, DM * 2, DM / 64, S, E); PHASE_END
        PHASE_BEGIN RUN(7, st_norm2_router(p, l, wc, lds)); PHASE_END
        PHASE_BEGIN RUN(8, st_topk(p, wc, lds)); PHASE_END
        PHASE_BEGIN pg8::ExpertOrder S{(const char*)p->U, (const char*)(p->WGU + (size_t)l * NE * 2 * FF * DM), 0, (size_t)256 * DM, 0, (size_t)2 * FF * DM, wc ? 17 : 16, 16, G, c, p->SRCROW};
                    pg8::EpiGU8 E{p->H, 1.f / (S8_W * S8_X), S8_H};
                    RUN(10, pg8::gemm_phase<pg8::EpiGU8, pg8::ExpertOrder, true, true, true, true>(lds3, DM, DM, DM / 128, S, E)); PHASE_END
        PHASE_BEGIN pg8::ExpertOrder S{(const char*)p->H, (const char*)(p->WD + (size_t)l * NE * DM * FF), (size_t)256 * FF, (size_t)256 * FF, (size_t)EROWS * FF, (size_t)DM * FF, wc ? 17 : 16, 4, G, c, nullptr};
                    pg8::EpiDown E{p->Y, 1.f / (S8_W * S8_H)};
                    RUN(11, pg8::gemm_phase<pg8::EpiDown, pg8::ExpertOrder, true, true, true>(lds3, FF, FF, FF / 128, S, E)); PHASE_END
        PHASE_BEGIN st_combine(p, l, wc); PHASE_END
    }
}

extern "C" void kernel_launch(void* const* d_in, const int* in_sizes, int n_in, void* d_out, int out_size, void* d_ws, size_t ws_size, hipStream_t stream) {
    Params p{};
    for (int i = 0; i < 26; ++i) p.in[i] = (const float*)d_in[i];
    p.out = (float*)d_out;
    unsigned char* w = (unsigned char*)d_ws; size_t off = 0;
    auto take = [&](size_t bytes) { unsigned char* r = w + off; off += (bytes + 255) & ~(size_t)255; return r; };
    p.bar = (unsigned*)take((XCD_BAR_WORDS + QUEUE_WORDS) * 4);
    p.X = (float*)take((size_t)MT * DM * 4);
    p.U = (bf16_t*)take((size_t)MT * DM * 2);
    p.MOD = (float*)take((size_t)NL * 9 * 6144 * 4);
    p.MPRE = (bf16_t*)take((size_t)MT * DM * 2);
    p.AFF = (float*)take((size_t)MT * 16 * 4);
    p.SRCROW = (int*)take((size_t)NE * EROWS * 4);
    p.VAL = (float*)take((size_t)NE * EROWS * 4);
    p.SLOTOF = (int*)take((size_t)MT * 16 * 4);
    p.WIN = (bf16_t*)take((size_t)NL * PC * DM * 2);
    p.WB = (bf16_t*)take((size_t)NL * DM * 768 * 2);
    p.WOUT = (bf16_t*)take((size_t)NL * DM * DM * 2);
    p.WGU = (unsigned char*)take((size_t)NL * NE * 2 * FF * DM);
    p.WD = (unsigned char*)take((size_t)NL * NE * DM * FF);
    p.U8W = (unsigned char*)take((size_t)MT * DM);
    p.WING8 = (unsigned char*)take((size_t)NL * 3072 * DM);
    const size_t r1 = off;
    p.P = (bf16_t*)take((size_t)MT * PC * 2);
    p.YCAT = (bf16_t*)take((size_t)MT * 768 * 2);
    p.DST = (float*)take((size_t)NB * 2 * NCH * 4 * 2048 * 4);
    p.DEC = (float*)take((size_t)NB * 2 * NCH * 4 * 32 * 4);
    p.ST = (bf16_t*)take((size_t)NB * 2 * NCH * 4 * 2048 * 2);
    p.PG = (unsigned char*)take((size_t)MT * 3072);
    const size_t r1_end = off;
    off = r1;
    p.XS = (unsigned char*)take((size_t)NE * EROWS * DM);
    p.H = (unsigned char*)take((size_t)NE * EROWS * FF);
    p.Y = (bf16_t*)take((size_t)NE * EROWS * DM * 2);
    if (off < r1_end) off = r1_end;
    if (off > ws_size) { fprintf(stderr, "workspace too small: need %zu have %zu\n", off, ws_size); return; }
    static int grid = 0;
    if (!grid) {
        (void)hipFuncSetAttribute((const void*)fwd, hipFuncAttributeMaxDynamicSharedMemorySize, LDS_BYTES);
        int dev = 0, cus = 0, per_cu = 0;
        (void)hipGetDevice(&dev);
        (void)hipDeviceGetAttribute(&cus, hipDeviceAttributeMultiprocessorCount, dev);
        (void)hipOccupancyMaxActiveBlocksPerMultiprocessor(&per_cu, fwd, NTHREADS, LDS_BYTES);
        if (per_cu < 1) fprintf(stderr, "occupancy query says %d blocks per CU\n", per_cu);
        grid = cus;
    }
    (void)hipMemsetAsync(p.bar, 0, (XCD_BAR_WORDS + QUEUE_WORDS) * 4, stream);
    hipLaunchKernelGGL(fwd, dim3(grid), dim3(NTHREADS), LDS_BYTES, stream, p);
}
```

```cpp
#include <hip/hip_runtime.h>
#include <stdint.h>
#include <stdio.h>


typedef unsigned short bf16_t;
typedef short bf16x8 __attribute__((ext_vector_type(8)));
typedef float f32x4 __attribute__((ext_vector_type(4)));
typedef unsigned u32x4 __attribute__((ext_vector_type(4)));
typedef unsigned u32x2 __attribute__((ext_vector_type(2)));
#define LAS __attribute__((address_space(3)))

constexpr int DM = 1024, NB = 8, TL = 4096, SC = 256, NL = 4;
constexpr int NLAT = NB * TL, NCTX = NB * SC, MT = NLAT + NCTX;
constexpr int INC = 5152, PC = 5376;
constexpr int C_QA = 0, C_KA = 256, C_VA = 512, C_QB = 768, C_KB = 896, C_VB = 1024, C_RB = 1280, C_G = 1536,
              C_QC = 1792, C_KC = 2048, C_VC = 2176, C_MG = 2304;
constexpr int NE = 16, FF = 2048, CAPL = 512, CAPC = 32, EROWS = NB * CAPL + NB * CAPC;
constexpr int NCH = 68;
constexpr int NTHREADS = 512;
constexpr float EPS = 1e-6f;
constexpr float S8_W = 256.f, S8_X = 8.f, S8_H = 4.f, S8_U = 8.f;

__device__ __forceinline__ unsigned cvt_pk_bf16_hw(float lo, float hi) { unsigned r; asm("v_cvt_pk_bf16_f32 %0, %1, %2" : "=v"(r) : "v"(lo), "v"(hi)); return r; }
__device__ __forceinline__ bf16_t f2bf(float f) { return (bf16_t)(cvt_pk_bf16_hw(f, f) & 0xFFFFu); }
__device__ __forceinline__ float bf2f(bf16_t b) { return __uint_as_float(((unsigned)b) << 16); }
__device__ __forceinline__ unsigned pack2(float lo, float hi) { return cvt_pk_bf16_hw(lo, hi); }
__device__ __forceinline__ float bflo(unsigned w) { return __uint_as_float(w << 16); }
__device__ __forceinline__ float bfhi(unsigned w) { return __uint_as_float(w & 0xFFFF0000u); }
__device__ __forceinline__ float siluf(float x) { return x * __builtin_amdgcn_rcpf(1.f + __expf(-x)); }
__device__ __forceinline__ float logsig16(float z) { return (fminf(z, 0.f) - __logf(1.f + __expf(-fabsf(z)))) * (1.f / 16.f); }
__device__ __forceinline__ float wave_sum(float v) {
#pragma unroll
    for (int o = 32; o > 0; o >>= 1) v += __shfl_xor(v, o);
    return v;
}
__device__ __forceinline__ int ltid() { int t = threadIdx.x; asm volatile("" : "+v"(t)); return t; }
__device__ __forceinline__ int lbid() { int t = blockIdx.x; asm volatile("" : "+s"(t)); return t; }
__device__ __forceinline__ int lgrid() { int t = gridDim.x; asm volatile("" : "+s"(t)); return t; }
__device__ __forceinline__ LAS unsigned char* llds3(LAS unsigned char* p) { asm volatile("" : "+s"(p)); return p; }
__device__ __forceinline__ int mod_row(int R) { return R < NLAT ? (R >> 12) : NB; }

struct Params {
    const float* in[26];
    float* out;
    bf16_t* X; bf16_t* U; float* MOD; bf16_t* P; bf16_t* YCAT; bf16_t* MPRE;
    float* AFF; int* SRCROW; float* VAL; int* SLOTOF;
    unsigned char* XS; unsigned char* H; bf16_t* Y;
    float* DST; float* DEC; bf16_t* ST; unsigned char* PG; unsigned char* U8W; unsigned char* WING8;
    bf16_t* WIN; bf16_t* WB; bf16_t* WOUT; unsigned char* WGU; unsigned char* WD;
    unsigned* bar;
};
enum { I_X = 0, I_C, I_CTX, I_CCTX, I_WADA, I_BADA, I_N1G, I_N2G, I_WIN, I_RPB, I_WGF, I_BGF, I_WGB, I_BGB, I_GLAG, I_QNG, I_KNG,
       I_WBA, I_WBB, I_WBC, I_WOUT, I_WR, I_WEG, I_WEU, I_WED, I_FNG };

typedef const __attribute__((address_space(4))) Params* KP;
__device__ __forceinline__ KP kparams() {
    KP kp = (KP)__builtin_amdgcn_kernarg_segment_ptr();
    asm volatile("" : "+s"(kp) :: "memory");
    return kp;
}
#define XB_TMO      128
#define XB_XCNT(j)  (256  + 64 * (j))
#define XB_XSUB(j)  (1280 + 64 * (j))
#define XB_XGEN(j)  (2304 + 64 * (j))
#define XB_TOP      3328
#define XB_TOPGEN   3392
#define XCD_BAR_WORDS 3456
#define XB_SPIN_CAP (1u << 22)
#define QUEUE_WORDS (48 * 64)
__device__ __forceinline__ unsigned xb_ld(unsigned* p)              { return __hip_atomic_load(p, __ATOMIC_RELAXED, __HIP_MEMORY_SCOPE_AGENT); }
__device__ __forceinline__ unsigned xb_add(unsigned* p, unsigned v) { return __hip_atomic_fetch_add(p, v, __ATOMIC_RELAXED, __HIP_MEMORY_SCOPE_AGENT); }
__device__ __forceinline__ unsigned xb_xcc_id() { return (unsigned)__builtin_amdgcn_s_getreg((3 << 11) | 20) & 0xFu; }
#define XB_SPIN(cond, bar) do { unsigned _sp = 0; while (cond) { __builtin_amdgcn_s_sleep(1); \
    if ((++_sp & 255u) == 0u) { if (xb_ld(&(bar)[XB_TMO])) break; if (_sp > XB_SPIN_CAP) { atomicAdd(&(bar)[XB_TMO], 1u); break; } } } } while (0)
struct XcdBarrier { unsigned* bar; unsigned x; volatile LAS unsigned* st; };
__device__ __forceinline__ XcdBarrier xcd_barrier_post(unsigned* bar, volatile LAS unsigned* st) {
    XcdBarrier b; b.bar = bar; b.x = xb_xcc_id(); b.st = st;
    if (threadIdx.x == 0) (void)xb_add(&bar[XB_XCNT(b.x)], 1u);
    return b;
}
__device__ __forceinline__ void xcd_barrier_complete(unsigned* bar, unsigned x, unsigned& nloc, unsigned& nx) {
    const unsigned G = gridDim.x * gridDim.y * gridDim.z;
    unsigned sum, cnt, mine, sp = 0u;
    for (;;) {
        sum = 0u; cnt = 0u; mine = 0u;
#pragma unroll
        for (unsigned j = 0; j < 16; ++j) { const unsigned c = xb_ld(&bar[XB_XCNT(j)]); sum += c; cnt += (c > 0u) ? 1u : 0u; mine = (j == x) ? c : mine; }
        if (sum == G) break;
        __builtin_amdgcn_s_sleep(1);
        if ((++sp & 255u) == 0u) { if (xb_ld(&bar[XB_TMO])) break; if (sp > XB_SPIN_CAP) { atomicAdd(&bar[XB_TMO], 1u); break; } }
    }
    nloc = mine > 0u ? mine : 1u; nx = cnt > 0u ? cnt : 1u;
}
__device__ __forceinline__ void xcd_barrier(const XcdBarrier& b) {
    asm volatile("s_waitcnt vmcnt(0)" ::: "memory");
    __syncthreads();
    if (threadIdx.x == 0) {
        unsigned* bar = b.bar;
        __builtin_amdgcn_s_waitcnt(0);
        unsigned nloc = b.st[0], nx = b.st[1];
        if (nloc == 0u) { xcd_barrier_complete(bar, b.x, nloc, nx); b.st[0] = nloc; b.st[1] = nx; }
        const unsigned old = xb_add(&bar[XB_XSUB(b.x)], 1u);
        const unsigned gen = old / nloc;
        if (old + 1u == (gen + 1u) * nloc) {
            __builtin_amdgcn_fence(__ATOMIC_RELEASE, "agent");
            asm volatile("s_waitcnt vmcnt(0)" ::: "memory");
            const unsigned og = xb_add(&bar[XB_TOP], 1u);
            const unsigned tg = og / nx;
            if (og + 1u == (tg + 1u) * nx) xb_add(&bar[XB_TOPGEN], 1u);
            else XB_SPIN(xb_ld(&bar[XB_TOPGEN]) == tg, bar);
            __builtin_amdgcn_fence(__ATOMIC_ACQUIRE, "agent");
            xb_add(&bar[XB_XGEN(b.x)], 1u);
            asm volatile("s_waitcnt vmcnt(0)" ::: "memory");
        } else {
            XB_SPIN(xb_ld(&bar[XB_XGEN(b.x)]) == gen, bar);
            __builtin_amdgcn_fence(__ATOMIC_ACQUIRE, "agent");
            asm volatile("s_waitcnt vmcnt(0)" ::: "memory");
        }
    }
    __syncthreads();
}

#ifndef PG8_TID
#define PG8_TID ltid()
#endif
namespace pg8 {
constexpr int BM = 256, BK = 64, HALF = 128, HTB = HALF * BK * 2, STAGE_BYTES = 8 * HTB;
__host__ __device__ __forceinline__ int lds_byte(int r, int c) { const int st = (r >> 4) * 2 + (c >> 5), rr = r & 15, cc = c & 31, ob = rr * 64 + cc * 2; return st * 1024 + (ob ^ (((ob >> 9) & 1) << 5)); }
__host__ __device__ __forceinline__ void stage_rc(int b, int& R, int& C) { const int st = b / 1024, sb = b % 1024, swz = sb ^ (((sb >> 9) & 1) << 5); R = (st >> 1) * 16 + swz / 64; C = (st & 1) * 32 + (swz % 64) / 2; }
__host__ __device__ __forceinline__ int perm32(int rho) { const int n = rho >> 4, i = rho & 15; return 8 * (i >> 2) + 4 * n + (i & 3); }
struct Unit { const char* A; const char* B; int row0, col0, aux, keep; const int* G; };
__device__ __forceinline__ unsigned cvt_pk_bf16(float lo, float hi) { unsigned r; asm volatile("v_cvt_pk_bf16_f32 %0, %1, %2" : "=v"(r) : "v"(lo), "v"(hi)); return r; }

typedef int v8i __attribute__((ext_vector_type(8)));
typedef int v4i __attribute__((ext_vector_type(4)));
__device__ __forceinline__ void glds16s(unsigned voff, const void* sbase, unsigned lds_dst) { unsigned keep;
    asm volatile("s_mov_b32 %0, m0\n\ts_mov_b32 m0, %3\n\ts_nop 0\n\tglobal_load_lds_dwordx4 %1, %2\n\ts_mov_b32 m0, %0" : "=&s"(keep) : "v"(voff), "s"(sbase), "s"(lds_dst) : "memory"); }
__device__ __forceinline__ void glds4s(unsigned voff, const void* sbase, unsigned lds_dst) { unsigned keep;
    asm volatile("s_mov_b32 %0, m0\n\ts_mov_b32 m0, %3\n\ts_nop 0\n\tglobal_load_lds_dword %1, %2\n\ts_mov_b32 m0, %0" : "=&s"(keep) : "v"(voff), "s"(sbase), "s"(lds_dst) : "memory"); }
template <class Epi, class Sched, bool ALIGN_EPI, bool SP2, bool FP8 = false, bool GATHER = false>
__device__ __forceinline__ void gemm_phase(LAS unsigned char* lds, const int ldaB, const int ldbB, const int nt_in, const Sched& S, const Epi& E) {
    int nt = nt_in; asm volatile("" : "+s"(nt));
    const int tid = PG8_TID, wid = __builtin_amdgcn_readfirstlane(tid >> 6), lane = tid & 63, wr = wid >> 2, wc = wid & 3, fr = lane & 15, fq = lane >> 4;
    unsigned voffA[2], voffB[2];
#pragma unroll
    for (int i = 0; i < 2; ++i) { int R, C; stage_rc(tid * 16 + i * 8192, R, C); const int Rb = Epi::PERM ? ((R & ~31) + perm32(R & 31)) : R;
        voffA[i] = (unsigned)(R * ldaB + C * 2); voffB[i] = (unsigned)(Rb * ldbB + C * 2); }
    const size_t kstep = (size_t)(BK * 2);
    const size_t hstepA = (size_t)HALF * ldaB, hstepB = (size_t)HALF * ldbB;
    const unsigned ldsw = (unsigned)wid * 1024u, ldsbase = (unsigned)__builtin_amdgcn_readfirstlane((int)(unsigned)(uintptr_t)lds);
    const int aoff = lds_byte(wr * 64 + fr, fq * 8), boff = lds_byte(wc * 32 + fr, fq * 8);
#define PG8_SA(b, h) (((b) * 2 + (h)) * HTB)
#define PG8_SB(b, h) ((4 + (b) * 2 + (h)) * HTB)
#define PG8_STAGE(bufoff, gbase, voff) do { _Pragma("unroll") for (int _i = 0; _i < 2; ++_i) \
        glds16s((voff)[_i], (const void*)(gbase), ldsbase + (unsigned)(bufoff) + ldsw + _i * 8192); } while (0)
    unsigned vc[2][2], vn[2][2]; int gR[2], gC[2];
#pragma unroll
    for (int i = 0; i < 2; ++i) { int R, C; stage_rc(tid * 16 + i * 8192, R, C); gR[i] = R; gC[i] = C * 2; vc[0][i] = vc[1][i] = vn[0][i] = vn[1][i] = 0u; }
    LAS int* gidx = (LAS int*)(lds + STAGE_BYTES);
#define PG8_GIDX(dst, buf) do { _Pragma("unroll") for (int h_ = 0; h_ < 2; ++h_) _Pragma("unroll") for (int i_ = 0; i_ < 2; ++i_) dst[h_][i_] = (unsigned)(gidx[(buf) * 256 + h_ * HALF + gR[i_]] * ldaB + gC[i_]); } while (0)
#define PG8_STAGE_A(b, h, base, nx) do { if constexpr (GATHER) { if (nx) PG8_STAGE(PG8_SA(b, h), base, vn[h]); else PG8_STAGE(PG8_SA(b, h), base, vc[h]); } \
        else PG8_STAGE(PG8_SA(b, h), (base) + (h) * hstepA, voffA); } while (0)
#define PG8_LDA(dst, b, h) do { _Pragma("unroll") for (int m = 0; m < 4; ++m) { dst[m].lo = *(const LAS v4i*)(lds + PG8_SA(b, h) + aoff + m * 2048); dst[m].hi = *(const LAS v4i*)(lds + PG8_SA(b, h) + aoff + m * 2048 + 1024); } } while (0)
#define PG8_LDB(dst, b, h) do { _Pragma("unroll") for (int n = 0; n < 2; ++n) { dst[n].lo = *(const LAS v4i*)(lds + PG8_SB(b, h) + boff + n * 2048); dst[n].hi = *(const LAS v4i*)(lds + PG8_SB(b, h) + boff + n * 2048 + 1024); } } while (0)
#define PG8_MMA(ai, bj, At, Bt) do { __builtin_amdgcn_s_setprio(1); _Pragma("unroll") for (int m = 0; m < 4; ++m) _Pragma("unroll") for (int n = 0; n < 2; ++n) { \
        if constexpr (FP8) asm volatile("v_mfma_scale_f32_16x16x128_f8f6f4 %0, %1, %2, %0, %3, %3 op_sel_hi:[0,0,0]" : "+v"(acc[ai][bj][m][n]) : "v"(Bt[n]), "v"(At[m]), "v"(sc8)); \
        else { const v4i bl_ = Bt[n].lo, bh_ = Bt[n].hi, al_ = At[m].lo, ah_ = At[m].hi;     \
               acc[ai][bj][m][n] = __builtin_amdgcn_mfma_f32_16x16x32_bf16(__builtin_bit_cast(bf16x8, bl_), __builtin_bit_cast(bf16x8, al_), acc[ai][bj][m][n], 0, 0, 0); \
               acc[ai][bj][m][n] = __builtin_amdgcn_mfma_f32_16x16x32_bf16(__builtin_bit_cast(bf16x8, bh_), __builtin_bit_cast(bf16x8, ah_), acc[ai][bj][m][n], 0, 0, 0); } } __builtin_amdgcn_s_setprio(0); } while (0)
#define PG8_WAIT_V(n) asm volatile("s_waitcnt vmcnt(" #n ")" ::: "memory")
#define PG8_WAIT_L(n) asm volatile("s_waitcnt lgkmcnt(" #n ")" ::: "memory")
#define PG8_BAR __builtin_amdgcn_s_barrier()
#define PG8_SCHED __builtin_amdgcn_sched_barrier(0)
    Unit cur, nxt; int ui = 0;
    if (!S.next(0, cur)) return;
    f32x4 acc[2][2][4][2];
#pragma unroll
    for (int a = 0; a < 2; ++a)
#pragma unroll
        for (int b = 0; b < 2; ++b)
#pragma unroll
            for (int m = 0; m < 4; ++m)
#pragma unroll
                for (int n = 0; n < 2; ++n) acc[a][b][m][n] = (f32x4){0.f, 0.f, 0.f, 0.f};
    v8i At[4], B0[2], B1[2];
    int sc8 = 0x7F7F7F7F; asm volatile("" : "+v"(sc8));
    const char* cA = cur.A; const char* cB = cur.B;
    if constexpr (GATHER) {
        if (tid < 256) gidx[tid] = cur.G[tid];
        asm volatile("s_waitcnt vmcnt(0) lgkmcnt(0)" ::: "memory"); PG8_BAR; asm volatile("" ::: "memory");
        PG8_GIDX(vc, 0);
    }
    if constexpr (SP2) {
        PG8_STAGE(PG8_SB(0, 0), cB, voffB); PG8_STAGE(PG8_SB(0, 1), cB + hstepB, voffB); PG8_STAGE_A(0, 0, cA, false); PG8_STAGE_A(0, 1, cA, false);
        if (wr == 1) PG8_BAR;
        PG8_WAIT_V(2); PG8_BAR;
        PG8_STAGE(PG8_SB(1, 0), cB + kstep, voffB); PG8_STAGE_A(1, 0, cA + kstep, false); PG8_STAGE(PG8_SB(1, 1), cB + hstepB + kstep, voffB);
        PG8_WAIT_V(6); PG8_BAR;
    } else {
        PG8_STAGE(PG8_SB(0, 0), cB, voffB); PG8_STAGE(PG8_SA(0, 0), cA, voffA); PG8_STAGE(PG8_SB(0, 1), cB + hstepB, voffB); PG8_STAGE(PG8_SA(0, 1), cA + hstepA, voffA);
        if (wr == 1) PG8_BAR;
        PG8_WAIT_V(4); PG8_BAR;
        PG8_STAGE(PG8_SB(1, 0), cB + kstep, voffB); PG8_STAGE(PG8_SA(1, 0), cA + kstep, voffA); PG8_STAGE(PG8_SB(1, 1), cB + hstepB + kstep, voffB);
        PG8_WAIT_V(6); PG8_BAR;
    }
    for (;;) {
        const bool has_next = S.next(ui + 1, nxt);
        const char* nA = has_next ? nxt.A : cA; const char* nB = has_next ? nxt.B : cB;
        if constexpr (GATHER) { if (has_next && wid < 4) glds4s((unsigned)lane * 4u, (const void*)(nxt.G + wid * 64), ldsbase + (unsigned)STAGE_BYTES + (unsigned)(((ui + 1) & 1) * 1024 + wid * 256)); }
#pragma unroll 1
        for (int t = 0; t < nt; t += 2) {
            const bool last = (t == nt - 2);
            const char* a1 = cA + (size_t)(t + 1) * kstep;
            const char* a2 = last ? nA : cA + (size_t)(t + 2) * kstep; const char* b2 = last ? nB : cB + (size_t)(t + 2) * kstep;
            const char* a3 = a2 + kstep; const char* b3 = b2 + kstep;
            if constexpr (SP2) {
            if constexpr (GATHER) { if (last) { if (has_next) PG8_GIDX(vn, (ui + 1) & 1); else { vn[0][0] = vc[0][0]; vn[0][1] = vc[0][1]; vn[1][0] = vc[1][0]; vn[1][1] = vc[1][1]; } } }
            PG8_LDB(B0, 0, 0); PG8_LDB(B1, 0, 1); PG8_SCHED; PG8_LDA(At, 0, 0); PG8_STAGE_A(1, 1, a1, false);
            PG8_WAIT_V(8); PG8_WAIT_L(0); PG8_BAR; PG8_MMA(0, 0, At, B0); PG8_MMA(0, 1, At, B1); PG8_BAR; PG8_SCHED;
            PG8_LDA(At, 0, 1); PG8_STAGE(PG8_SB(0, 0), b2, voffB); PG8_STAGE(PG8_SB(0, 1), b2 + hstepB, voffB); PG8_STAGE_A(0, 0, a2, last);
            PG8_WAIT_V(8); PG8_WAIT_L(0); PG8_BAR; PG8_MMA(1, 0, At, B0); PG8_MMA(1, 1, At, B1); PG8_BAR; PG8_SCHED;
            PG8_LDB(B0, 1, 0); PG8_LDB(B1, 1, 1); PG8_SCHED; PG8_LDA(At, 1, 0); PG8_STAGE_A(0, 1, a2, last);
            PG8_WAIT_V(8); PG8_WAIT_L(0); PG8_BAR; PG8_MMA(0, 0, At, B0); PG8_MMA(0, 1, At, B1); PG8_BAR; PG8_SCHED;
            PG8_LDA(At, 1, 1); PG8_STAGE(PG8_SB(1, 0), b3, voffB); PG8_STAGE(PG8_SB(1, 1), b3 + hstepB, voffB); PG8_STAGE_A(1, 0, a3, last);
            PG8_WAIT_V(8); PG8_WAIT_L(0); PG8_BAR; PG8_MMA(1, 0, At, B0); PG8_MMA(1, 1, At, B1); PG8_BAR; PG8_SCHED;
            } else {
            PG8_LDB(B0, 0, 0); PG8_SCHED; PG8_LDA(At, 0, 0); PG8_STAGE(PG8_SA(1, 1), a1 + hstepA, voffA);
            PG8_WAIT_L(8); PG8_BAR; PG8_WAIT_L(0); PG8_MMA(0, 0, At, B0); PG8_BAR; PG8_SCHED;
            PG8_LDB(B1, 0, 1); PG8_STAGE(PG8_SB(0, 0), b2, voffB);
            PG8_BAR; PG8_WAIT_L(0); PG8_MMA(0, 1, At, B1); PG8_BAR;
            PG8_LDA(At, 0, 1); PG8_STAGE(PG8_SA(0, 0), a2, voffA);
            PG8_BAR; PG8_WAIT_L(0); PG8_MMA(1, 0, At, B0); PG8_BAR; PG8_SCHED;
            PG8_STAGE(PG8_SB(0, 1), b2 + hstepB, voffB);
            PG8_WAIT_V(6); PG8_BAR; PG8_MMA(1, 1, At, B1); PG8_BAR;
            PG8_LDB(B0, 1, 0); PG8_SCHED; PG8_LDA(At, 1, 0); PG8_STAGE(PG8_SA(0, 1), a2 + hstepA, voffA);
            PG8_WAIT_L(8); PG8_BAR; PG8_WAIT_L(0); PG8_MMA(0, 0, At, B0); PG8_BAR; PG8_SCHED;
            PG8_LDB(B1, 1, 1); PG8_STAGE(PG8_SB(1, 0), b3, voffB);
            PG8_BAR; PG8_WAIT_L(0); PG8_MMA(0, 1, At, B1); PG8_BAR;
            PG8_LDA(At, 1, 1); PG8_STAGE(PG8_SA(1, 0), a3, voffA);
            PG8_BAR; PG8_WAIT_L(0); PG8_MMA(1, 0, At, B0); PG8_BAR; PG8_SCHED;
            PG8_STAGE(PG8_SB(1, 1), b3 + hstepB, voffB);
            PG8_WAIT_V(6); PG8_BAR; PG8_MMA(1, 1, At, B1); PG8_BAR;
            }
        }
        if constexpr (FP8) asm volatile("s_nop 15\n\ts_nop 15" ::: "memory");
        if constexpr (ALIGN_EPI) { if (wr == 0) PG8_BAR; }
        E(acc, cur, wr, wc, fr, fq);
        if (!has_next) break;
        if (!(Epi::KEEP && cur.keep)) {
#pragma unroll
        for (int a = 0; a < 2; ++a)
#pragma unroll
            for (int b = 0; b < 2; ++b)
#pragma unroll
                for (int m = 0; m < 4; ++m)
#pragma unroll
                    for (int n = 0; n < 2; ++n) acc[a][b][m][n] = (f32x4){0.f, 0.f, 0.f, 0.f};
        }
        cur = nxt; cA = nA; cB = nB; ++ui;
        if constexpr (GATHER) { vc[0][0] = vn[0][0]; vc[0][1] = vn[0][1]; vc[1][0] = vn[1][0]; vc[1][1] = vn[1][1]; }
        if constexpr (ALIGN_EPI) { if (wr == 1) PG8_BAR; }
    }
    PG8_WAIT_V(0);
    if constexpr (!ALIGN_EPI) { if (wr == 0) PG8_BAR; }
    PG8_BAR;
#undef PG8_SA
#undef PG8_SB
#undef PG8_STAGE
#undef PG8_STAGE_A
#undef PG8_GIDX
#undef PG8_LDA
#undef PG8_LDB
#undef PG8_MMA
#undef PG8_WAIT_V
#undef PG8_WAIT_L
#undef PG8_BAR
#undef PG8_SCHED
}

struct PlainOrder {
    const char* A; const char* B; size_t astep, bstep; int nM, nN, G, c;
    __device__ __forceinline__ bool next(int i, Unit& u) const {
        const int L = i * G + c; if (L >= nM * nN) return false;
        const int nig = 8 * nN, gid = L / nig, fm = gid * 8, gsz = (nM - fm) < 8 ? (nM - fm) : 8;
        const int pm = fm + ((L % nig) % gsz), pn = (L % nig) / gsz;
        u.A = A + (size_t)pm * astep; u.B = B + (size_t)pn * bstep; u.row0 = pm * 256; u.col0 = pn * 256; u.aux = 0; u.keep = 0; u.G = nullptr; return true;
    }
};
struct MergeOrder {
    const char* A; const char* B; size_t astep, bstep; int nM, nN, G, c;
    __device__ __forceinline__ bool next(int i, Unit& u) const {
        const int t = i / 3, seg = i - 3 * t;
        const int L = t * G + c; if (L >= nM * nN) return false;
        const int nig = 8 * nN, gid = L / nig, fm = gid * 8, gsz = (nM - fm) < 8 ? (nM - fm) : 8;
        const int pm = fm + ((L % nig) % gsz), pn = (L % nig) / gsz;
        u.A = A + (size_t)pm * astep + seg * 512; u.B = B + (size_t)pn * bstep + seg * 512; u.row0 = pm * 256; u.col0 = pn * 256; u.aux = seg; u.keep = seg < 2; u.G = nullptr; return true;
    }
};
struct ExpertOrder {
    const char* A; const char* B; size_t astep, bstep, aexp, bexp; int nM, nN, G, c; const int* rows;
    __device__ __forceinline__ bool next(int i, Unit& u) const {
        const int L = i * G + c, per = nM * nN; if (L >= NE * per) return false;
        const int e = L / per, r = L - e * per;
        const int nig = 8 * nN, gid = r / nig, fm = gid * 8, gsz = (nM - fm) < 8 ? (nM - fm) : 8;
        const int pm = fm + ((r % nig) % gsz), pn = (r % nig) / gsz;
        u.A = A + (size_t)e * aexp + (size_t)pm * astep; u.B = B + (size_t)e * bexp + (size_t)pn * bstep; u.row0 = e * EROWS + pm * 256; u.col0 = pn * 256; u.aux = e; u.keep = 0; u.G = rows ? rows + u.row0 : nullptr; return true;
    }
};
__device__ __forceinline__ unsigned q8(float g) {
    const float sg = __builtin_amdgcn_rcpf(1.f + __builtin_amdgcn_exp2f(g * -1.4426950408889634f));
    return (unsigned)__builtin_amdgcn_fmed3f(sg * 255.f + 0.5f, 1.f, 255.f);
}
struct EpiIn {
    static constexpr bool PERM = true, KEEP = false;
    bf16_t* P; unsigned char* PG;
    __device__ __forceinline__ void operator()(f32x4 (&acc)[2][2][4][2], const Unit& u, int wr, int wc, int fr, int fq) const {
        const int row0 = u.row0 + wr * 64 + fr, cl = u.col0 + wc * 32 + 8 * fq; const bool mg = u.col0 >= C_MG;
        if (mg) {
#pragma unroll
            for (int ai = 0; ai < 2; ++ai)
#pragma unroll
                for (int m = 0; m < 4; ++m) { unsigned char* rowp = PG + (size_t)(row0 + ai * HALF + m * 16) * 3072 + (cl - C_MG);
#pragma unroll
                    for (int bj = 0; bj < 2; ++bj) { const f32x4 v0 = acc[ai][bj][m][0], v1 = acc[ai][bj][m][1]; u32x2 w;
                        w.x = q8(v0[0]) | (q8(v0[1]) << 8) | (q8(v0[2]) << 16) | (q8(v0[3]) << 24); w.y = q8(v1[0]) | (q8(v1[1]) << 8) | (q8(v1[2]) << 16) | (q8(v1[3]) << 24);
                        *(u32x2*)(rowp + bj * HALF) = w; } }
        } else {
#pragma unroll
            for (int ai = 0; ai < 2; ++ai)
#pragma unroll
                for (int m = 0; m < 4; ++m) { bf16_t* rowp = P + (size_t)(row0 + ai * HALF + m * 16) * PC + cl;
#pragma unroll
                    for (int bj = 0; bj < 2; ++bj) { const f32x4 v0 = acc[ai][bj][m][0], v1 = acc[ai][bj][m][1]; u32x4 w; w.x = cvt_pk_bf16(v0[0], v0[1]); w.y = cvt_pk_bf16(v0[2], v0[3]); w.z = cvt_pk_bf16(v1[0], v1[1]); w.w = cvt_pk_bf16(v1[2], v1[3]);
                        *(u32x4*)(rowp + bj * HALF) = w; } }
        }
    }
};
__device__ __forceinline__ float ub(unsigned w, int i) { return (float)((w >> (8 * i)) & 0xFFu); }
struct EpiMerge {
    static constexpr bool PERM = true, KEEP = true;
    const unsigned char* PG; bf16_t* MPRE;
    __device__ __forceinline__ void operator()(f32x4 (&acc)[2][2][4][2], const Unit& u, int wr, int wc, int fr, int fq) const {
        const int row0 = u.row0 + wr * 64 + fr, cl = u.col0 + wc * 32 + 8 * fq, seg = u.aux;
#pragma unroll
        for (int ai = 0; ai < 2; ++ai) {
            u32x2 g0[4][2], g1[4][2];
#pragma unroll
            for (int m = 0; m < 4; ++m) { const unsigned char* gp = PG + (size_t)(row0 + ai * HALF + m * 16) * 3072 + seg * 1024 + cl;
#pragma unroll
                for (int bj = 0; bj < 2; ++bj) { g0[m][bj] = *(const u32x2*)(gp + bj * HALF); g1[m][bj] = (seg < 2) ? *(const u32x2*)(gp + 1024 + bj * HALF) : (u32x2){0u, 0u}; } }
            __builtin_amdgcn_sched_barrier(0);
#pragma unroll
            for (int m = 0; m < 4; ++m) { const int row = row0 + ai * HALF + m * 16;
#pragma unroll
                for (int bj = 0; bj < 2; ++bj) {
                    float f[8];
#pragma unroll
                    for (int e = 0; e < 4; ++e) { f[e] = ub(g0[m][bj].x, e); f[4 + e] = ub(g0[m][bj].y, e); }
                    if (seg < 2) {
#pragma unroll
                        for (int e = 0; e < 4; ++e) { f[e] *= __builtin_amdgcn_rcpf(ub(g1[m][bj].x, e)); f[4 + e] *= __builtin_amdgcn_rcpf(ub(g1[m][bj].y, e)); }
                        acc[ai][bj][m][0] *= (f32x4){f[0], f[1], f[2], f[3]}; acc[ai][bj][m][1] *= (f32x4){f[4], f[5], f[6], f[7]};
                    } else {
                        const f32x4 v0 = acc[ai][bj][m][0] * (1.f / 255.f), v1 = acc[ai][bj][m][1] * (1.f / 255.f); u32x4 w;
                        w.x = cvt_pk_bf16(v0[0] * f[0], v0[1] * f[1]); w.y = cvt_pk_bf16(v0[2] * f[2], v0[3] * f[3]); w.z = cvt_pk_bf16(v1[0] * f[4], v1[1] * f[5]); w.w = cvt_pk_bf16(v1[2] * f[6], v1[3] * f[7]);
                        *(u32x4*)(MPRE + (size_t)row * DM + cl + bj * HALF) = w; }
                } }
        }
    }
};
struct EpiOut {
    static constexpr bool PERM = true, KEEP = false;
    bf16_t* X; const float* mod;
    __device__ __forceinline__ void operator()(f32x4 (&acc)[2][2][4][2], const Unit& u, int wr, int wc, int fr, int fq) const {
        const int row0 = u.row0 + wr * 64 + fr, cl = u.col0 + wc * 32 + 8 * fq;
        const float* g1 = mod + mod_row(u.row0) * 6144 + 2048 + cl;
        f32x4 gv[2][2];
#pragma unroll
        for (int bj = 0; bj < 2; ++bj)
#pragma unroll
            for (int n = 0; n < 2; ++n) gv[bj][n] = *(const f32x4*)(g1 + bj * HALF + n * 4);
#pragma unroll
        for (int ai = 0; ai < 2; ++ai) {
            u32x4 xw[4][2];
#pragma unroll
            for (int m = 0; m < 4; ++m)
#pragma unroll
                for (int bj = 0; bj < 2; ++bj) xw[m][bj] = *(const u32x4*)(X + (size_t)(row0 + ai * HALF + m * 16) * DM + cl + bj * HALF);
            __builtin_amdgcn_sched_barrier(0);
#pragma unroll
            for (int m = 0; m < 4; ++m) { bf16_t* rowp = X + (size_t)(row0 + ai * HALF + m * 16) * DM + cl;
#pragma unroll
                for (int bj = 0; bj < 2; ++bj) { const u32x4 w = xw[m][bj];
                    const f32x4 v0 = (f32x4){bflo(w.x), bfhi(w.x), bflo(w.y), bfhi(w.y)} + gv[bj][0] * acc[ai][bj][m][0], v1 = (f32x4){bflo(w.z), bfhi(w.z), bflo(w.w), bfhi(w.w)} + gv[bj][1] * acc[ai][bj][m][1];
                    u32x4 o; o.x = cvt_pk_bf16(v0[0], v0[1]); o.y = cvt_pk_bf16(v0[2], v0[3]); o.z = cvt_pk_bf16(v1[0], v1[1]); o.w = cvt_pk_bf16(v1[2], v1[3]);
                    *(u32x4*)(rowp + bj * HALF) = o; } }
        }
    }
};
__device__ __forceinline__ float clamp8(float v) { return __builtin_amdgcn_fmed3f(v, -448.f, 448.f); }
__device__ __forceinline__ unsigned pk4_fp8(float a, float b, float c, float d) { int w = 0; a = clamp8(a); b = clamp8(b); c = clamp8(c); d = clamp8(d); w = __builtin_amdgcn_cvt_pk_fp8_f32(a, b, w, false); w = __builtin_amdgcn_cvt_pk_fp8_f32(c, d, w, true); return (unsigned)w; }
struct EpiGate8 {
    static constexpr bool PERM = true, KEEP = false;
    unsigned char* PG; float s;
    typedef float f32x2 __attribute__((ext_vector_type(2)));
    static __device__ __forceinline__ f32x2 q2(f32x2 a, f32x2 k1, f32x2 k2, f32x2 i255, f32x2 magic) {
        const f32x2 t = __builtin_elementwise_fma(a, k1, k2);
        f32x2 e; e.x = __builtin_amdgcn_exp2f(t.x); e.y = __builtin_amdgcn_exp2f(t.y);
        const f32x2 d = e + i255;
        f32x2 r; r.x = fmaxf(__builtin_amdgcn_rcpf(d.x), 1.f); r.y = fmaxf(__builtin_amdgcn_rcpf(d.y), 1.f);
        return r + magic;
    }
    static __device__ __forceinline__ unsigned pack4(f32x2 a, f32x2 b) {
        const unsigned lo = __builtin_amdgcn_perm(__float_as_uint(a.y), __float_as_uint(a.x), 0x0c0c0400u), hi = __builtin_amdgcn_perm(__float_as_uint(b.y), __float_as_uint(b.x), 0x0c0c0400u);
        return __builtin_amdgcn_perm(hi, lo, 0x05040100u);
    }
    __device__ __forceinline__ void operator()(f32x4 (&acc)[2][2][4][2], const Unit& u, int wr, int wc, int fr, int fq) const {
        const int row0 = u.row0 + wr * 64 + fr, cl = u.col0 + wc * 32 + 8 * fq;
        const float k1f = -s * 1.4426950408889634f;
        const f32x2 k1 = {k1f, k1f}, k2 = {-7.99435343685886f, -7.99435343685886f}, i255 = {1.f / 255.f, 1.f / 255.f}, magic = {8388608.f, 8388608.f};
#pragma unroll
        for (int ai = 0; ai < 2; ++ai)
#pragma unroll
            for (int m = 0; m < 4; ++m) { unsigned char* rowp = PG + (size_t)(row0 + ai * HALF + m * 16) * 3072 + cl;
#pragma unroll
                for (int bj = 0; bj < 2; ++bj) { const f32x4 v0 = acc[ai][bj][m][0], v1 = acc[ai][bj][m][1]; u32x2 w;
                    w.x = pack4(q2((f32x2){v0[0], v0[1]}, k1, k2, i255, magic), q2((f32x2){v0[2], v0[3]}, k1, k2, i255, magic));
                    w.y = pack4(q2((f32x2){v1[0], v1[1]}, k1, k2, i255, magic), q2((f32x2){v1[2], v1[3]}, k1, k2, i255, magic));
                    *(u32x2*)(rowp + bj * HALF) = w; } }
    }
};
struct EpiGU8 {
    static constexpr bool PERM = true, KEEP = false;
    unsigned char* H; float s, hs;
    typedef float f32x2 __attribute__((ext_vector_type(2)));
    static __device__ __forceinline__ f32x2 gu2(f32x2 g, f32x2 u, f32x2 ne, f32x2 nlc, f32x2 ic) {
        const f32x2 t = __builtin_elementwise_fma(g, ne, nlc);
        f32x2 e; e.x = __builtin_amdgcn_exp2f(t.x); e.y = __builtin_amdgcn_exp2f(t.y);
        const f32x2 d = e + ic;
        f32x2 r; r.x = __builtin_amdgcn_rcpf(d.x); r.y = __builtin_amdgcn_rcpf(d.y);
        return (g * u) * r;
    }
    __device__ __forceinline__ void operator()(f32x4 (&acc)[2][2][4][2], const Unit& u, int wr, int wc, int fr, int fq) const {
        const int row0 = u.row0 + wr * 64 + fr, hc = (u.col0 >> 1) + wc * 32 + 8 * fq;
        const float c = s * s * hs, nef = -s * 1.4426950408889634f, nlcf = -__builtin_log2f(c), icf = 1.f / c;
        const f32x2 ne = {nef, nef}, nlc = {nlcf, nlcf}, ic = {icf, icf};
#pragma unroll
        for (int ai = 0; ai < 2; ++ai)
#pragma unroll
            for (int m = 0; m < 4; ++m) { const f32x4 g0 = acc[ai][0][m][0], g1 = acc[ai][0][m][1], u0 = acc[ai][1][m][0], u1 = acc[ai][1][m][1]; u32x2 w;
                const f32x2 a0 = gu2((f32x2){g0[0], g0[1]}, (f32x2){u0[0], u0[1]}, ne, nlc, ic), a1 = gu2((f32x2){g0[2], g0[3]}, (f32x2){u0[2], u0[3]}, ne, nlc, ic);
                const f32x2 b0 = gu2((f32x2){g1[0], g1[1]}, (f32x2){u1[0], u1[1]}, ne, nlc, ic), b1 = gu2((f32x2){g1[2], g1[3]}, (f32x2){u1[2], u1[3]}, ne, nlc, ic);
                w.x = pk4_fp8(a0.x, a0.y, a1.x, a1.y); w.y = pk4_fp8(b0.x, b0.y, b1.x, b1.y);
                *(u32x2*)(H + (size_t)(row0 + ai * HALF + m * 16) * FF + hc) = w; }
    }
};
struct EpiDown {
    static constexpr bool PERM = true, KEEP = false;
    bf16_t* Y; float s;
    __device__ __forceinline__ void operator()(f32x4 (&acc)[2][2][4][2], const Unit& u, int wr, int wc, int fr, int fq) const {
        const int row0 = u.row0 + wr * 64 + fr, cl = u.col0 + wc * 32 + 8 * fq;
#pragma unroll
        for (int ai = 0; ai < 2; ++ai)
#pragma unroll
            for (int m = 0; m < 4; ++m) { bf16_t* rowp = Y + (size_t)(row0 + ai * HALF + m * 16) * DM + cl;
#pragma unroll
                for (int bj = 0; bj < 2; ++bj) { const f32x4 v0 = acc[ai][bj][m][0] * s, v1 = acc[ai][bj][m][1] * s; u32x4 w; w.x = cvt_pk_bf16(v0[0], v0[1]); w.y = cvt_pk_bf16(v0[2], v0[3]); w.z = cvt_pk_bf16(v1[0], v1[1]); w.w = cvt_pk_bf16(v1[2], v1[3]);
                    *(u32x4*)(rowp + bj * HALF) = w; } }
    }
};
}

__device__ __forceinline__ void st_adaln(KP p, unsigned char* lds) {
    float* sc = (float*)lds;
    float* red = sc + 9 * 1024;
    const int tid = ltid(), wid = tid >> 6, lane = tid & 63;
    __syncthreads();
    for (int i = tid; i < 9 * 1024; i += NTHREADS) { const int r = i >> 10, k = i & 1023; const float v = r < 8 ? p->in[I_C][r * 1024 + k] : p->in[I_CCTX][k]; sc[i] = siluf(v); }
    __syncthreads();
    for (int u = lbid(); u < NL * 96; u += lgrid()) {
        const int l = u / 96, n = (u % 96) * 64 + lane;
        const float* w = p->in[I_WADA] + (size_t)l * 1024 * 6144 + n;
        float a[9];
#pragma unroll
        for (int r = 0; r < 9; ++r) a[r] = 0.f;
#pragma unroll 16
        for (int k = wid * 128; k < wid * 128 + 128; ++k) {
            const float wv = w[(size_t)k * 6144];
#pragma unroll
            for (int r = 0; r < 9; ++r) a[r] += sc[r * 1024 + k] * wv;
        }
#pragma unroll
        for (int r = 0; r < 9; ++r) red[(wid * 9 + r) * 64 + lane] = a[r];
        __syncthreads();
        for (int i = tid; i < 9 * 64; i += NTHREADS) {
            const int r = i >> 6, c = i & 63; float s = 0.f;
#pragma unroll
            for (int w8 = 0; w8 < 8; ++w8) s += red[(w8 * 9 + r) * 64 + c];
            const int nn = (u % 96) * 64 + c;
            p->MOD[((size_t)l * 9 + r) * 6144 + nn] = s + p->in[I_BADA][l * 6144 + nn];
        }
        __syncthreads();
    }
}
template <class RowMap>
__device__ __forceinline__ void cvt_tile(float* tile, const float* src, int N, int k0, int n0, bf16_t* dst, int ldd, int koff, const RowMap& rm, float scale = 1.f) {
    const int tid = ltid();
    __syncthreads();
#pragma unroll
    for (int i = 0; i < 8; ++i) { const int idx = i * NTHREADS + tid, kk = idx >> 6, nn = idx & 63; tile[kk * 65 + nn] = (n0 + nn < N) ? src[(size_t)(k0 + kk) * N + n0 + nn] * scale : 0.f; }
    __syncthreads();
    const int nn = tid >> 3, kc = tid & 7; const int dr = rm(n0 + nn);
    if (n0 + nn < N && dr >= 0) {
        u32x4 w; const float* t = tile + (kc * 8) * 65 + nn;
        w.x = pack2(t[0], t[65]); w.y = pack2(t[130], t[195]); w.z = pack2(t[260], t[325]); w.w = pack2(t[390], t[455]);
        *(u32x4*)(dst + (size_t)dr * ldd + koff + k0 + kc * 8) = w;
    }
}
template <int KT, class RowMap>
__device__ __forceinline__ void cvt_tile8(float* tile, const float* src, int N, int k0, int n0, unsigned char* dst, int ldd, const RowMap& rm, float scale) {
    const int tid = ltid();
    __syncthreads();
#pragma unroll
    for (int i = 0; i < KT / 32; ++i) { const int idx = i * NTHREADS + tid, kk = idx >> 4, n4 = (idx & 15) * 4;
        const f32x4 v = (n0 + n4 < N) ? *(const f32x4*)(src + (size_t)(k0 + kk) * N + n0 + n4) : (f32x4){0.f, 0.f, 0.f, 0.f};
        float* t = tile + kk * 65 + n4; t[0] = v[0] * scale; t[1] = v[1] * scale; t[2] = v[2] * scale; t[3] = v[3] * scale; }
    __syncthreads();
    const int nn = tid >> 3, kc = tid & 7; const int dr = (n0 + nn < N) ? rm(n0 + nn) : -1;
    if (dr >= 0) {
#pragma unroll
        for (int h = 0; h < KT / 64; ++h) { u32x2 w; const float* t = tile + (h * 64 + kc * 8) * 65 + nn;
            w.x = pg8::pk4_fp8(t[0], t[65], t[130], t[195]); w.y = pg8::pk4_fp8(t[260], t[325], t[390], t[455]);
            *(u32x2*)(dst + (size_t)dr * ldd + k0 + h * 64 + kc * 8) = w; } }
}
__device__ __forceinline__ void store_row_fp8(unsigned char* dst, const f32x4 (&x)[4], int lane, float sc) {
#pragma unroll
    for (int i = 0; i < 4; ++i) *(unsigned*)(dst + lane * 4 + 256 * i) = pg8::pk4_fp8(x[i][0] * sc, x[i][1] * sc, x[i][2] * sc, x[i][3] * sc);
}
struct MapIn  { __device__ __forceinline__ int operator()(int n) const { return n < 1536 ? n : ((n < 1568 || n >= 2080) ? -1 : n + 224); } };
struct MapInG { __device__ __forceinline__ int operator()(int n) const { return n >= 2080 ? n - 2080 : -1; } };
struct MapId  { __device__ __forceinline__ int operator()(int n) const { return n; } };
struct MapGU  { int up; __device__ __forceinline__ int operator()(int n) const { return (n >> 7) * 256 + up * 128 + (n & 127); } };
constexpr int CV_IN = 16 * 81, CV_WB = 3 * 64, CV_OUT = 256, CV_G = 16 * 128, CV_D = 16 * 128, CV_LAYER = CV_IN + CV_WB + CV_OUT + 2 * CV_G + CV_D;
__device__ __forceinline__ void st_convert(KP p, unsigned char* lds, int l_lo, int l_hi) {
    float* tile = (float*)lds;
    for (int u = l_lo * CV_LAYER + lbid(); u < l_hi * CV_LAYER; u += lgrid()) {
        const int l = u / CV_LAYER; int r = u % CV_LAYER;
        if (r < CV_IN) { const int nt_ = r % 81;
            if (nt_ <= 32) cvt_tile(tile, p->in[I_WIN] + (size_t)l * DM * INC, INC, (r / 81) * 64, nt_ * 64, p->WIN + (size_t)l * PC * DM, DM, 0, MapIn(), nt_ < 4 ? 0.125f * 1.4426950408889634f : 1.f);
            if (nt_ >= 32) cvt_tile8<64>(tile, p->in[I_WIN] + (size_t)l * DM * INC, INC, (r / 81) * 64, nt_ * 64, p->WING8 + (size_t)l * 3072 * DM, DM, MapInG(), S8_W);
            continue; }
        r -= CV_IN;
        if (r < CV_WB) { const int br = r / 64, t = r % 64; cvt_tile(tile, p->in[I_WBA + br] + (size_t)l * 256 * DM, DM, (t / 16) * 64, (t % 16) * 64, p->WB + (size_t)l * DM * 768, 768, br * 256, MapId()); continue; }
        r -= CV_WB;
        if (r < CV_OUT) { cvt_tile(tile, p->in[I_WOUT] + (size_t)l * DM * DM, DM, (r / 16) * 64, (r % 16) * 64, p->WOUT + (size_t)l * DM * DM, DM, 0, MapId()); continue; }
        r -= CV_OUT;
        if (r < 2 * CV_G) { const int up = r / CV_G, rr = r % CV_G, e = rr / 128, t = rr % 128;
            cvt_tile8<256>(tile, p->in[up ? I_WEU : I_WEG] + ((size_t)l * NE + e) * DM * FF, FF, (t / 32) * 256, (t % 32) * 64, p->WGU + ((size_t)l * NE + e) * 2 * FF * DM, DM, MapGU{up}, S8_W); continue; }
        r -= 2 * CV_G;
        { const int e = r / 128, t = r % 128; cvt_tile8<256>(tile, p->in[I_WED] + ((size_t)l * NE + e) * FF * DM, DM, (t / 16) * 256, (t % 16) * 64, p->WD + ((size_t)l * NE + e) * DM * FF, FF, MapId(), S8_W); }
    }
}
__device__ __forceinline__ void st_fold(KP p) {
    for (int i = lbid() * NTHREADS + ltid(); i < NL * 256 * DM; i += lgrid() * NTHREADS) {
        const int l = i / (256 * DM), r = i % (256 * DM), nn = r / DM, k = r % DM, dir = nn >> 7, n = nn & 127;
        const float* wi = p->in[I_WIN] + ((size_t)l * DM + k) * INC + 1536 + dir * 16;
        const float* wg = p->in[dir ? I_WGB : I_WGF] + (size_t)l * 16 * 128 + n;
        float s = 0.f;
#pragma unroll
        for (int j = 0; j < 16; ++j) s += wi[j] * wg[j * 128];
        p->WIN[((size_t)l * PC + C_G + nn) * DM + k] = f2bf(s);
    }
}
__device__ __forceinline__ void norm_mod_row(f32x4 (&x)[4], const float* g, const float* sh, const float* sc, int lane) {
    float ss = 0.f;
#pragma unroll
    for (int i = 0; i < 4; ++i) ss += x[i][0] * x[i][0] + x[i][1] * x[i][1] + x[i][2] * x[i][2] + x[i][3] * x[i][3];
    ss = wave_sum(ss);
    const float rs = rsqrtf(ss * (1.f / DM) + EPS);
#pragma unroll
    for (int i = 0; i < 4; ++i) {
        const int c = lane * 4 + 256 * i;
        const f32x4 gv = *(const f32x4*)(g + c), sv = *(const f32x4*)(sh + c), cv = *(const f32x4*)(sc + c);
        x[i] = (x[i] * rs) * gv * (cv + 1.f) + sv;
    }
}
__device__ __forceinline__ void store_row_bf16(bf16_t* dst, const f32x4 (&x)[4], int lane) {
#pragma unroll
    for (int i = 0; i < 4; ++i) { u32x2 w; w.x = pack2(x[i][0], x[i][1]); w.y = pack2(x[i][2], x[i][3]); *(u32x2*)(dst + lane * 4 + 256 * i) = w; }
}
__device__ __forceinline__ f32x4 xrow4(const bf16_t* rowp, int lane, int i) { const u32x2 w = *(const u32x2*)(rowp + lane * 4 + 256 * i); return (f32x4){bflo(w.x), bfhi(w.x), bflo(w.y), bfhi(w.y)}; }
__device__ __forceinline__ void store_row_fp8(unsigned char* dst, const f32x4 (&x)[4], int lane, float sc);
__device__ __forceinline__ void st_norm1(KP p, int l) {
    const int wid = ltid() >> 6, lane = ltid() & 63;
    const float* mod = p->MOD + (size_t)l * 9 * 6144; const float* g = p->in[I_N1G] + l * DM;
    for (int R = lbid() * 8 + wid; R < MT; R += lgrid() * 8) {
        const float* src = R < NLAT ? p->in[I_X] + (size_t)R * DM : p->in[I_CTX] + (size_t)(R - NLAT) * DM;
        f32x4 x[4];
#pragma unroll
        for (int i = 0; i < 4; ++i) x[i] = *(const f32x4*)(src + lane * 4 + 256 * i);
        store_row_bf16(p->X + (size_t)R * DM, x, lane);
        const float* m = mod + mod_row(R) * 6144;
        norm_mod_row(x, g, m, m + 1024, lane);
        store_row_bf16(p->U + (size_t)R * DM, x, lane);
        store_row_fp8(p->U8W + (size_t)R * DM, x, lane, S8_U);
    }
}

__device__ __forceinline__ void st_qkrope(KP p, int l, unsigned char* lds) {
    float* tab = (float*)lds;
    const int tid = ltid(), wid = tid >> 6, lane = tid & 63;
    __syncthreads();
    for (int i = tid; i < 1024; i += NTHREADS) { const int pos = i >> 4, f = i & 15; const float inv = powf(10000.f, -(float)f / 16.f); const float a = (float)pos * inv; tab[i] = cosf(a); tab[1024 + i] = sinf(a); }
    __syncthreads();
    const float qg = p->in[I_QNG][l * 64 + lane] * (0.125f * 1.4426950408889634f), kg = p->in[I_KNG][l * 64 + lane];
    const int f = lane & 15;
    const int stride = lgrid() * 8;
    for (int R0 = lbid() * 8 + wid; R0 < MT; R0 += 2 * stride) {
        const int R1 = R0 + stride; const bool has1 = R1 < MT;
        bf16_t* p0 = p->P + (size_t)R0 * PC + C_QC + lane; bf16_t* p1 = p->P + (size_t)(has1 ? R1 : R0) * PC + C_QC + lane;
        float v0[6], v1[6];
#pragma unroll
        for (int j = 0; j < 6; ++j) { v0[j] = bf2f(p0[j * 64]); v1[j] = bf2f(p1[j * 64]); }
#pragma unroll
        for (int rr = 0; rr < 2; ++rr) {
            const int R = rr ? R1 : R0; if (rr && !has1) break;
            bf16_t* pp = rr ? p1 : p0;
#pragma unroll
            for (int j = 0; j < 6; ++j) {
                float v = rr ? v1[j] : v0[j];
                const float ss = wave_sum(v * v);
                v = v * rsqrtf(ss * (1.f / 64.f) + EPS) * (j < 4 ? qg : kg);
                if (R < NLAT) {
                    const int t = R & (TL - 1), pos = (lane < 32) ? (t >> 6) : (t & 63);
                    const float other = __shfl_xor(v, 16);
                    const float c = tab[pos * 16 + f], sn = tab[1024 + pos * 16 + f];
                    v = (lane & 16) ? (v * c + other * sn) : (v * c - other * sn);
                }
                pp[j * 64] = f2bf(v);
            }
        }
    }
}

namespace att {
typedef float f32x16 __attribute__((ext_vector_type(16)));
typedef short s16x4 __attribute__((ext_vector_type(4)));
constexpr int NSLOT = 3, SLOTB = 8192;
constexpr int LDS_K = 0, LDS_V = NSLOT * SLOTB, LDS_WS = 2 * NSLOT * SLOTB, LDS_OST = LDS_WS + 8 * 64 * 4, LDS_BIAS = LDS_OST + 8 * 4096, LDS_TOTAL = LDS_BIAS + 16 * 32 * 4;
constexpr float C2 = 0.125f * 1.4426950408889634f;
constexpr float LOG2E = 1.4426950408889634f;
constexpr float THR = 8.f;
__device__ __forceinline__ int crow(int r, int hi) { return (r & 3) + 8 * (r >> 2) + 4 * hi; }
__device__ __forceinline__ void glds16(const void* gsrc, unsigned lds_dst) { unsigned keep;
    asm volatile("s_mov_b32 %0, m0\n\ts_mov_b32 m0, %2\n\ts_nop 0\n\tglobal_load_lds_dwordx4 %1, off\n\ts_mov_b32 m0, %0" : "=&s"(keep) : "v"(gsrc), "s"(lds_dst) : "memory"); }
__device__ __forceinline__ unsigned cvtpk(float lo, float hi) { unsigned r; asm volatile("v_cvt_pk_bf16_f32 %0, %1, %2" : "=v"(r) : "v"(lo), "v"(hi)); return r; }
#define ATT_WAIT_BAR(N) asm volatile("s_waitcnt vmcnt(" #N ") lgkmcnt(0)\n\ts_barrier" ::: "memory")
__device__ __forceinline__ void qkt(f32x16& p0, f32x16& p1, const LAS unsigned char* Kslot, const bf16x8* qr, const f32x16& negm, int r32, int hi) {
    const unsigned ka = (unsigned)(uintptr_t)(Kslot + hi * 1024 + r32 * 16);
    bf16x8 b[8];
#pragma unroll
    for (int i = 0; i < 8; ++i) asm volatile("ds_read_b128 %0, %1 offset:%c2" : "=&v"(b[i]) : "v"(ka), "i"((i >> 1) * 2048 + (i & 1) * 512) : "memory");
    asm volatile("s_waitcnt lgkmcnt(6)" ::: "memory"); __builtin_amdgcn_sched_barrier(0);
    p0 = __builtin_amdgcn_mfma_f32_32x32x16_bf16(b[0], qr[0], negm, 0, 0, 0); p1 = __builtin_amdgcn_mfma_f32_32x32x16_bf16(b[1], qr[0], negm, 0, 0, 0);
    asm volatile("s_waitcnt lgkmcnt(4)" ::: "memory"); __builtin_amdgcn_sched_barrier(0);
    p0 = __builtin_amdgcn_mfma_f32_32x32x16_bf16(b[2], qr[1], p0, 0, 0, 0); p1 = __builtin_amdgcn_mfma_f32_32x32x16_bf16(b[3], qr[1], p1, 0, 0, 0);
    asm volatile("s_waitcnt lgkmcnt(2)" ::: "memory"); __builtin_amdgcn_sched_barrier(0);
    p0 = __builtin_amdgcn_mfma_f32_32x32x16_bf16(b[4], qr[2], p0, 0, 0, 0); p1 = __builtin_amdgcn_mfma_f32_32x32x16_bf16(b[5], qr[2], p1, 0, 0, 0);
    asm volatile("s_waitcnt lgkmcnt(0)" ::: "memory"); __builtin_amdgcn_sched_barrier(0);
    p0 = __builtin_amdgcn_mfma_f32_32x32x16_bf16(b[6], qr[3], p0, 0, 0, 0); p1 = __builtin_amdgcn_mfma_f32_32x32x16_bf16(b[7], qr[3], p1, 0, 0, 0);
}
__device__ __forceinline__ float rowmax(const f32x16& p0, const f32x16& p1) {
    float a = fmaxf(fmaxf(p0[0], p0[1]), p1[0]), b = fmaxf(fmaxf(p0[2], p0[3]), p1[1]); a = fmaxf(fmaxf(a, p1[2]), p1[3]);
#pragma unroll
    for (int r = 4; r < 16; r += 4) { a = fmaxf(fmaxf(a, p0[r]), p0[r + 1]); b = fmaxf(fmaxf(b, p0[r + 2]), p0[r + 3]); a = fmaxf(fmaxf(a, p1[r]), p1[r + 1]); b = fmaxf(fmaxf(b, p1[r + 2]), p1[r + 3]); }
    const float m = fmaxf(a, b);
    auto rr = __builtin_amdgcn_permlane32_swap(__float_as_uint(m), __float_as_uint(m), false, false);
    return fmaxf(__uint_as_float(rr[0]), __uint_as_float(rr[1]));
}
__device__ __forceinline__ void pv(f32x16* o, int vb, bf16x8 pa0, bf16x8 pa1, bf16x8 pa2, bf16x8 pa3) {
#pragma unroll
    for (int d0 = 0; d0 < 2; ++d0) { s16x4 lo[4], hi[4];
#pragma unroll
        for (int ks = 0; ks < 4; ++ks) {
            asm volatile("ds_read_b64_tr_b16 %0,%1 offset:%c2" : "=&v"(lo[ks]) : "v"(vb), "i"(d0 * 4096 + ks * 1024) : "memory");
            asm volatile("ds_read_b64_tr_b16 %0,%1 offset:%c2" : "=&v"(hi[ks]) : "v"(vb), "i"(d0 * 4096 + ks * 1024 + 512) : "memory"); }
        asm volatile("s_waitcnt lgkmcnt(0)" ::: "memory"); __builtin_amdgcn_sched_barrier(0);
#define ATT_PK(k) (bf16x8){lo[k][0], lo[k][1], lo[k][2], lo[k][3], hi[k][0], hi[k][1], hi[k][2], hi[k][3]}
        o[d0] = __builtin_amdgcn_mfma_f32_32x32x16_bf16(pa0, ATT_PK(0), o[d0], 0, 0, 0);
        o[d0] = __builtin_amdgcn_mfma_f32_32x32x16_bf16(pa1, ATT_PK(1), o[d0], 0, 0, 0);
        o[d0] = __builtin_amdgcn_mfma_f32_32x32x16_bf16(pa2, ATT_PK(2), o[d0], 0, 0, 0);
        o[d0] = __builtin_amdgcn_mfma_f32_32x32x16_bf16(pa3, ATT_PK(3), o[d0], 0, 0, 0);
#undef ATT_PK
    }
}
struct Desc {
    const bf16_t* Q;
    const bf16_t* KV;
    bf16_t* O;
    int kcol, vcol;
    int NT;
    int ctx_row0;
    int lat_row0;
    int rlo;
    int qrow;
};
template <int MODE>
__device__ __forceinline__ void attn_unit(const Desc& D, LAS unsigned char* shm) {
    const int tid = ltid(), lane = tid & 63, r32 = lane & 31, hi = lane >> 5; const int wid = __builtin_amdgcn_readfirstlane(tid >> 6);
    const unsigned lds0 = (unsigned)(uintptr_t)shm;
    LAS float* wsf = (LAS float*)(shm + LDS_WS) + wid * 64;
    const bf16_t* Qw = D.Q + (size_t)(wid * 32) * PC;
    bf16x8 qr[4];
#pragma unroll
    for (int d0 = 0; d0 < 4; ++d0) qr[d0] = *(const bf16x8*)(Qw + (size_t)r32 * PC + d0 * 16 + hi * 8);
    const bf16_t* kbase = D.KV + D.kcol + wid * 8 + (size_t)lane * PC;
    const bf16_t* vbase = D.KV + D.vcol + (wid >> 2) * 32 + (lane & 3) * 8 + (size_t)(16 * (wid & 3) + (lane >> 2)) * PC;
    const unsigned kdst = lds0 + LDS_K + wid * 1024, vdst = lds0 + LDS_V + wid * 1024;
    const int NT = D.NT;
#define ATT_TROW(t) ((t) < 4 ? D.ctx_row0 + 64 * (t) : D.lat_row0 + 64 * ((t) - 4))
#define ATT_DMA(t, slotoff) do { const int t_ = (t) < NT ? (t) : NT - 1; const size_t ro_ = (size_t)ATT_TROW(t_) * PC; \
        glds16(kbase + ro_, (unsigned)__builtin_amdgcn_readfirstlane(kdst + (slotoff))); glds16(vbase + ro_, (unsigned)__builtin_amdgcn_readfirstlane(vdst + (slotoff))); } while (0)
    ATT_DMA(0, 0); ATT_DMA(1, SLOTB);
    const int vb0 = (int)(lds0 + LDS_V) + ((lane >> 4) & 1) * 32 + (lane & 3) * 8 + (4 * hi + ((lane & 15) >> 2)) * 64;
    float mhat = 0.f, l_reg = 0.f; f32x16 o[2]; o[0] = f32x16{}; o[1] = f32x16{}; f32x16 negm = f32x16{};
    const int rq = D.qrow + (wid >> 1), cq = (wid & 1) * 32 + r32;
    const int rs = min(max(rq - 4, 0), 56), cs = min(max(cq - 8, 0), 48);
    const int L0 = 4 * hi - cq + 15, L1 = 4 * hi - cs;
    const LAS float* btab = (const LAS float*)(shm + LDS_BIAS);
    int slot = 0;
    for (int t = 0; t < NT; ++t) {
        ATT_WAIT_BAR(2);
        { const int s2 = slot == 0 ? 2 * SLOTB : slot - SLOTB; ATT_DMA(t + 2, s2); }
        bool active = true; int kr = 0;
        if (MODE == 1 && t >= 4) { kr = D.rlo + (t - 4); active = (kr >= rs) && (kr < rs + 8); }
        if (active) {
            f32x16 p0, p1;
            qkt(p0, p1, shm + LDS_K + slot, qr, negm, r32, hi);
            if (MODE == 1 && t >= 4) {
                const LAS float* brow = btab + (kr - rq + 7) * 32;
#pragma unroll
                for (int r = 0; r < 16; ++r) { const int kc = (r & 3) + 8 * (r >> 2);
                    { const int ix = L0 + kc, iv = L1 + kc; const float bv = brow[min(max(ix, 0), 30)]; p0[r] = ((unsigned)iv < 16u) ? p0[r] + bv : -INFINITY; }
                    { const int ix = L0 + kc + 32, iv = L1 + kc + 32; const float bv = brow[min(max(ix, 0), 30)]; p1[r] = ((unsigned)iv < 16u) ? p1[r] + bv : -INFINITY; } }
            }
            const float rm = rowmax(p0, p1);
            bool resc = false;
            if (t == 0) { mhat = rm;
#pragma unroll
                for (int r = 0; r < 16; ++r) { p0[r] -= rm; p1[r] -= rm; negm[r] = -mhat; }
            } else if (__any(rm > THR)) { const float dl = fmaxf(rm, 0.f); mhat += dl;
#pragma unroll
                for (int r = 0; r < 16; ++r) { p0[r] -= dl; p1[r] -= dl; negm[r] = -mhat; }
                const float f = __builtin_amdgcn_exp2f(-dl); l_reg *= f; if (hi == 0) wsf[r32] = f; resc = true; }
            float sacc = 0.f;
#pragma unroll
            for (int r = 0; r < 16; ++r) { p0[r] = __builtin_amdgcn_exp2f(p0[r]); p1[r] = __builtin_amdgcn_exp2f(p1[r]); sacc += p0[r] + p1[r]; }
            l_reg += sacc;
            u32x4 pw0, pw1, pw2, pw3;
            pw0 = (u32x4){cvtpk(p0[0], p0[1]), cvtpk(p0[2], p0[3]), cvtpk(p0[4], p0[5]), cvtpk(p0[6], p0[7])};
            pw1 = (u32x4){cvtpk(p0[8], p0[9]), cvtpk(p0[10], p0[11]), cvtpk(p0[12], p0[13]), cvtpk(p0[14], p0[15])};
            pw2 = (u32x4){cvtpk(p1[0], p1[1]), cvtpk(p1[2], p1[3]), cvtpk(p1[4], p1[5]), cvtpk(p1[6], p1[7])};
            pw3 = (u32x4){cvtpk(p1[8], p1[9]), cvtpk(p1[10], p1[11]), cvtpk(p1[12], p1[13]), cvtpk(p1[14], p1[15])};
            if (resc) { asm volatile("s_waitcnt lgkmcnt(0)" ::: "memory");
#pragma unroll
                for (int r = 0; r < 16; ++r) { const float f = wsf[crow(r, hi)]; o[0][r] *= f; o[1][r] *= f; } }
            __builtin_amdgcn_sched_barrier(0);
            pv(o, vb0 + slot, __builtin_bit_cast(bf16x8, pw0), __builtin_bit_cast(bf16x8, pw1), __builtin_bit_cast(bf16x8, pw2), __builtin_bit_cast(bf16x8, pw3));
        }
        slot = slot == 2 * SLOTB ? 0 : slot + SLOTB;
    }
    { auto rr = __builtin_amdgcn_permlane32_swap(__float_as_uint(l_reg), __float_as_uint(l_reg), false, false); l_reg = __uint_as_float(rr[0]) + __uint_as_float(rr[1]); }
    if (hi == 0) wsf[32 + r32] = l_reg;
    asm volatile("s_waitcnt lgkmcnt(0)" ::: "memory");
    float rli[16];
#pragma unroll
    for (int r = 0; r < 16; ++r) rli[r] = __builtin_amdgcn_rcpf(wsf[32 + crow(r, hi)]);
    bf16_t* Ow = D.O + (size_t)(wid * 32) * 768;
    { LAS bf16_t* stg = (LAS bf16_t*)(shm + LDS_OST) + wid * 2048;
#pragma unroll
      for (int r = 0; r < 16; ++r) { const int orow = crow(r, hi);
#pragma unroll
          for (int d0 = 0; d0 < 2; ++d0) stg[orow * 64 + d0 * 32 + r32] = f2bf(o[d0][r] * rli[r]); }
      asm volatile("s_waitcnt lgkmcnt(0)" ::: "memory");
#pragma unroll
      for (int i = 0; i < 4; ++i) { const int row = i * 8 + (lane >> 3), ch = lane & 7; const u32x4 v = *(const LAS u32x4*)(stg + row * 64 + ch * 8); *(u32x4*)(Ow + (size_t)row * 768 + ch * 8) = v; } }
    asm volatile("s_waitcnt vmcnt(0) lgkmcnt(0)\n\ts_barrier" ::: "memory");
#undef ATT_TROW
#undef ATT_DMA
}

typedef const LAS char* lds_cptr;
typedef short v4i16_t __attribute__((ext_vector_type(4)));
__device__ __forceinline__ void kload2(bf16x8* kf, lds_cptr kp, int d0) { kf[2 * d0] = *(const LAS bf16x8*)(kp + d0 * 2048); kf[2 * d0 + 1] = *(const LAS bf16x8*)(kp + d0 * 2048 + 512); }
__device__ __forceinline__ s16x4 vtr(lds_cptr p) { return __builtin_bit_cast(s16x4, __builtin_amdgcn_ds_read_tr16_b64_v4i16((LAS v4i16_t*)p)); }
#define SBAR() __builtin_amdgcn_sched_barrier(0)
#define PIN(x) asm volatile("" : "+v"(x))
#define MFMA(a, b, c) __builtin_amdgcn_mfma_f32_32x32x16_bf16(a, b, c, 0, 0, 0)
__device__ __forceinline__ void attn_unit_pipe(const Desc& D, LAS unsigned char* shm) {
    const int tid = ltid(), lane = tid & 63, r32 = lane & 31, hi = lane >> 5; const int wid = __builtin_amdgcn_readfirstlane(tid >> 6);
    const unsigned lds0 = (unsigned)(uintptr_t)shm;
    LAS float* wsf = (LAS float*)(shm + LDS_WS) + wid * 64;
    const bf16_t* Qw = D.Q + (size_t)(wid * 32) * PC;
    const int NT = D.NT;
    const bf16_t* ksrc = D.KV + D.kcol + wid * 8 + (size_t)lane * PC;
    const bf16_t* vsrc = D.KV + D.vcol + (wid >> 2) * 32 + (lane & 3) * 8 + (size_t)(16 * (wid & 3) + (lane >> 2)) * PC;
    const unsigned kdst = lds0 + LDS_K + wid * 1024, vdst = lds0 + LDS_V + wid * 1024;
#define TROW(t) ((t) < 4 ? D.ctx_row0 + 64 * (t) : D.lat_row0 + 64 * ((t) - 4))
#define DMA_K(t, slot) glds16(ksrc + (size_t)TROW(t) * PC, (unsigned)__builtin_amdgcn_readfirstlane(kdst + (slot)))
#define DMA_V(t, slot) glds16(vsrc + (size_t)TROW(t) * PC, (unsigned)__builtin_amdgcn_readfirstlane(vdst + (slot)))
    const lds_cptr vp0 = (lds_cptr)shm + LDS_V + ((lane >> 4) & 1) * 32 + (lane & 3) * 8 + (4 * hi + ((lane & 15) >> 2)) * 64;
    const lds_cptr kp0 = (lds_cptr)shm + LDS_K + hi * 1024 + r32 * 16;
    DMA_K(0, 0); DMA_V(0, 0); DMA_K(1, SLOTB);
    bf16x8 qr[4];
#pragma unroll
    for (int d0 = 0; d0 < 4; ++d0) qr[d0] = *(const bf16x8*)(Qw + (size_t)r32 * PC + d0 * 16 + hi * 8);
    float mhat = 0.f, l_reg = 0.f; f32x16 o[2]; o[0] = f32x16{}; o[1] = f32x16{};
    f32x16 negm = f32x16{}; PIN(negm);
    bool resc = false;
    f32x16 pA0, pA1, pB0, pB1; bf16x8 kf[8]; s16x4 vlo[8], vhi[8]; u32x4 pw0, pw1, pw2, pw3;
    int sl_prev = 0, sl_cur = 0, sl_next = SLOTB;
#define ROT() do { sl_prev = sl_cur; sl_cur = sl_next; sl_next = (sl_next == 2 * SLOTB) ? 0 : sl_next + SLOTB; } while (0)
#define EX(v) __builtin_amdgcn_exp2f(v)
#define RESC() do { if (resc) { _Pragma("unroll") for (int d_ = 0; d_ < 2; ++d_) _Pragma("unroll") for (int r = 0; r < 16; ++r) o[d_][r] *= wsf[crow(r, hi)]; } } while (0)
    DMA_K(2, 2 * SLOTB);
    ATT_WAIT_BAR(3);
    _Pragma("unroll") for (int d0 = 0; d0 < 4; ++d0) kload2(kf, kp0, d0);
    pA0 = MFMA(kf[0], qr[0], negm); pA1 = MFMA(kf[1], qr[0], negm); pA0 = MFMA(kf[2], qr[1], pA0); pA1 = MFMA(kf[3], qr[1], pA1);
    pA0 = MFMA(kf[4], qr[2], pA0); pA1 = MFMA(kf[5], qr[2], pA1); pA0 = MFMA(kf[6], qr[3], pA0); pA1 = MFMA(kf[7], qr[3], pA1);
    { const float rm = rowmax(pA0, pA1); mhat = rm;
#pragma unroll
      for (int r = 0; r < 16; ++r) { pA0[r] = EX(pA0[r] - rm); pA1[r] = EX(pA1[r] - rm); negm[r] = -mhat; } }
    ATT_WAIT_BAR(0);
    DMA_K(3, 0); DMA_V(1, SLOTB); ROT();
    _Pragma("unroll") for (int d0 = 0; d0 < 4; ++d0) kload2(kf, kp0 + sl_cur, d0);
    ATT_WAIT_BAR(2);
#define PKW(P, i) cvtpk(P[i], P[i + 1])
#define PAF(k) __builtin_bit_cast(bf16x8, pw##k)
#define VFR(i) (bf16x8){vlo[i][0], vlo[i][1], vlo[i][2], vlo[i][3], vhi[i][0], vhi[i][1], vhi[i][2], vhi[i][3]}
#define VRD(i) do { vlo[i] = vtr(vp_ + (((i) >> 2) * 4096 + ((i) & 3) * 1024)); vhi[i] = vtr(vp_ + (((i) >> 2) * 4096 + ((i) & 3) * 1024 + 512)); } while (0)
#define KRD(G, d0) do { if (G) { kload2(kf, kp0 + sl_next, d0); SBAR(); } } while (0)
#define GAPA(MF, a0, a1, a2, a3, W0, W1, PW) do { MF; sacc += a0; sacc += a1; sacc += a2; sacc += a3; W0; W1; PIN(PW); PIN(sacc); SBAR(); } while (0)
#define GAPB(MF, X, i) do { MF; X[i] = EX(X[i]); X[i + 1] = EX(X[i + 1]); X[i + 2] = EX(X[i + 2]); X[i + 3] = EX(X[i + 3]); PIN(X); SBAR(); } while (0)
#define STEP(C0, C1, P0, P1, t, GK, GV, GL) do { SBAR(); \
    const lds_cptr vp_ = vp0 + sl_prev; \
    VRD(0); SBAR(); float sacc = P0[0] + P0[1]; \
                    GAPA(C0 = MFMA(kf[0], qr[0], negm), P0[2], P0[3], P0[4], P0[5],     pw0[0] = PKW(P0, 0),  pw0[1] = PKW(P0, 2),  pw0); \
    VRD(4); SBAR(); GAPA(C1 = MFMA(kf[1], qr[0], negm), P0[6], P0[7], P0[8], P0[9],     pw0[2] = PKW(P0, 4),  pw0[3] = PKW(P0, 6),  pw0); \
    VRD(1); SBAR(); GAPA(C0 = MFMA(kf[2], qr[1], C0),    P0[10], P0[11], P0[12], P0[13], pw1[0] = PKW(P0, 8),  pw1[1] = PKW(P0, 10), pw1); \
    VRD(5); SBAR(); GAPA(C1 = MFMA(kf[3], qr[1], C1),    P0[14], P0[15], P1[0], P1[1],   pw1[2] = PKW(P0, 12), pw1[3] = PKW(P0, 14), pw1); \
    VRD(2); SBAR(); GAPA(C0 = MFMA(kf[4], qr[2], C0),    P1[2], P1[3], P1[4], P1[5],     pw2[0] = PKW(P1, 0),  pw2[1] = PKW(P1, 2),  pw2); \
    VRD(6); SBAR(); GAPA(C1 = MFMA(kf[5], qr[2], C1),    P1[6], P1[7], P1[8], P1[9],     pw2[2] = PKW(P1, 4),  pw2[3] = PKW(P1, 6),  pw2); \
    VRD(3); SBAR(); GAPA(C0 = MFMA(kf[6], qr[3], C0),    P1[10], P1[11], P1[12], P1[13], pw3[0] = PKW(P1, 8),  pw3[1] = PKW(P1, 10), pw3); \
    VRD(7); SBAR(); GAPA(C1 = MFMA(kf[7], qr[3], C1),    P1[14], P1[15], 0.f, 0.f,       pw3[2] = PKW(P1, 12), pw3[3] = PKW(P1, 14), pw3); \
    l_reg += sacc; \
    if (GK) DMA_K((t) + 3, sl_cur); if (GV) DMA_V((t) + 1, sl_next); \
    { const float rm = rowmax(C0, C1); resc = false;                        \
      if (__builtin_expect(__any(rm > THR), 0)) { const float dl = fmaxf(rm, 0.f); mhat += dl; \
          _Pragma("unroll") for (int r = 0; r < 16; ++r) { C0[r] -= dl; C1[r] -= dl; negm[r] = -mhat; } \
          const float f = __builtin_amdgcn_exp2f(-dl); l_reg *= f; if (hi == 0) wsf[r32] = f; resc = true; } } \
    SBAR(); \
    GAPB(o[0] = MFMA(PAF(0), VFR(0), o[0]), C0, 0);              GAPB(o[1] = MFMA(PAF(0), VFR(4), o[1]), C0, 4); \
    KRD(GL, 0); GAPB(o[0] = MFMA(PAF(1), VFR(1), o[0]), C0, 8);  KRD(GL, 1); GAPB(o[1] = MFMA(PAF(1), VFR(5), o[1]), C0, 12); \
    KRD(GL, 2); GAPB(o[0] = MFMA(PAF(2), VFR(2), o[0]), C1, 0);  KRD(GL, 3); GAPB(o[1] = MFMA(PAF(2), VFR(6), o[1]), C1, 4); \
    GAPB(o[0] = MFMA(PAF(3), VFR(3), o[0]), C1, 8);              GAPB(o[1] = MFMA(PAF(3), VFR(7), o[1]), C1, 12); \
    } while (0)
    int t = 1;
    for (; t + 5 < NT; t += 2) {
        STEP(pB0, pB1, pA0, pA1, t, true, true, true);     ATT_WAIT_BAR(2); RESC(); ROT();
        STEP(pA0, pA1, pB0, pB1, t + 1, true, true, true); ATT_WAIT_BAR(2); RESC(); ROT();
    }
#define ENDW(tt) do { if ((tt) + 3 < NT) { ATT_WAIT_BAR(2); } else if ((tt) + 2 < NT) { ATT_WAIT_BAR(1); } else { ATT_WAIT_BAR(0); } } while (0)
    for (; t + 1 < NT; t += 2) {
        STEP(pB0, pB1, pA0, pA1, t, (t + 3 < NT), (t + 1 < NT), (t + 1 < NT));         ENDW(t);     RESC(); ROT();
        STEP(pA0, pA1, pB0, pB1, t + 1, (t + 4 < NT), (t + 2 < NT), (t + 2 < NT));     ENDW(t + 1); RESC(); ROT();
    }
    STEP(pB0, pB1, pA0, pA1, NT - 1, false, false, false); RESC();
    { float sacc = pB0[0] + pB0[1];
#pragma unroll
      for (int r = 2; r < 16; ++r) sacc += pB0[r];
#pragma unroll
      for (int r = 0; r < 16; ++r) sacc += pB1[r];
      l_reg += sacc;
      pw0 = (u32x4){PKW(pB0, 0), PKW(pB0, 2), PKW(pB0, 4), PKW(pB0, 6)}; pw1 = (u32x4){PKW(pB0, 8), PKW(pB0, 10), PKW(pB0, 12), PKW(pB0, 14)};
      pw2 = (u32x4){PKW(pB1, 0), PKW(pB1, 2), PKW(pB1, 4), PKW(pB1, 6)}; pw3 = (u32x4){PKW(pB1, 8), PKW(pB1, 10), PKW(pB1, 12), PKW(pB1, 14)};
      const lds_cptr vp_ = vp0 + sl_cur; _Pragma("unroll") for (int i = 0; i < 8; ++i) VRD(i);
      o[0] = MFMA(PAF(0), VFR(0), o[0]); o[1] = MFMA(PAF(0), VFR(4), o[1]); o[0] = MFMA(PAF(1), VFR(1), o[0]); o[1] = MFMA(PAF(1), VFR(5), o[1]);
      o[0] = MFMA(PAF(2), VFR(2), o[0]); o[1] = MFMA(PAF(2), VFR(6), o[1]); o[0] = MFMA(PAF(3), VFR(3), o[0]); o[1] = MFMA(PAF(3), VFR(7), o[1]); }
    { auto rr = __builtin_amdgcn_permlane32_swap(__float_as_uint(l_reg), __float_as_uint(l_reg), false, false); l_reg = __uint_as_float(rr[0]) + __uint_as_float(rr[1]); }
    if (hi == 0) wsf[32 + r32] = l_reg;
    asm volatile("s_waitcnt lgkmcnt(0)" ::: "memory");
    float rli[16];
#pragma unroll
    for (int r = 0; r < 16; ++r) rli[r] = __builtin_amdgcn_rcpf(wsf[32 + crow(r, hi)]);
    bf16_t* Ow = D.O + (size_t)(wid * 32) * 768;
    { LAS bf16_t* stg = (LAS bf16_t*)(shm + LDS_OST) + wid * 2048;
#pragma unroll
      for (int r = 0; r < 16; ++r) { const int orow = crow(r, hi);
#pragma unroll
          for (int d0 = 0; d0 < 2; ++d0) stg[orow * 64 + d0 * 32 + r32] = f2bf(o[d0][r] * rli[r]); }
      asm volatile("s_waitcnt lgkmcnt(0)" ::: "memory");
#pragma unroll
      for (int i = 0; i < 4; ++i) { const int row = i * 8 + (lane >> 3), ch = lane & 7; const u32x4 v = *(const LAS u32x4*)(stg + row * 64 + ch * 8); *(u32x4*)(Ow + (size_t)row * 768 + ch * 8) = v; } }
    asm volatile("s_waitcnt vmcnt(0) lgkmcnt(0)\n\ts_barrier" ::: "memory");
#undef TROW
#undef DMA_K
#undef DMA_V
#undef ROT
#undef EX
#undef RESC
#undef PKW
#undef PAF
#undef VFR
#undef VRD
#undef KRD
#undef ENDW
#undef GAPA
#undef GAPB
#undef STEP
}
#undef SBAR
#undef PIN
#undef MFMA
}
__device__ __forceinline__ void attn_one(KP p, int l, int u, bool na, LAS unsigned char* shm);
__device__ __forceinline__ void st_attn(KP p, int l, bool with_ctx, bool na, LAS unsigned char* shm) {
    const int tid = ltid();
    if (na) {
        asm volatile("s_waitcnt lgkmcnt(0)\n\ts_barrier" ::: "memory");
        LAS float* bt = (LAS float*)(shm + att::LDS_BIAS);
        (void)bt;
    }
    const int nlat = NB * 4 * 16, nun = nlat + (with_ctx ? NB * 4 : 0);
    for (int u = lbid(); u < nun; u += lgrid()) attn_one(p, l, u, na, shm);
}
__device__ __forceinline__ void attn_one(KP p, int l, int u, bool na, LAS unsigned char* shm) {
    const int tid = ltid(); const int nlat = NB * 4 * 16;
    {
        att::Desc D;
        const bool isc = u >= nlat; const int uu = isc ? u - nlat : u;
        const int b = isc ? uu >> 2 : uu >> 6, h = isc ? uu & 3 : (uu >> 4) & 3, qb = isc ? 0 : uu & 15;
        const int qrow0 = isc ? NLAT + b * SC : b * TL + qb * 256;
        D.ctx_row0 = NLAT + b * SC; D.NT = 4; D.lat_row0 = b * TL; D.rlo = 0; D.qrow = qb * 4;
        if (na) {
            D.Q = p->P + (size_t)qrow0 * PC + C_QA + h * 64; D.KV = p->P; D.kcol = C_KA + h * 64; D.vcol = C_VA + h * 64; D.O = p->YCAT + (size_t)qrow0 * 768 + h * 64;
            if (!isc) { const int rlo = min(max(qb * 4 - 4, 0), 56), rhi = min(max(qb * 4 - 1, 0), 56) + 7; D.rlo = rlo; D.lat_row0 = b * TL + rlo * 64; D.NT = 4 + (rhi - rlo + 1);
                LAS float* bt = (LAS float*)(shm + att::LDS_BIAS); const float* rpb = p->in[I_RPB] + ((size_t)l * 4 + h) * 15 * 31;
                if (tid < 15 * 32) { const int dr = tid >> 5, dc = tid & 31; bt[tid] = dc < 31 ? rpb[dr * 31 + dc] * att::LOG2E : 0.f; }
                asm volatile("s_waitcnt lgkmcnt(0)\n\ts_barrier" ::: "memory");
                att::attn_unit<1>(D, shm);
            } else att::attn_unit<0>(D, shm);
        } else {
            const int kvh = h >> 1;
            D.Q = p->P + (size_t)qrow0 * PC + C_QC + h * 64; D.KV = p->P; D.kcol = C_KC + kvh * 64; D.vcol = C_VC + kvh * 64; D.O = p->YCAT + (size_t)qrow0 * 768 + 512 + h * 64;
            if (!isc) { D.NT = 68; att::attn_unit_pipe(D, shm); }
            else att::attn_unit<0>(D, shm);
        }
    }
}

__device__ __forceinline__ int gla_row(int b, int c, int j) { return c < 4 ? NLAT + b * SC + c * 64 + j : b * TL + (c - 4) * 64 + j; }
namespace gla {
constexpr int G_OFF = 0, KT_OFF = 65536, VTS_OFF = 65536 + 36864, QD_OFF = 65536, KI_OFF = 65536 + 40960, VTO_OFF = 0, X_OFF = 65536, LDS_TOTAL = 65536 + 81920;
typedef short s16x4 __attribute__((ext_vector_type(4)));
__device__ __forceinline__ f32x4 mfma16(bf16x8 a, bf16x8 b, f32x4 c) { return __builtin_amdgcn_mfma_f32_16x16x32_bf16(a, b, c, 0, 0, 0); }
__device__ __forceinline__ void gates_cumsum(KP p, int l, int b, int c, LAS unsigned char* shm, int tid) {
    LAS float* Gs = (LAS float*)(shm + G_OFF);
    { const int j = tid >> 3, part = tid & 7; const bf16_t* src = p->P + (size_t)gla_row(b, c, j) * PC + C_G + part * 32;
      const float* bias = (part < 4 ? p->in[I_BGF] + l * 128 + part * 32 : p->in[I_BGB] + l * 128 + (part - 4) * 32);
#pragma unroll
      for (int q = 0; q < 4; ++q) { const u32x4 w = *(const u32x4*)(src + q * 8); const f32x4 b0 = *(const f32x4*)(bias + q * 8), b1 = *(const f32x4*)(bias + q * 8 + 4);
          LAS float* d = Gs + j * 256 + part * 32 + q * 8;
          *(LAS f32x4*)d = (f32x4){logsig16(bflo(w.x) + b0[0]), logsig16(bfhi(w.x) + b0[1]), logsig16(bflo(w.y) + b0[2]), logsig16(bfhi(w.y) + b0[3])};
          *(LAS f32x4*)(d + 4) = (f32x4){logsig16(bflo(w.z) + b1[0]), logsig16(bfhi(w.z) + b1[1]), logsig16(bflo(w.w) + b1[2]), logsig16(bfhi(w.w) + b1[3])}; } }
    __syncthreads();
    if (tid < 256) {
        float v[64];
#pragma unroll
        for (int j = 0; j < 64; ++j) v[j] = Gs[j * 256 + tid];
        if (tid < 128) {
#pragma unroll
            for (int j = 1; j < 64; ++j) v[j] += v[j - 1];
        } else {
#pragma unroll
            for (int j = 62; j >= 0; --j) v[j] += v[j + 1];
        }
#pragma unroll
        for (int j = 0; j < 64; ++j) Gs[j * 256 + tid] = v[j];
    }
    __syncthreads();
}
__device__ __forceinline__ void build_vt(KP p, int b, int c, LAS unsigned char* vt, int tid) {
    const int j = tid & 63, w = tid >> 6; const bf16_t* src = p->P + (size_t)gla_row(b, c, j) * PC + C_VB + w * 32;
    LAS bf16_t* dst = (LAS bf16_t*)(vt + (w >> 1) * 9216 + ((w & 1) * 32) * 144) + j;
#pragma unroll
    for (int q = 0; q < 4; ++q) { const u32x4 x = *(const u32x4*)(src + q * 8);
        dst[(q * 8 + 0) * 72] = (bf16_t)(x.x & 0xFFFF); dst[(q * 8 + 1) * 72] = (bf16_t)(x.x >> 16); dst[(q * 8 + 2) * 72] = (bf16_t)(x.y & 0xFFFF); dst[(q * 8 + 3) * 72] = (bf16_t)(x.y >> 16);
        dst[(q * 8 + 4) * 72] = (bf16_t)(x.z & 0xFFFF); dst[(q * 8 + 5) * 72] = (bf16_t)(x.z >> 16); dst[(q * 8 + 6) * 72] = (bf16_t)(x.w & 0xFFFF); dst[(q * 8 + 7) * 72] = (bf16_t)(x.w >> 16); }
}
}
__device__ __forceinline__ void gla_states_one(KP p, int l, int u, LAS unsigned char* shm);
__device__ __forceinline__ void st_gla_states2(KP p, int l, LAS unsigned char* shm) {
    const int tid = ltid(), lane = tid & 63, l15 = lane & 15, kg = lane >> 4; const int w = __builtin_amdgcn_readfirstlane(tid >> 6);
    LAS float* Gs = (LAS float*)(shm + gla::G_OFF);
    for (int u = lbid(); u < NB * NCH; u += lgrid()) gla_states_one(p, l, u, shm);
    __syncthreads();
}
__device__ __forceinline__ void gla_states_one(KP p, int l, int u, LAS unsigned char* shm) {
    const int tid = ltid(), lane = tid & 63, l15 = lane & 15, kg = lane >> 4; const int w = __builtin_amdgcn_readfirstlane(tid >> 6);
    LAS float* Gs = (LAS float*)(shm + gla::G_OFF);
    {
        const int b = u / NCH, c = u % NCH;
        __syncthreads();
        gla::gates_cumsum(p, l, b, c, shm, tid);
        {
          const int dir = w >> 2, h = w & 3, j = lane; const bf16_t* src = p->P + (size_t)gla_row(b, c, j) * PC + C_KB + h * 32;
          LAS bf16_t* dst = (LAS bf16_t*)(shm + gla::KT_OFF + w * 4608) + j;
          const LAS float* gb = Gs + j * 256 + dir * 128 + h * 32; const LAS float* gl = Gs + (dir ? 0 : 63) * 256 + dir * 128 + h * 32;
#pragma unroll
          for (int q = 0; q < 4; ++q) { const u32x4 x = *(const u32x4*)(src + q * 8); const unsigned xs[4] = {x.x, x.y, x.z, x.w};
#pragma unroll
              for (int e = 0; e < 8; ++e) { const int kk = q * 8 + e; const float kv = (e & 1) ? bfhi(xs[e >> 1]) : bflo(xs[e >> 1]);
                  dst[kk * 72] = f2bf(kv * __expf(gl[kk] - gb[kk])); } } }
        gla::build_vt(p, b, c, shm + gla::VTS_OFF, tid);
        if (tid < 256) { const int dir = tid >> 7, h = (tid >> 5) & 3, kk = tid & 31; p->DEC[((((size_t)b * 2 + dir) * NCH + c) * 4 + h) * 32 + kk] = __expf(Gs[(dir ? 0 : 63) * 256 + tid]); }
        __syncthreads();
        { const int dir = w >> 2, h = w & 3;
          const LAS unsigned char* vt = shm + gla::VTS_OFF + h * 9216; const LAS unsigned char* kt = shm + gla::KT_OFF + w * 4608;
          float* dst = p->DST + ((((size_t)b * 2 + dir) * NCH + c) * 4 + h) * 2048;
#pragma unroll
          for (int ki = 0; ki < 2; ++ki) { const bf16x8 kb0 = *(const LAS bf16x8*)(kt + (ki * 16 + l15) * 144 + kg * 16), kb1 = *(const LAS bf16x8*)(kt + (ki * 16 + l15) * 144 + 64 + kg * 16);
#pragma unroll
              for (int vi = 0; vi < 4; ++vi) { const bf16x8 va0 = *(const LAS bf16x8*)(vt + (vi * 16 + l15) * 144 + kg * 16), va1 = *(const LAS bf16x8*)(vt + (vi * 16 + l15) * 144 + 64 + kg * 16);
                  f32x4 acc = (f32x4){0.f, 0.f, 0.f, 0.f}; acc = gla::mfma16(va0, kb0, acc); acc = gla::mfma16(va1, kb1, acc);
                  *(f32x4*)(dst + (ki * 16 + l15) * 64 + vi * 16 + 4 * kg) = acc; } } }
    }
    __syncthreads();
}
__device__ __forceinline__ void st_gla_scan2(KP p) {
    for (int i = lbid() * NTHREADS + ltid(); i < NB * 2 * 4 * 2048; i += lgrid() * NTHREADS) {
        const int e = i & 2047, h = (i >> 11) & 3, dir = (i >> 13) & 1, b = i >> 14, kk = e >> 6;
        float s = 0.f;
#pragma unroll 1
        for (int n0 = 0; n0 < NCH; n0 += 17) {
            float d[17], dc[17]; size_t base[17];
#pragma unroll
            for (int q = 0; q < 17; ++q) { const int n = n0 + q; const int c = dir == 0 ? n : (n < 4 ? 3 - n : 71 - n);
                base[q] = (((size_t)b * 2 + dir) * NCH + c) * 4 + h; d[q] = p->DST[base[q] * 2048 + e]; dc[q] = p->DEC[base[q] * 32 + kk]; }
#pragma unroll
            for (int q = 0; q < 17; ++q) { p->ST[base[q] * 2048 + e] = f2bf(s); s = dc[q] * s + d[q]; }
        }
    }
}
__device__ __forceinline__ void st_gla_out2(KP p, int l, bool with_ctx, LAS unsigned char* shm) {
    const int tid = ltid(), lane = tid & 63, l15 = lane & 15, kg = lane >> 4; const int w = __builtin_amdgcn_readfirstlane(tid >> 6);
    LAS float* Gs = (LAS float*)(shm + gla::G_OFF);
    const float qs = 0.17677669529663687f;
    for (int u = lbid(); u < NB * NCH; u += lgrid()) {
        const int b = u / NCH, c = u % NCH;
        if (!with_ctx && c < 4) continue;
        __syncthreads();
        gla::gates_cumsum(p, l, b, c, shm, tid);
        {
          const int j = tid >> 3, part = tid & 7, h = part >> 1, kk0 = (part & 1) * 16; const size_t ro = (size_t)gla_row(b, c, j) * PC;
          const u32x4 q0 = *(const u32x4*)(p->P + ro + C_QB + part * 16), q1 = *(const u32x4*)(p->P + ro + C_QB + part * 16 + 8);
          const u32x4 k0 = *(const u32x4*)(p->P + ro + C_KB + part * 16), k1 = *(const u32x4*)(p->P + ro + C_KB + part * 16 + 8);
          const unsigned qx[8] = {q0.x, q0.y, q0.z, q0.w, q1.x, q1.y, q1.z, q1.w}, kx[8] = {k0.x, k0.y, k0.z, k0.w, k1.x, k1.y, k1.z, k1.w};
#pragma unroll
          for (int dir = 0; dir < 2; ++dir) { const LAS float* gb = Gs + j * 256 + dir * 128 + part * 16; unsigned qo[8], ko[8];
#pragma unroll
              for (int e = 0; e < 8; ++e) { const float g0 = gb[2 * e], g1 = gb[2 * e + 1];
                  qo[e] = pack2(bflo(qx[e]) * qs * __expf(g0), bfhi(qx[e]) * qs * __expf(g1)); ko[e] = pack2(bflo(kx[e]) * __expf(-g0), bfhi(kx[e]) * __expf(-g1)); }
              LAS unsigned char* qd = shm + gla::QD_OFF + (dir * 4 + h) * 5120 + j * 80 + kk0 * 2; LAS unsigned char* ki = shm + gla::KI_OFF + (dir * 4 + h) * 5120 + j * 80 + kk0 * 2;
              *(LAS u32x4*)qd = (u32x4){qo[0], qo[1], qo[2], qo[3]}; *(LAS u32x4*)(qd + 16) = (u32x4){qo[4], qo[5], qo[6], qo[7]};
              *(LAS u32x4*)ki = (u32x4){ko[0], ko[1], ko[2], ko[3]}; *(LAS u32x4*)(ki + 16) = (u32x4){ko[4], ko[5], ko[6], ko[7]}; } }
        __syncthreads();
        gla::build_vt(p, b, c, shm + gla::VTO_OFF, tid);
        __syncthreads();
        const int dir = w >> 2, h = w & 3;
        f32x4 acc[4][4];
#pragma unroll
        for (int ti = 0; ti < 4; ++ti)
#pragma unroll
            for (int vi = 0; vi < 4; ++vi) acc[ti][vi] = (f32x4){0.f, 0.f, 0.f, 0.f};
        { const LAS unsigned char* qd = shm + gla::QD_OFF + w * 5120; const LAS unsigned char* ki = shm + gla::KI_OFF + w * 5120; const LAS unsigned char* vt = shm + gla::VTO_OFF + h * 9216;
          const bf16_t* st = p->ST + ((((size_t)b * 2 + dir) * NCH + c) * 4 + h) * 2048;
          bf16x8 sfr[4];
#pragma unroll
          for (int vi = 0; vi < 4; ++vi) {
#pragma unroll
              for (int j = 0; j < 8; ++j) sfr[vi][j] = (short)st[(kg * 8 + j) * 64 + vi * 16 + l15]; }
#pragma unroll
          for (int ti = 0; ti < 4; ++ti) {
              const bf16x8 qf = *(const LAS bf16x8*)(qd + (ti * 16 + l15) * 80 + kg * 16);
              const int ig = ti * 16 + l15;
              unsigned pk[4][2];
#pragma unroll
              for (int tj = 0; tj < 4; ++tj) {
                  const bf16x8 kf = *(const LAS bf16x8*)(ki + (tj * 16 + l15) * 80 + kg * 16);
                  f32x4 a2 = gla::mfma16(kf, qf, (f32x4){0.f, 0.f, 0.f, 0.f});
#pragma unroll
                  for (int jj = 0; jj < 4; ++jj) { const int jg = tj * 16 + 4 * kg + jj; const bool ok = dir == 0 ? (jg <= ig) : (jg >= ig); a2[jj] = ok ? a2[jj] : 0.f; }
                  pk[tj][0] = pack2(a2[0], a2[1]); pk[tj][1] = pack2(a2[2], a2[3]);
              }
#pragma unroll
              for (int s2 = 0; s2 < 2; ++s2) {
                  const u32x4 bw = (u32x4){pk[2 * s2][0], pk[2 * s2][1], pk[2 * s2 + 1][0], pk[2 * s2 + 1][1]}; const bf16x8 bfr = __builtin_bit_cast(bf16x8, bw);
#pragma unroll
                  for (int vi = 0; vi < 4; ++vi) {
                      const LAS unsigned char* vr = vt + (vi * 16 + l15) * 144 + kg * 8;
                      const u32x2 lo = *(const LAS u32x2*)(vr + (2 * s2) * 32), hi2 = *(const LAS u32x2*)(vr + (2 * s2 + 1) * 32);
                      const u32x4 aw = (u32x4){lo.x, lo.y, hi2.x, hi2.y};
                      acc[ti][vi] = gla::mfma16(__builtin_bit_cast(bf16x8, aw), bfr, acc[ti][vi]);
                  }
              }
#pragma unroll
              for (int vi = 0; vi < 4; ++vi) acc[ti][vi] = gla::mfma16(sfr[vi], qf, acc[ti][vi]);
          } }
        __syncthreads();
        { LAS f32x4* xo = (LAS f32x4*)(shm + gla::X_OFF + w * 8192);
#pragma unroll
          for (int t2 = 0; t2 < 2; ++t2)
#pragma unroll
              for (int vi = 0; vi < 4; ++vi) xo[(t2 * 4 + vi) * 64 + lane] = dir == 0 ? acc[2 + t2][vi] : acc[t2][vi]; }
        __syncthreads();
        { const LAS f32x4* xi = (const LAS f32x4*)(shm + gla::X_OFF + (w ^ 4) * 8192);
          const float* gg = p->in[I_GLAG] + l * 64;
#pragma unroll
          for (int t2 = 0; t2 < 2; ++t2) {
              f32x4 o[4]; float ss = 0.f;
#pragma unroll
              for (int vi = 0; vi < 4; ++vi) { o[vi] = (dir == 0 ? acc[t2][vi] : acc[2 + t2][vi]) + xi[(t2 * 4 + vi) * 64 + lane]; ss += o[vi][0] * o[vi][0] + o[vi][1] * o[vi][1] + o[vi][2] * o[vi][2] + o[vi][3] * o[vi][3]; }
              ss += __shfl_xor(ss, 16); ss += __shfl_xor(ss, 32);
              const float rs = rsqrtf(ss * (1.f / 64.f) + EPS);
              const int R = gla_row(b, c, (dir * 2 + t2) * 16 + l15);
#pragma unroll
              for (int vi = 0; vi < 4; ++vi) { const int col = h * 64 + vi * 16 + 4 * kg; const u32x2 rw = *(const u32x2*)(p->P + (size_t)R * PC + C_RB + col); const f32x4 gv = *(const f32x4*)(gg + vi * 16 + 4 * kg);
                  u32x2 yw; yw.x = pack2(o[vi][0] * rs * gv[0] * siluf(bflo(rw.x)), o[vi][1] * rs * gv[1] * siluf(bfhi(rw.x))); yw.y = pack2(o[vi][2] * rs * gv[2] * siluf(bflo(rw.y)), o[vi][3] * rs * gv[3] * siluf(bfhi(rw.y)));
                  *(u32x2*)(p->YCAT + (size_t)R * 768 + 256 + col) = yw; }
          } }
    }
    __syncthreads();
}

__device__ __forceinline__ void st_norm2_router(KP p, int l, bool with_ctx, unsigned char* lds) {
    float* W2 = (float*)lds;
    const int tid = ltid(), wid = tid >> 6, lane = tid & 63;
    __syncthreads();
    for (int i_ = tid; i_ < DM * NE; i_ += NTHREADS) { const int col = i_ >> 4, e = i_ & 15, ln = (col & 255) >> 2, q = col & 3, i = col >> 8;
        W2[(((i * 4 + q) * 64) + ln) * 20 + e] = p->in[I_WR][(size_t)l * DM * NE + i_]; }
    __syncthreads();
    const float* mod = p->MOD + (size_t)l * 9 * 6144; const float* g = p->in[I_N2G] + l * DM;
    const int nrows = with_ctx ? MT : NLAT, stride = lgrid() * 8;
    const bool b5 = lane & 32, b4 = lane & 16, b3 = lane & 8, b2 = lane & 4;
    const int my_e = (b5 ? 8 : 0) + (b4 ? 4 : 0) + (b3 ? 2 : 0) + (b2 ? 1 : 0);
    for (int R0 = lbid() * 8 + wid; R0 < nrows; R0 += 2 * stride) {
        const int R1 = R0 + stride; const bool has1 = R1 < nrows; const int R1c = has1 ? R1 : R0;
        f32x4 x0[4], x1[4];
#pragma unroll
        for (int i = 0; i < 4; ++i) { x0[i] = xrow4(p->X + (size_t)R0 * DM, lane, i); x1[i] = xrow4(p->X + (size_t)R1c * DM, lane, i); }
        const float* m0 = mod + mod_row(R0) * 6144; const float* m1 = mod + mod_row(R1c) * 6144;
        float ss0 = 0.f, ss1 = 0.f;
#pragma unroll
        for (int i = 0; i < 4; ++i) { ss0 += x0[i][0] * x0[i][0] + x0[i][1] * x0[i][1] + x0[i][2] * x0[i][2] + x0[i][3] * x0[i][3]; ss1 += x1[i][0] * x1[i][0] + x1[i][1] * x1[i][1] + x1[i][2] * x1[i][2] + x1[i][3] * x1[i][3]; }
#pragma unroll
        for (int o = 32; o > 0; o >>= 1) { ss0 += __shfl_xor(ss0, o); ss1 += __shfl_xor(ss1, o); }
        const float rs0 = rsqrtf(ss0 * (1.f / DM) + EPS), rs1 = rsqrtf(ss1 * (1.f / DM) + EPS);
#pragma unroll
        for (int i = 0; i < 4; ++i) {
            const int c = lane * 4 + 256 * i; const f32x4 gv = *(const f32x4*)(g + c);
            x0[i] = (x0[i] * rs0) * gv * (*(const f32x4*)(m0 + 4096 + c) + 1.f) + *(const f32x4*)(m0 + 3072 + c);
            x1[i] = (x1[i] * rs1) * gv * (*(const f32x4*)(m1 + 4096 + c) + 1.f) + *(const f32x4*)(m1 + 3072 + c);
        }
        store_row_fp8((unsigned char*)p->U + (size_t)R0 * DM, x0, lane, S8_X);
        if (has1) store_row_fp8((unsigned char*)p->U + (size_t)R1 * DM, x1, lane, S8_X);
        f32x4 a0[4], a1[4];
#pragma unroll
        for (int j = 0; j < 4; ++j) { a0[j] = (f32x4){0.f, 0.f, 0.f, 0.f}; a1[j] = (f32x4){0.f, 0.f, 0.f, 0.f}; }
#pragma unroll
        for (int i = 0; i < 4; ++i)
#pragma unroll
            for (int q = 0; q < 4; ++q) { const f32x4* wv = (const f32x4*)(W2 + (((i * 4 + q) * 64) + lane) * 20); const float xa = x0[i][q], xb = x1[i][q];
#pragma unroll
                for (int j = 0; j < 4; ++j) { const f32x4 w4 = wv[j]; a0[j] += w4 * xa; a1[j] += w4 * xb; }
                if (q & 1) __builtin_amdgcn_sched_barrier(0); }
        float l0, l1;
        { float u0[8], u1[8];
#pragma unroll
          for (int k = 0; k < 8; ++k) { const float k0 = a0[k >> 2][k & 3], h0 = a0[2 + (k >> 2)][k & 3], k1 = a1[k >> 2][k & 3], h1 = a1[2 + (k >> 2)][k & 3];
              u0[k] = (b5 ? h0 : k0) + __shfl_xor(b5 ? k0 : h0, 32); u1[k] = (b5 ? h1 : k1) + __shfl_xor(b5 ? k1 : h1, 32); }
          float v0[4], v1[4];
#pragma unroll
          for (int k = 0; k < 4; ++k) { v0[k] = (b4 ? u0[4 + k] : u0[k]) + __shfl_xor(b4 ? u0[k] : u0[4 + k], 16); v1[k] = (b4 ? u1[4 + k] : u1[k]) + __shfl_xor(b4 ? u1[k] : u1[4 + k], 16); }
          float w0[2], w1[2];
#pragma unroll
          for (int k = 0; k < 2; ++k) { w0[k] = (b3 ? v0[2 + k] : v0[k]) + __shfl_xor(b3 ? v0[k] : v0[2 + k], 8); w1[k] = (b3 ? v1[2 + k] : v1[k]) + __shfl_xor(b3 ? v1[k] : v1[2 + k], 8); }
          l0 = (b2 ? w0[1] : w0[0]) + __shfl_xor(b2 ? w0[0] : w0[1], 4); l1 = (b2 ? w1[1] : w1[0]) + __shfl_xor(b2 ? w1[0] : w1[1], 4);
          l0 += __shfl_xor(l0, 2); l1 += __shfl_xor(l1, 2); l0 += __shfl_xor(l0, 1); l1 += __shfl_xor(l1, 1); }
        float mx0 = l0, mx1 = l1;
#pragma unroll
        for (int o = 32; o >= 4; o >>= 1) { mx0 = fmaxf(mx0, __shfl_xor(mx0, o)); mx1 = fmaxf(mx1, __shfl_xor(mx1, o)); }
        const float ex0 = expf(l0 - mx0), ex1 = expf(l1 - mx1); float s0 = ex0, s1 = ex1;
#pragma unroll
        for (int o = 32; o >= 4; o >>= 1) { s0 += __shfl_xor(s0, o); s1 += __shfl_xor(s1, o); }
        if ((lane & 3) == 0) { p->AFF[(size_t)R0 * 16 + my_e] = ex0 / s0; if (has1) p->AFF[(size_t)R1 * 16 + my_e] = ex1 / s1; }
    }
}

__device__ __forceinline__ int block_sum_i(int v, int* red, int tid) {
    const int lane = tid & 63, wid = tid >> 6;
#pragma unroll
    for (int o = 32; o > 0; o >>= 1) v += __shfl_xor(v, o);
    __syncthreads();
    if (lane == 0) red[wid] = v;
    __syncthreads();
    int s = 0;
#pragma unroll
    for (int w = 0; w < 8; ++w) s += red[w];
    return s;
}
__device__ __forceinline__ int block_excl_scan_i(int v, int* red, int tid) {
    const int lane = tid & 63, wid = tid >> 6;
    int inc = v;
#pragma unroll
    for (int o = 1; o < 64; o <<= 1) { const int t = __shfl_up(inc, o); if (lane >= o) inc += t; }
    __syncthreads();
    if (lane == 63) red[wid] = inc;
    __syncthreads();
    int base = 0;
#pragma unroll
    for (int w = 0; w < 8; ++w) base += (w < wid) ? red[w] : 0;
    return base + inc - v;
}
__device__ __forceinline__ void st_topk(KP p, bool with_ctx, unsigned char* lds) {
    int* red = (int*)lds;
    const int tid = ltid();
    const int nun = NB * NE * (with_ctx ? 2 : 1);
    for (int u = lbid(); u < nun; u += lgrid()) {
        const int grp = u / (NB * NE), b = (u / NE) % NB, e = u % NE;
        const int n = grp ? SC : TL, cap = grp ? CAPC : CAPL, per = grp ? 1 : 8;
        const int rowbase = grp ? NLAT + b * SC : b * TL;
        unsigned key[8];
#pragma unroll
        for (int i = 0; i < 8; ++i) { const int t = tid * per + i; key[i] = (i < per && t < n) ? __float_as_uint(p->AFF[(size_t)(rowbase + t) * 16 + e]) : 0u; }
        unsigned prefix = 0u;
        { const int lane_ = tid & 63, wid_ = tid >> 6; int* rq = red + 16;
          __syncthreads();
          for (int step = 0; step < 16; ++step) {
              const int bit = step == 0 ? 30 : 30 - 2 * step;
              const unsigned c1 = prefix | (1u << bit), c2 = step == 0 ? 0xFFFFFFFFu : prefix | (2u << bit), c3 = step == 0 ? 0xFFFFFFFFu : prefix | (3u << bit);
              int a = 0, b3 = 0;
#pragma unroll
              for (int i = 0; i < 8; ++i) { a += (key[i] >= c1 ? 1 : 0) + (key[i] >= c2 ? 65536 : 0); b3 += key[i] >= c3 ? 1 : 0; }
#pragma unroll
              for (int o = 32; o > 0; o >>= 1) { a += __shfl_xor(a, o); b3 += __shfl_xor(b3, o); }
              int* slot = rq + (step & 1) * 16;
              if (lane_ == 0) { slot[wid_ * 2] = a; slot[wid_ * 2 + 1] = b3; }
              __syncthreads();
              int sa = 0, sb = 0;
#pragma unroll
              for (int w8 = 0; w8 < 8; ++w8) { sa += slot[w8 * 2]; sb += slot[w8 * 2 + 1]; }
              const int n1 = sa & 0xFFFF, n2 = sa >> 16, n3 = sb;
              prefix = (n3 >= cap) ? c3 : (n2 >= cap) ? c2 : (n1 >= cap) ? c1 : prefix;
          } }
        int ngt = 0, neq = 0;
#pragma unroll
        for (int i = 0; i < 8; ++i) { ngt += key[i] > prefix ? 1 : 0; neq += (key[i] == prefix && key[i] != 0u) ? 1 : 0; }
        const int need = cap - block_sum_i(ngt, red, tid);
        int eqbase = block_excl_scan_i(neq, red, tid);
        int sel[8]; int nsel = 0;
#pragma unroll
        for (int i = 0; i < 8; ++i) { const bool eq = key[i] == prefix && key[i] != 0u; sel[i] = (key[i] > prefix || (eq && eqbase < need)) ? 1 : 0; eqbase += eq ? 1 : 0; nsel += sel[i]; }
        int slot = block_excl_scan_i(nsel, red, tid);
        const int ebase = e * EROWS + (grp ? NB * CAPL + b * CAPC : b * CAPL);
#pragma unroll
        for (int i = 0; i < 8; ++i) { const int t = tid * per + i;
            if (i < per && t < n) { const int R = rowbase + t;
                if (sel[i]) { const int er = ebase + slot; p->SRCROW[er] = R; p->VAL[er] = __uint_as_float(key[i]); p->SLOTOF[(size_t)R * 16 + e] = er; ++slot; }
                else p->SLOTOF[(size_t)R * 16 + e] = -1; } }
        __syncthreads();
    }
}
__device__ __forceinline__ void st_combine(KP p, int l, bool with_ctx) {
    const int wid = ltid() >> 6, lane = ltid() & 63;
    const float* mod = p->MOD + (size_t)l * 9 * 6144;
    const int nrows = with_ctx ? MT : NLAT, stride = lgrid() * 8;
    int R = lbid() * 8 + wid;
    int so_n = -1; float sv_n = 0.f; u32x2 x_n[4];
    if (R < nrows) {
        so_n = p->SLOTOF[(size_t)R * 16 + (lane & 15)]; sv_n = so_n >= 0 ? p->VAL[so_n] : 0.f;
#pragma unroll
        for (int i = 0; i < 4; ++i) x_n[i] = *(const u32x2*)(p->X + (size_t)R * DM + lane * 4 + 256 * i);
    }
    for (; R < nrows; R += stride) {
        const int so = so_n; const float sv = sv_n; f32x4 x[4];
#pragma unroll
        for (int i = 0; i < 4; ++i) x[i] = (f32x4){bflo(x_n[i].x), bfhi(x_n[i].x), bflo(x_n[i].y), bfhi(x_n[i].y)};
        const int Rn = R + stride;
        if (Rn < nrows) {
            so_n = p->SLOTOF[(size_t)Rn * 16 + (lane & 15)]; sv_n = so_n >= 0 ? p->VAL[so_n] : 0.f;
#pragma unroll
            for (int i = 0; i < 4; ++i) x_n[i] = *(const u32x2*)(p->X + (size_t)Rn * DM + lane * 4 + 256 * i);
        }
        unsigned mask = (unsigned)(__ballot(so >= 0) & 0xFFFFull);
        f32x4 a[4];
#pragma unroll
        for (int i = 0; i < 4; ++i) a[i] = (f32x4){0.f, 0.f, 0.f, 0.f};
        while (mask) {
            const int e0 = __builtin_ctz(mask); mask &= mask - 1;
            const bool two = mask != 0; const int e1 = two ? __builtin_ctz(mask) : e0; if (two) mask &= mask - 1;
            const int er0 = __shfl(so, e0), er1 = __shfl(so, e1); const float v0 = __shfl(sv, e0), v1 = two ? __shfl(sv, e1) : 0.f;
            const bf16_t* y0 = p->Y + (size_t)er0 * DM + lane * 4; const bf16_t* y1 = p->Y + (size_t)er1 * DM + lane * 4;
            u32x2 w0[4], w1[4];
#pragma unroll
            for (int i = 0; i < 4; ++i) { w0[i] = *(const u32x2*)(y0 + 256 * i); w1[i] = *(const u32x2*)(y1 + 256 * i); }
#pragma unroll
            for (int i = 0; i < 4; ++i) { a[i][0] += v0 * bflo(w0[i].x) + v1 * bflo(w1[i].x); a[i][1] += v0 * bfhi(w0[i].x) + v1 * bfhi(w1[i].x); a[i][2] += v0 * bflo(w0[i].y) + v1 * bflo(w1[i].y); a[i][3] += v0 * bfhi(w0[i].y) + v1 * bfhi(w1[i].y); }
        }
        const float* m = mod + mod_row(R) * 6144;
#pragma unroll
        for (int i = 0; i < 4; ++i) { const int c = lane * 4 + 256 * i; x[i] += *(const f32x4*)(m + 5120 + c) * a[i]; }
        if (l + 1 < NL) {
            store_row_bf16(p->X + (size_t)R * DM, x, lane);
            const float* m2 = p->MOD + (size_t)(l + 1) * 9 * 6144 + mod_row(R) * 6144;
            norm_mod_row(x, p->in[I_N1G] + (l + 1) * DM, m2, m2 + 1024, lane);
            store_row_bf16(p->U + (size_t)R * DM, x, lane);
            store_row_fp8(p->U8W + (size_t)R * DM, x, lane, S8_U);
        } else {
            float ss = 0.f;
#pragma unroll
            for (int i = 0; i < 4; ++i) ss += x[i][0] * x[i][0] + x[i][1] * x[i][1] + x[i][2] * x[i][2] + x[i][3] * x[i][3];
            ss = wave_sum(ss); const float rs = rsqrtf(ss * (1.f / DM) + EPS);
#pragma unroll
            for (int i = 0; i < 4; ++i) { const int c = lane * 4 + 256 * i; *(f32x4*)(p->out + (size_t)R * DM + c) = x[i] * rs * *(const f32x4*)(p->in[I_FNG] + c); }
        }
    }
}

constexpr int LDS_BYTES = 160 * 1024;
#define PHASE_BEGIN { KP p = kparams(); LAS unsigned char* lds3 = llds3(lds0); unsigned char* lds = (unsigned char*)lds3; const int G = lgrid(), c0_ = lbid(), c = (G % 8 == 0) ? (c0_ % 8) * (G / 8) + c0_ / 8 : c0_;     (void)p; (void)lds; (void)lds3; (void)G; (void)c;
#define PHASE_END   xcd_barrier(bar); }
#ifndef DUPMASK
#define DUPMASK 0
#endif
#define RUN(bit, ...) do { __VA_ARGS__; if ((DUPMASK >> (bit)) & 1) { xcd_barrier(bar); __VA_ARGS__; } } while (0)
__global__ void __launch_bounds__(NTHREADS, 2) fwd(Params p_unused) {
    extern __shared__ __attribute__((aligned(16))) unsigned char lds_raw[];
    LAS unsigned char* lds0 = (LAS unsigned char*)lds_raw + 16;
    volatile LAS unsigned* xbw = (volatile LAS unsigned*)lds_raw;
    if (threadIdx.x == 0) { xbw[0] = 0u; xbw[1] = 0u; xbw[2] = 0u; xbw[3] = 0u; }
    __syncthreads();
    XcdBarrier bar = xcd_barrier_post(kparams()->bar, xbw);
    PHASE_BEGIN RUN(12, st_adaln(p, lds)); RUN(0, st_convert(p, lds, 0, NL)); RUN(13, st_fold(p)); PHASE_END
    PHASE_BEGIN RUN(14, st_norm1(p, 0)); PHASE_END
    for (int l = 0; l < NL; ++l) {
        const bool wc = l + 1 < NL;
        PHASE_BEGIN pg8::PlainOrder S{(const char*)p->U, (const char*)(p->WIN + (size_t)l * PC * DM), (size_t)256 * DM * 2, (size_t)256 * DM * 2, MT / 256, C_MG / 256, G, c};
                    pg8::EpiIn E{p->P, p->PG};
                    const int c8 = (c + 56) % G;
                    pg8::PlainOrder S8{(const char*)p->U8W, (const char*)(p->WING8 + (size_t)l * 3072 * DM), (size_t)256 * DM, (size_t)256 * DM, (wc ? MT : NLAT) / 256, 3072 / 256, G, c8};
                    pg8::EpiGate8 E8{p->PG, 1.f / (S8_U * S8_W)};
                    RUN(1, pg8::gemm_phase<pg8::EpiIn, pg8::PlainOrder, true, true>(lds3, DM * 2, DM * 2, DM / 64, S, E); pg8::gemm_phase<pg8::EpiGate8, pg8::PlainOrder, true, true, true>(lds3, DM, DM, DM / 128, S8, E8)); PHASE_END
        PHASE_BEGIN st_qkrope(p, l, lds);
                    { unsigned* head = p->bar + XCD_BAR_WORDS + l * 64; volatile LAS unsigned* qw = (volatile LAS unsigned*)lds_raw + 2;
                      const int nNA = NB * 4 * 16, nGS = NB * NCH, nTot = nNA + nGS + (wc ? NB * 4 : 0);
                      for (;;) {
                          __syncthreads();
                          if (ltid() == 0) *qw = __hip_atomic_fetch_add(head, 1u, __ATOMIC_RELAXED, __HIP_MEMORY_SCOPE_AGENT);
                          __syncthreads();
                          const int u = (int)*qw;
                          if (u >= nTot) break;
                          if (u < nNA) attn_one(p, l, u, true, lds3);
                          else if (u < nNA + nGS) gla_states_one(p, l, u - nNA, lds3);
                          else attn_one(p, l, nNA + (u - nNA - nGS), true, lds3);
                      } }
                    PHASE_END
        PHASE_BEGIN st_gla_scan2(p);
                    { const int nq = (G % 8 == 0) ? 8 : 1, x = c0_ % nq;
                      unsigned* head = p->bar + XCD_BAR_WORDS + (16 + l * 8 + x) * 64; volatile LAS unsigned* qw = (volatile LAS unsigned*)lds_raw + 2;
                      const int nLat = NB * 4 * 16 / nq, nCtxQ = NB * 4 / nq, nTot = nLat + (wc ? nCtxQ : 0);
                      for (;;) {
                          __syncthreads();
                          if (ltid() == 0) *qw = __hip_atomic_fetch_add(head, 1u, __ATOMIC_RELAXED, __HIP_MEMORY_SCOPE_AGENT);
                          __syncthreads();
                          const int j = (int)*qw;
                          if (j >= nTot) break;
                          int u = j;
                          if (nq == 8) {
                              if (j < nLat) { const int pair = x + 8 * (j >> 5), jj = j & 31; u = ((pair >> 1) << 6) | ((((pair & 1) << 1) | (jj >> 4)) << 4) | (jj & 15); }
                              else u = NB * 4 * 16 + x * nCtxQ + (j - nLat);
                          }
                          attn_one(p, l, u, false, lds3);
                      } }
                    PHASE_END
        PHASE_BEGIN RUN(5, st_gla_out2(p, l, wc, lds3)); PHASE_END
        PHASE_BEGIN pg8::MergeOrder S{(const char*)p->YCAT, (const char*)(p->WB + (size_t)l * DM * 768), (size_t)256 * 768 * 2, (size_t)256 * 768 * 2, (wc ? MT : NLAT) / 256, DM / 256, G, c};
                    pg8::EpiMerge E{p->PG, p->MPRE};
                    RUN(6, pg8::gemm_phase<pg8::EpiMerge, pg8::MergeOrder, true, true>(lds3, 768 * 2, 768 * 2, 256 / 64, S, E)); PHASE_END
        PHASE_BEGIN pg8::PlainOrder S{(const char*)p->MPRE, (const char*)(p->WOUT + (size_t)l * DM * DM), (size_t)256 * DM * 2, (size_t)256 * DM * 2, (wc ? MT : NLAT) / 256, DM / 256, G, c};
                    pg8::EpiOut E{p->X, p->MOD + (size_t)l * 9 * 6144};
                    pg8::gemm_phase<pg8::EpiOut, pg8::PlainOrder, true, true>(lds3, DM * 2, DM * 2, DM / 64, S, E); PHASE_END
        PHASE_BEGIN RUN(7, st_norm2_router(p, l, wc, lds)); PHASE_END
        PHASE_BEGIN RUN(8, st_topk(p, wc, lds)); PHASE_END
        PHASE_BEGIN pg8::ExpertOrder S{(const char*)p->U, (const char*)(p->WGU + (size_t)l * NE * 2 * FF * DM), 0, (size_t)256 * DM, 0, (size_t)2 * FF * DM, wc ? 17 : 16, 16, G, c, p->SRCROW};
                    pg8::EpiGU8 E{p->H, 1.f / (S8_W * S8_X), S8_H};
                    RUN(10, pg8::gemm_phase<pg8::EpiGU8, pg8::ExpertOrder, true, true, true, true>(lds3, DM, DM, DM / 128, S, E)); PHASE_END
        PHASE_BEGIN pg8::ExpertOrder S{(const char*)p->H, (const char*)(p->WD + (size_t)l * NE * DM * FF), (size_t)256 * FF, (size_t)256 * FF, (size_t)EROWS * FF, (size_t)DM * FF, wc ? 17 : 16, 4, G, c, nullptr};
                    pg8::EpiDown E{p->Y, 1.f / (S8_W * S8_H)};
                    RUN(11, pg8::gemm_phase<pg8::EpiDown, pg8::ExpertOrder, true, true, true>(lds3, FF, FF, FF / 128, S, E)); PHASE_END
        PHASE_BEGIN st_combine(p, l, wc); PHASE_END
    }
}

extern "C" void kernel_launch(void* const* d_in, const int* in_sizes, int n_in, void* d_out, int out_size, void* d_ws, size_t ws_size, hipStream_t stream) {
    Params p{};
    for (int i = 0; i < 26; ++i) p.in[i] = (const float*)d_in[i];
    p.out = (float*)d_out;
    unsigned char* w = (unsigned char*)d_ws; size_t off = 0;
    auto take = [&](size_t bytes) { unsigned char* r = w + off; off += (bytes + 255) & ~(size_t)255; return r; };
    p.bar = (unsigned*)take((XCD_BAR_WORDS + QUEUE_WORDS) * 4);
    p.X = (bf16_t*)take((size_t)MT * DM * 2);
    p.U = (bf16_t*)take((size_t)MT * DM * 2);
    p.MOD = (float*)take((size_t)NL * 9 * 6144 * 4);
    p.MPRE = (bf16_t*)take((size_t)MT * DM * 2);
    p.AFF = (float*)take((size_t)MT * 16 * 4);
    p.SRCROW = (int*)take((size_t)NE * EROWS * 4);
    p.VAL = (float*)take((size_t)NE * EROWS * 4);
    p.SLOTOF = (int*)take((size_t)MT * 16 * 4);
    p.WIN = (bf16_t*)take((size_t)NL * PC * DM * 2);
    p.WB = (bf16_t*)take((size_t)NL * DM * 768 * 2);
    p.WOUT = (bf16_t*)take((size_t)NL * DM * DM * 2);
    p.WGU = (unsigned char*)take((size_t)NL * NE * 2 * FF * DM);
    p.WD = (unsigned char*)take((size_t)NL * NE * DM * FF);
    p.U8W = (unsigned char*)take((size_t)MT * DM);
    p.WING8 = (unsigned char*)take((size_t)NL * 3072 * DM);
    const size_t r1 = off;
    p.P = (bf16_t*)take((size_t)MT * PC * 2);
    p.YCAT = (bf16_t*)take((size_t)MT * 768 * 2);
    p.DST = (float*)take((size_t)NB * 2 * NCH * 4 * 2048 * 4);
    p.DEC = (float*)take((size_t)NB * 2 * NCH * 4 * 32 * 4);
    p.ST = (bf16_t*)take((size_t)NB * 2 * NCH * 4 * 2048 * 2);
    p.PG = (unsigned char*)take((size_t)MT * 3072);
    const size_t r1_end = off;
    off = r1;
    p.XS = (unsigned char*)take((size_t)NE * EROWS * DM);
    p.H = (unsigned char*)take((size_t)NE * EROWS * FF);
    p.Y = (bf16_t*)take((size_t)NE * EROWS * DM * 2);
    if (off < r1_end) off = r1_end;
    if (off > ws_size) { fprintf(stderr, "workspace too small: need %zu have %zu\n", off, ws_size); return; }
    static int grid = 0;
    if (!grid) {
        (void)hipFuncSetAttribute((const void*)fwd, hipFuncAttributeMaxDynamicSharedMemorySize, LDS_BYTES);
        int dev = 0, cus = 0, per_cu = 0;
        (void)hipGetDevice(&dev);
        (void)hipDeviceGetAttribute(&cus, hipDeviceAttributeMultiprocessorCount, dev);
        (void)hipOccupancyMaxActiveBlocksPerMultiprocessor(&per_cu, fwd, NTHREADS, LDS_BYTES);
        if (per_cu < 1) fprintf(stderr, "occupancy query says %d blocks per CU\n", per_cu);
        grid = cus;
    }
    (void)hipMemsetAsync(p.bar, 0, (XCD_BAR_WORDS + QUEUE_WORDS) * 4, stream);
    hipLaunchKernelGGL(fwd, dim3(grid), dim3(NTHREADS), LDS_BYTES, stream, p);
}
```
